# Optimizing an MI355X kernel written in HIP

```python
import math
import jax, jax.numpy as jnp
from jax import lax
import numpy as np

D_MODEL = 1024
BATCH = 4
SEQ = 4096
DEPTH = 1

GRID_W = 64
CTX_LEN = 256
ATTN_HEADS = 4
ATTN_QK_DIM = 64
ATTN_V_DIM = 2 * ATTN_QK_DIM
ATTN_WIDTH = ATTN_HEADS * ATTN_V_DIM
QKV_WIDTH = 3 * ATTN_WIDTH
AXIS_DIM = ATTN_QK_DIM // 2
ROPE_THETA = 10000.0
Q_BLOCK = 128
POOL_WIDTH = D_MODEL - ATTN_WIDTH
POOL_WINDOWS = (2, 4, 8, 16)
N_POOL_GROUPS = len(POOL_WINDOWS)
POOL_GROUP = POOL_WIDTH // N_POOL_GROUPS
IN_WIDTH = QKV_WIDTH + POOL_WIDTH
N_EXPERTS = 64
TOP_K = 8
N_GROUPS = 8
TOPK_GROUPS = 4
EXPERT_DIM = 256
SHARED_DIM = 256
ROUTED_SCALE = 2.5
EXPERT_BLOCK = 256
EPS = 1e-6

kernel_name = "hybrid_diffattn_pool_moe_dit_layer"


def rmsnorm(x, g):
    xf = x.astype(jnp.float32)
    y = xf * lax.rsqrt(jnp.mean(xf * xf, axis=-1, keepdims=True) + EPS)
    return (y * g.astype(jnp.float32)).astype(x.dtype)


def adaln(cvec, w, b):
    m = jax.nn.silu(cvec) @ w + b
    return jnp.split(m, 6, axis=-1)


def modulate(h, shift, scale):
    return h * (1.0 + scale) + shift


def axial_rope_tables(rows):
    row = jnp.broadcast_to(jnp.arange(rows)[:, None], (rows, GRID_W)).reshape(-1).astype(jnp.float32)
    col = jnp.broadcast_to(jnp.arange(GRID_W)[None, :], (rows, GRID_W)).reshape(-1).astype(jnp.float32)
    freqs = ROPE_THETA ** (-jnp.arange(0, AXIS_DIM, 2, dtype=jnp.float32) / AXIS_DIM)
    ar = row[:, None] * freqs
    ac = col[:, None] * freqs
    return (jnp.cos(ar), jnp.sin(ar), jnp.cos(ac), jnp.sin(ac))


def rope_axis(x, cos, sin):
    x1, x2 = jnp.split(x, 2, axis=-1)
    cos = cos[None, :, None, :]
    sin = sin[None, :, None, :]
    return jnp.concatenate([x1 * cos - x2 * sin, x2 * cos + x1 * sin], axis=-1)


def rope2d(x, tabs):
    cr, sr, cc, sc = tabs
    out = jnp.concatenate([rope_axis(x[..., :AXIS_DIM], cr, sr), rope_axis(x[..., AXIS_DIM:], cc, sc)], axis=-1)
    return out.astype(x.dtype)


def split_q(pq):
    b, n, _ = pq.shape
    q = pq.reshape(b, n, ATTN_HEADS, 2, ATTN_QK_DIM)
    return q[..., 0, :], q[..., 1, :]


def split_kv(pkv):
    b, n, _ = pkv.shape
    k = pkv[..., :ATTN_WIDTH].reshape(b, n, ATTN_HEADS, 2, ATTN_QK_DIM)
    v = pkv[..., ATTN_WIDTH:].reshape(b, n, ATTN_HEADS, ATTN_V_DIM)
    return k[..., 0, :], k[..., 1, :], v


def bhnd(x):
    return jnp.swapaxes(x, 1, 2)


def diff_lambda(lq1, lk1, lq2, lk2, lam_init):
    f = jnp.float32
    return (jnp.exp(jnp.sum(lq1.astype(f) * lk1.astype(f))) - jnp.exp(jnp.sum(lq2.astype(f) * lk2.astype(f)))
            + lam_init)


def diff_attn(q1, q2, k1, k2, v, lam):
    scale = ATTN_QK_DIM ** -0.5
    s1 = jnp.einsum('bhqd,bhkd->bhqk', q1, k1, preferred_element_type=jnp.float32) * scale
    s2 = jnp.einsum('bhqd,bhkd->bhqk', q2, k2, preferred_element_type=jnp.float32) * scale
    a = jax.nn.softmax(s1, axis=-1) - lam * jax.nn.softmax(s2, axis=-1)
    return jnp.einsum('bhqk,bhkd->bhqd', a.astype(v.dtype), v)


def blocked_diff_attn(q1, q2, k1, k2, v, lam):
    b, h, n, d = q1.shape
    nb = n // Q_BLOCK
    to_blocks = lambda q: jnp.moveaxis(q.reshape(b, h, nb, Q_BLOCK, d), 2, 0)
    o = lax.map(lambda qq: diff_attn(qq[0], qq[1], k1, k2, v, lam), (to_blocks(q1), to_blocks(q2)))
    return jnp.moveaxis(o, 0, 2).reshape(b, h, n, ATTN_V_DIM)


def attn_heads_out(o, g_subln, lam_init):
    o = rmsnorm(o, g_subln) * (1.0 - lam_init)
    b, h, n, dv = o.shape
    return bhnd(o).reshape(b, n, h * dv)


def pool_mix(p, w_pool, b_pool, pool_scale):
    b, n, _ = p.shape
    pf = p.astype(jnp.float32)
    cs = jnp.concatenate([jnp.zeros((b, 1, POOL_WIDTH), jnp.float32), jnp.cumsum(pf, axis=1)], axis=1)
    t = jnp.arange(n)
    outs = []
    for gi, w in enumerate(POOL_WINDOWS):
        lo = jnp.clip(t - w // 2, 0, n)
        hi = jnp.clip(t + (w - w // 2), 0, n)
        sl = slice(gi * POOL_GROUP, (gi + 1) * POOL_GROUP)
        csg = cs[..., sl]
        mean = (csg[:, hi] - csg[:, lo]) / (hi - lo).astype(jnp.float32)[None, :, None]
        outs.append(mean - pf[..., sl])
    d = jnp.stack(outs, axis=2)
    y = jnp.einsum('bngc,gce->bnge', d, w_pool.astype(jnp.float32)).reshape(b, n, POOL_WIDTH) + b_pool
    return (y * pool_scale).astype(p.dtype)


def swiglu(t, wg, wu, wd):
    return (jax.nn.silu(t @ wg) * (t @ wu)) @ wd


def moe_ffn(h, w_router, router_bias, w_e_gate, w_e_up, w_e_down, w_sh_gate, w_sh_up, w_sh_down):
    b, n, d = h.shape
    t = h.reshape(-1, d)
    T = t.shape[0]
    scores = jax.nn.sigmoid((t @ w_router).astype(jnp.float32))
    biased = scores + router_bias.astype(jnp.float32)
    grp = biased.reshape(T, N_GROUPS, N_EXPERTS // N_GROUPS)
    grp_score = lax.top_k(grp, 2)[0].sum(-1)
    _, top_groups = lax.top_k(grp_score, TOPK_GROUPS)
    group_mask = jax.nn.one_hot(top_groups, N_GROUPS, dtype=jnp.float32).sum(1) > 0
    expert_mask = jnp.repeat(group_mask, N_EXPERTS // N_GROUPS, axis=1)
    _, top_e = lax.top_k(jnp.where(expert_mask, biased, -jnp.inf), TOP_K)
    wts = jnp.take_along_axis(scores, top_e, axis=1)
    wts = wts / jnp.sum(wts, axis=-1, keepdims=True) * ROUTED_SCALE
    A = T * TOP_K
    flat_e = top_e.reshape(-1)
    flat_tok = jnp.repeat(jnp.arange(T, dtype=jnp.int32), TOP_K)
    flat_w = wts.reshape(-1)
    order = jnp.argsort(flat_e)
    sorted_e = flat_e[order]
    counts = jnp.bincount(flat_e, length=N_EXPERTS)
    starts = jnp.cumsum(counts) - counts
    padded = ((counts + EXPERT_BLOCK - 1) // EXPERT_BLOCK) * EXPERT_BLOCK
    pends = jnp.cumsum(padded)
    pstarts = pends - padded
    dest = pstarts[sorted_e] + (jnp.arange(A) - starts[sorted_e])
    P = A + N_EXPERTS * EXPERT_BLOCK
    nblk = P // EXPERT_BLOCK
    slot_tok = jnp.full((P,), T, jnp.int32).at[dest].set(flat_tok[order])
    slot_w = jnp.zeros((P,), jnp.float32).at[dest].set(flat_w[order])
    block_e = jnp.minimum(jnp.searchsorted(pends, jnp.arange(nblk) * EXPERT_BLOCK, side='right'), N_EXPERTS - 1)
    t_pad = jnp.concatenate([t, jnp.zeros((1, d), t.dtype)], axis=0)

    def expert_block(args):
        tok, wb, e = args
        xb = t_pad[tok]
        yb = swiglu(xb, w_e_gate[e], w_e_up[e], w_e_down[e])
        return yb * wb[:, None]

    yb = lax.map(expert_block, (slot_tok.reshape(nblk, EXPERT_BLOCK), slot_w.reshape(nblk, EXPERT_BLOCK), block_e))
    routed = jax.ops.segment_sum(yb.reshape(P, d), slot_tok, num_segments=T + 1)[:T]
    shared = swiglu(t, w_sh_gate, w_sh_up, w_sh_down)
    return (routed + shared).astype(h.dtype).reshape(b, n, d)


def setup_inputs(seed: int = 0) -> dict:
    key = jax.random.key(seed)
    ks = jax.random.split(key, 32)
    f32 = jnp.float32
    L, D, E, F, FS = DEPTH, D_MODEL, N_EXPERTS, EXPERT_DIM, SHARED_DIM

    def nrm(k, shape, scale=1.0):
        return jax.random.normal(k, shape, f32) * scale

    def gain(k, shape, s=0.05):
        return 1.0 + s * jax.random.normal(k, shape, f32)

    return {
        "x": nrm(ks[0], (BATCH, SEQ, D)),
        "c": nrm(ks[1], (BATCH, D)),
        "ctx": nrm(ks[2], (BATCH, CTX_LEN, D)),
        "c_ctx": nrm(ks[3], (D,)),
        "w_ada": nrm(ks[4], (L, D, 6 * D), D ** -0.5),
        "b_ada": nrm(ks[5], (L, 6 * D), 0.01),
        "g_pre_mix": gain(ks[6], (L, D)),
        "g_post_mix": gain(ks[7], (L, D)),
        "g_pre_ffn": gain(ks[8], (L, D)),
        "g_post_ffn": gain(ks[9], (L, D)),
        "w_in": nrm(ks[10], (L, D, IN_WIDTH), D ** -0.5),
        "lambda_q1": nrm(ks[11], (L, ATTN_QK_DIM), 0.1),
        "lambda_k1": nrm(ks[12], (L, ATTN_QK_DIM), 0.1),
        "lambda_q2": nrm(ks[13], (L, ATTN_QK_DIM), 0.1),
        "lambda_k2": nrm(ks[14], (L, ATTN_QK_DIM), 0.1),
        "g_subln": gain(ks[15], (L, ATTN_V_DIM)),
        "w_pool": nrm(ks[16], (L, N_POOL_GROUPS, POOL_GROUP, POOL_GROUP), POOL_GROUP ** -0.5),
        "b_pool": nrm(ks[17], (L, POOL_WIDTH), 0.01),
        "pool_scale": gain(ks[18], (L, POOL_WIDTH), 0.1),
        "w_out": nrm(ks[19], (L, D, D), D ** -0.5),
        "w_router": nrm(ks[20], (L, D, E), D ** -0.5),
        "router_bias": nrm(ks[21], (L, E), 0.01),
        "w_e_gate": nrm(ks[22], (L, E, D, F), D ** -0.5),
        "w_e_up": nrm(ks[23], (L, E, D, F), D ** -0.5),
        "w_e_down": nrm(ks[24], (L, E, F, D), F ** -0.5),
        "w_sh_gate": nrm(ks[25], (L, D, FS), D ** -0.5),
        "w_sh_up": nrm(ks[26], (L, D, FS), D ** -0.5),
        "w_sh_down": nrm(ks[27], (L, FS, D), FS ** -0.5),
    }


def reference(x, c, ctx, c_ctx, w_ada, b_ada, g_pre_mix, g_post_mix, g_pre_ffn, g_post_ffn, w_in,
              lambda_q1, lambda_k1, lambda_q2, lambda_k2, g_subln, w_pool, b_pool, pool_scale, w_out,
              w_router, router_bias, w_e_gate, w_e_up, w_e_down, w_sh_gate, w_sh_up, w_sh_down):
    n = x.shape[1]
    rows = n // GRID_W
    tabs = axial_rope_tables(rows)
    ex = lambda m: m[:, None, :]
    for l in range(DEPTH):
        last = l == DEPTH - 1
        lam_init = 0.8 - 0.6 * math.exp(-0.3 * l)
        sh_a, sc_a, g_a, sh_f, sc_f, g_f = adaln(c, w_ada[l], b_ada[l])
        csh_a, csc_a, cg_a, csh_f, csc_f, cg_f = adaln(c_ctx, w_ada[l], b_ada[l])
        lam = diff_lambda(lambda_q1[l], lambda_k1[l], lambda_q2[l], lambda_k2[l], lam_init)

        hx = modulate(rmsnorm(x, g_pre_mix[l]), ex(sh_a), ex(sc_a))
        hc = modulate(rmsnorm(ctx, g_pre_mix[l]), csh_a, csc_a)
        px = hx @ w_in[l]
        q1x, q2x = split_q(px[..., :ATTN_WIDTH])
        k1x, k2x, vx = split_kv(px[..., ATTN_WIDTH:QKV_WIDTH])
        q1x, q2x, k1x, k2x = (rope2d(t, tabs) for t in (q1x, q2x, k1x, k2x))
        k1c, k2c, vc = split_kv(hc @ w_in[l][:, ATTN_WIDTH:QKV_WIDTH])
        k1_all = jnp.concatenate([bhnd(k1c), bhnd(k1x)], axis=2)
        k2_all = jnp.concatenate([bhnd(k2c), bhnd(k2x)], axis=2)
        v_all = jnp.concatenate([bhnd(vc), bhnd(vx)], axis=2)
        att_x = blocked_diff_attn(bhnd(q1x), bhnd(q2x), k1_all, k2_all, v_all, lam)
        att_x = attn_heads_out(att_x, g_subln[l], lam_init)
        pool_x = pool_mix(px[..., QKV_WIDTH:], w_pool[l], b_pool[l], pool_scale[l])
        yx = jnp.concatenate([att_x, pool_x], axis=-1) @ w_out[l]
        x = x + ex(g_a) * rmsnorm(yx, g_post_mix[l])
        if not last:
            q1c, q2c = split_q(hc @ w_in[l][:, :ATTN_WIDTH])
            att_c = diff_attn(bhnd(q1c), bhnd(q2c), bhnd(k1c), bhnd(k2c), bhnd(vc), lam)
            att_c = attn_heads_out(att_c, g_subln[l], lam_init)
            pool_c = pool_mix(hc @ w_in[l][:, QKV_WIDTH:], w_pool[l], b_pool[l], pool_scale[l])
            yc = jnp.concatenate([att_c, pool_c], axis=-1) @ w_out[l]
            ctx = ctx + cg_a * rmsnorm(yc, g_post_mix[l])

        moe_w = (w_router[l], router_bias[l], w_e_gate[l], w_e_up[l], w_e_down[l],
                 w_sh_gate[l], w_sh_up[l], w_sh_down[l])
        hx = modulate(rmsnorm(x, g_pre_ffn[l]), ex(sh_f), ex(sc_f))
        x = x + ex(g_f) * rmsnorm(moe_ffn(hx, *moe_w), g_post_ffn[l])
        if not last:
            hc = modulate(rmsnorm(ctx, g_pre_ffn[l]), csh_f, csc_f)
            ctx = ctx + cg_f * rmsnorm(moe_ffn(hc, *moe_w), g_post_ffn[l])
    return x
```

```cpp
#include <hip/hip_runtime.h>
#include <cstdio>
#include <cstdint>

#ifndef MK_PER_PHASE_LAUNCH
#define MK_PER_PHASE_LAUNCH 0
#endif

constexpr int NB = 4, NSEQ = 4096, DM = 1024, T = NB * NSEQ, CTXL = 256, TC = NB * CTXL, TT = T + TC;
constexpr int NH = 4, DQK = 64, DV = 128, AW = 512, INW = 2048, PW = 512;
constexpr int SKV = CTXL + NSEQ;
constexpr int NE = 64, FF = 256, TOPK = 8;
constexpr int HALF_T = T / 2;
constexpr int NSLOT_R = T * TOPK;
constexpr int NSLOT = NSLOT_R + T;
constexpr int YROWS = HALF_T * (TOPK + 1);
constexpr float EPS = 1e-6f;
constexpr float LAM_INIT = 0.2f;
constexpr int NVB = 256;

typedef unsigned short bf16_t;
typedef unsigned int u32;

constexpr size_t KiB = 1024, MiB = 1024 * 1024;
constexpr size_t WS_CTL = 0;
constexpr size_t CTL_ZERO_BYTES = 64 * KiB;
constexpr size_t WS_MODS = 64 * KiB;
constexpr size_t WS_LAM = 192 * KiB;
constexpr size_t WS_ROPE = 196 * KiB;
constexpr size_t WS_SEG = 208 * KiB;
constexpr size_t WS_BLKCNT = 256 * KiB;
constexpr size_t WS_TOPE = 512 * KiB;
constexpr size_t WS_TOPW = 1 * MiB;
constexpr size_t WS_TOKSLOT = 1 * MiB + 512 * KiB;
constexpr size_t WS_SLOTTOK = 2 * MiB;
constexpr size_t WS_SLOTW = 2 * MiB + 512 * KiB;
constexpr size_t WS_SLOTE = 3 * MiB;
constexpr size_t WS_WD = 4 * MiB;
constexpr size_t WS_WGU = WS_WD + 33280 * KiB;
constexpr size_t WS_HX = WS_WGU + 65 * MiB;
constexpr size_t WS_WIN = WS_HX + 34 * MiB;
constexpr size_t WS_WOUT = WS_WIN + 4 * MiB;
constexpr size_t WS_Q = WS_WOUT + 2 * MiB;
constexpr size_t WS_K = WS_Q + 16 * MiB;
constexpr size_t WS_V = WS_K + 17 * MiB;
constexpr size_t WS_P = WS_V + 17 * MiB;
constexpr size_t WS_ATT = WS_P + 16 * MiB;
constexpr size_t WS_YX = WS_ATT + 32 * MiB;
constexpr size_t WS_PXB = WS_ATT;
constexpr size_t WS_ACT = 227 * MiB + 256 * KiB;
constexpr size_t WS_Y = WS_WGU;
constexpr size_t WS_END = WS_ACT + (size_t)(NSLOT + 256) * FF * 2;
static_assert(WS_YX + 32 * MiB <= WS_END + 64 * MiB, "map");
static_assert(WS_Y + (size_t)(YROWS + 256) * DM * 2 <= WS_ACT, "Y must not reach ACT");
static_assert(WS_PXB + (size_t)TT * INW * 2 <= WS_END, "PXB fits");

constexpr int LDS_BYTES = 147456;
constexpr int LDS_MAIN = 140 * 1024;
constexpr int LDSCTL_OFF = LDS_MAIN;
constexpr int MISC_OFF = LDSCTL_OFF + 320;

#define GAS __attribute__((address_space(1)))
#define LAS __attribute__((address_space(3)))

__device__ __forceinline__ u32 f2bf(float f) { u32 u = __float_as_uint(f); return (u + 0x7fffu + ((u >> 16) & 1u)) >> 16; }
__device__ __forceinline__ u32 pk2(float lo, float hi) { return f2bf(lo) | (f2bf(hi) << 16); }
__device__ __forceinline__ float bflo(u32 w) { return __uint_as_float(w << 16); }
__device__ __forceinline__ float bfhi(u32 w) { return __uint_as_float(w & 0xffff0000u); }
__device__ __forceinline__ float bf2f(bf16_t b) { return __uint_as_float(((u32)b) << 16); }
__device__ __forceinline__ float wave_sum(float v) {
#pragma unroll
    for (int o = 1; o < 64; o <<= 1) v += __shfl_xor(v, o);
    return v;
}
__device__ __forceinline__ float wave_max(float v) {
#pragma unroll
    for (int o = 1; o < 64; o <<= 1) v = fmaxf(v, __shfl_xor(v, o));
    return v;
}
__device__ __forceinline__ float silu_f(float v) { return v / (1.f + __expf(-v)); }
__device__ __forceinline__ float dot8(uint4 a, uint4 b, float acc) {
    acc = fmaf(bflo(a.x), bflo(b.x), acc); acc = fmaf(bfhi(a.x), bfhi(b.x), acc);
    acc = fmaf(bflo(a.y), bflo(b.y), acc); acc = fmaf(bfhi(a.y), bfhi(b.y), acc);
    acc = fmaf(bflo(a.z), bflo(b.z), acc); acc = fmaf(bfhi(a.z), bfhi(b.z), acc);
    acc = fmaf(bflo(a.w), bflo(b.w), acc); acc = fmaf(bfhi(a.w), bfhi(b.w), acc);
    return acc;
}
__device__ __forceinline__ float ndot(const bf16_t* a, const bf16_t* b, int K) {
    float a0 = 0.f, a1 = 0.f;
    for (int k = 0; k < K; k += 16) {
        const uint4 x0 = *(const uint4*)(a + k), y0 = *(const uint4*)(b + k), x1 = *(const uint4*)(a + k + 8), y1 = *(const uint4*)(b + k + 8);
        a0 = dot8(x0, y0, a0); a1 = dot8(x1, y1, a1);
    }
    return a0 + a1;
}

#define XB_TMO      128
#define XB_XCNT(j)  (256  + 64 * (j))
#define XB_XSUB(j)  (1280 + 64 * (j))
#define XB_XGEN(j)  (2304 + 64 * (j))
#define XB_TOP      3328
#define XB_TOPGEN   3392
#define XCD_BAR_WORDS 3456
#define XB_SPIN_CAP (1u << 22)
__device__ __forceinline__ unsigned xb_ld(unsigned* p)              { return __hip_atomic_load(p, __ATOMIC_RELAXED, __HIP_MEMORY_SCOPE_AGENT); }
__device__ __forceinline__ unsigned xb_add(unsigned* p, unsigned v) { return __hip_atomic_fetch_add(p, v, __ATOMIC_RELAXED, __HIP_MEMORY_SCOPE_AGENT); }
__device__ __forceinline__ unsigned xb_xcc_id() { return (unsigned)__builtin_amdgcn_s_getreg((3 << 11) | 20) & 0xFu; }
#define XB_SPIN(cond, bar) do { unsigned _sp = 0; while (cond) { __builtin_amdgcn_s_sleep(1); \
    if ((++_sp & 255u) == 0u) { if (xb_ld(&(bar)[XB_TMO])) break; if (_sp > XB_SPIN_CAP) { atomicAdd(&(bar)[XB_TMO], 1u); break; } } } } while (0)
struct XcdBarrier { unsigned* bar; unsigned x; volatile LAS unsigned* st; };
__device__ __forceinline__ XcdBarrier xcd_barrier_post(unsigned* bar, volatile LAS unsigned* st) {
    XcdBarrier b; b.bar = bar; b.x = xb_xcc_id(); b.st = st;
    if (threadIdx.x == 0) (void)xb_add(&bar[XB_XCNT(b.x)], 1u);
    return b;
}
__device__ __forceinline__ void xcd_barrier_complete(unsigned* bar, unsigned x, unsigned& nloc, unsigned& nx) {
    const unsigned G = gridDim.x * gridDim.y * gridDim.z;
    unsigned sum, cnt, mine, sp = 0u;
    for (;;) {
        sum = 0u; cnt = 0u; mine = 0u;
#pragma unroll
        for (unsigned j = 0; j < 16; ++j) { const unsigned c = xb_ld(&bar[XB_XCNT(j)]); sum += c; cnt += (c > 0u) ? 1u : 0u; mine = (j == x) ? c : mine; }
        if (sum == G) break;
        __builtin_amdgcn_s_sleep(1);
        if ((++sp & 255u) == 0u) { if (xb_ld(&bar[XB_TMO])) break; if (sp > XB_SPIN_CAP) { atomicAdd(&bar[XB_TMO], 1u); break; } }
    }
    nloc = mine > 0u ? mine : 1u; nx = cnt > 0u ? cnt : 1u;
}
__device__ __forceinline__ void xcd_barrier(const XcdBarrier& b) {
    asm volatile("s_waitcnt vmcnt(0)" ::: "memory");
    __syncthreads();
    if (threadIdx.x == 0) {
        unsigned* bar = b.bar;
        __builtin_amdgcn_s_waitcnt(0);
        unsigned nloc = b.st[0], nx = b.st[1];
        if (nloc == 0u) { xcd_barrier_complete(bar, b.x, nloc, nx); b.st[0] = nloc; b.st[1] = nx; }
        const unsigned old = xb_add(&bar[XB_XSUB(b.x)], 1u);
        const unsigned gen = old / nloc;
        if (old + 1u == (gen + 1u) * nloc) {
            __builtin_amdgcn_fence(__ATOMIC_RELEASE, "agent");
            asm volatile("s_waitcnt vmcnt(0)" ::: "memory");
            const unsigned og = xb_add(&bar[XB_TOP], 1u);
            const unsigned tg = og / nx;
            if (og + 1u == (tg + 1u) * nx) xb_add(&bar[XB_TOPGEN], 1u);
            else XB_SPIN(xb_ld(&bar[XB_TOPGEN]) == tg, bar);
            __builtin_amdgcn_fence(__ATOMIC_ACQUIRE, "agent");
            xb_add(&bar[XB_XGEN(b.x)], 1u);
            asm volatile("s_waitcnt vmcnt(0)" ::: "memory");
        } else {
            XB_SPIN(xb_ld(&bar[XB_XGEN(b.x)]) == gen, bar);
            __builtin_amdgcn_fence(__ATOMIC_ACQUIRE, "agent");
            asm volatile("s_waitcnt vmcnt(0)" ::: "memory");
        }
    }
    __syncthreads();
}

struct Args {
    const float* in[28];
    float* out;
    unsigned char* ws;
    int ph_lo, ph_hi;
};
enum { I_X = 0, I_C, I_CTX, I_CCTX, I_WADA, I_BADA, I_GPREMIX, I_GPOSTMIX, I_GPREFFN, I_GPOSTFFN, I_WIN, I_LQ1, I_LK1, I_LQ2, I_LK2,
       I_GSUBLN, I_WPOOL, I_BPOOL, I_PSCALE, I_WOUT, I_WROUTER, I_RBIAS, I_WEG, I_WEU, I_WED, I_WSG, I_WSU, I_WSD };

struct Ctx {
    int tid, lane, wave, blk, G;
    unsigned char* lds;
};

__device__ __forceinline__ void ph_adaln(const Args& a, const Ctx& c) {
    float* MODS = (float*)(a.ws + WS_MODS);
    float* red = (float*)c.lds;
    const float* w_ada = a.in[I_WADA];
    for (int it = c.blk; it < 96; it += c.G) {
        const int j = it * 64 + c.lane;
        float acc[5] = {0.f, 0.f, 0.f, 0.f, 0.f};
        const int k0 = c.wave * 128;
        for (int k = k0; k < k0 + 128; ++k) {
            const float w = w_ada[(size_t)k * 6144 + j];
#pragma unroll
            for (int r = 0; r < 5; ++r) { const float cv = (r < 4) ? a.in[I_C][r * DM + k] : a.in[I_CCTX][k]; acc[r] = fmaf(silu_f(cv), w, acc[r]); }
        }
#pragma unroll
        for (int r = 0; r < 5; ++r) red[(c.wave * 5 + r) * 64 + c.lane] = acc[r];
        __syncthreads();
        if (c.tid < 320) {
            const int r = c.tid >> 6, l = c.tid & 63; float s = 0.f;
#pragma unroll
            for (int w = 0; w < 8; ++w) s += red[(w * 5 + r) * 64 + l];
            MODS[r * 6144 + it * 64 + l] = s + a.in[I_BADA][it * 64 + l];
        }
        __syncthreads();
    }
    if (c.blk == c.G - 1) {
        float* ROPE = (float*)(a.ws + WS_ROPE);
        for (int i = c.tid; i < 1024; i += 512) {
            const int pos = i >> 4, fi = i & 15;
            const float freq = powf(10000.f, -(float)fi / 16.f);
            const float ang = (float)pos * freq;
            ROPE[i * 2] = cosf(ang); ROPE[i * 2 + 1] = sinf(ang);
        }
        if (c.wave == 0) {
            const float s1 = wave_sum(a.in[I_LQ1][c.lane] * a.in[I_LK1][c.lane]);
            const float s2 = wave_sum(a.in[I_LQ2][c.lane] * a.in[I_LK2][c.lane]);
            if (c.lane == 0) *(float*)(a.ws + WS_LAM) = expf(s1) - expf(s2) + LAM_INIT;
        }
    }
}

__device__ __forceinline__ void transpose_item(const float* W, int K, int N, bf16_t* WT, int k0, int n0, int drow0, float* scr, int lane) {
#pragma unroll 8
    for (int i = 0; i < 32; ++i) { const int kk = 2 * i + (lane >> 5); scr[kk * 33 + (lane & 31)] = W[(size_t)(k0 + kk) * N + n0 + (lane & 31)]; }
    asm volatile("s_waitcnt lgkmcnt(0)" ::: "memory");
    const int cc = lane & 7;
#pragma unroll
    for (int j = 0; j < 4; ++j) { const int n = (lane >> 3) + 8 * j; const float* s = scr + (8 * cc) * 33 + n;
        uint4 o; o.x = pk2(s[0 * 33], s[1 * 33]); o.y = pk2(s[2 * 33], s[3 * 33]); o.z = pk2(s[4 * 33], s[5 * 33]); o.w = pk2(s[6 * 33], s[7 * 33]);
        *(uint4*)(WT + (size_t)(drow0 + n) * K + k0 + 8 * cc) = o; }
    asm volatile("s_waitcnt lgkmcnt(0)" ::: "memory");
}
__device__ __forceinline__ void ph_prep(const Args& a, const Ctx& c) {
    float* scr = (float*)(c.lds + c.wave * 16384);
    const int gw = c.blk * 8 + c.wave, NGW = c.G * 8;
    constexpr int I_IN = 16 * 64, I_OUT = 16 * 32, I_G = 16 * 8, I_D = 4 * 32;
    constexpr int NIT = I_IN + I_OUT + 65 * (2 * I_G + I_D);
    bf16_t* WIN = (bf16_t*)(a.ws + WS_WIN); bf16_t* WOUT = (bf16_t*)(a.ws + WS_WOUT); bf16_t* WGU = (bf16_t*)(a.ws + WS_WGU); bf16_t* WD = (bf16_t*)(a.ws + WS_WD);
    for (int it = gw; it < NIT; it += NGW) {
        int r = it;
        if (r < I_IN) { const int kb = r / 64, nb = r % 64; transpose_item(a.in[I_WIN], DM, INW, WIN, kb * 64, nb * 32, nb * 32, scr, c.lane); continue; } r -= I_IN;
        if (r < I_OUT) { const int kb = r / 32, nb = r % 32; transpose_item(a.in[I_WOUT], DM, DM, WOUT, kb * 64, nb * 32, nb * 32, scr, c.lane); continue; } r -= I_OUT;
        const int e = r / (2 * I_G + I_D); r -= e * (2 * I_G + I_D);
        if (r < 2 * I_G) {
            const int up = r / I_G; r -= up * I_G; const int kb = r / 8, nb = r % 8, n0 = nb * 32;
            const float* src = (e < 64) ? a.in[up ? I_WEU : I_WEG] + (size_t)e * DM * FF : a.in[up ? I_WSU : I_WSG];
            transpose_item(src, DM, FF, WGU + (size_t)e * 512 * DM, kb * 64, n0, 256 * (n0 >> 7) + (n0 & 127) + (up ? 128 : 0), scr, c.lane);
        } else {
            r -= 2 * I_G; const int kb = r / 32, nb = r % 32;
            const float* src = (e < 64) ? a.in[I_WED] + (size_t)e * FF * DM : a.in[I_WSD];
            transpose_item(src, FF, DM, WD + (size_t)e * DM * FF, kb * 64, nb * 32, nb * 32, scr, c.lane);
        }
    }
    const float* MODS = (const float*)(a.ws + WS_MODS); bf16_t* HX = (bf16_t*)(a.ws + WS_HX);
    for (int m = gw; m < TT; m += NGW) {
        const float* xr = (m < T) ? a.in[I_X] + (size_t)m * DM : a.in[I_CTX] + (size_t)(m - T) * DM;
        const float* md = MODS + (size_t)((m < T) ? (m / NSEQ) : 4) * 6144;
        float4 v[4]; float ss = 0.f;
#pragma unroll
        for (int j = 0; j < 4; ++j) { v[j] = *(const float4*)(xr + 4 * c.lane + 256 * j); ss += v[j].x * v[j].x + v[j].y * v[j].y + v[j].z * v[j].z + v[j].w * v[j].w; }
        const float rs = rsqrtf(wave_sum(ss) * (1.f / DM) + EPS);
#pragma unroll
        for (int j = 0; j < 4; ++j) {
            const int col = 4 * c.lane + 256 * j;
            const float4 g = *(const float4*)(a.in[I_GPREMIX] + col), sh = *(const float4*)(md + col), sc = *(const float4*)(md + 1024 + col);
            const float o0 = v[j].x * rs * g.x * (1.f + sc.x) + sh.x, o1 = v[j].y * rs * g.y * (1.f + sc.y) + sh.y;
            const float o2 = v[j].z * rs * g.z * (1.f + sc.z) + sh.z, o3 = v[j].w * rs * g.w * (1.f + sc.w) + sh.w;
            uint2 w; w.x = pk2(o0, o1); w.y = pk2(o2, o3);
            *(uint2*)(HX + (size_t)m * DM + col) = w;
        }
    }
}

__device__ __forceinline__ void naive_gemm(const bf16_t* A, const bf16_t* Bt, bf16_t* C, int M, int N, int K, const Ctx& c) {
    const size_t total = (size_t)M * N;
    for (size_t idx = (size_t)c.blk * 512 + c.tid; idx < total; idx += (size_t)c.G * 512) {
        const int row = (int)(idx / N), col = (int)(idx % N);
        C[idx] = (bf16_t)f2bf(ndot(A + (size_t)row * K, Bt + (size_t)col * K, K));
    }
}

__device__ __forceinline__ void ph_rope_scatter(const Args& a, const Ctx& c) {
    const bf16_t* PXB = (const bf16_t*)(a.ws + WS_PXB); const float* ROPE = (const float*)(a.ws + WS_ROPE);
    bf16_t* Q = (bf16_t*)(a.ws + WS_Q); bf16_t* Kb = (bf16_t*)(a.ws + WS_K); bf16_t* Vb = (bf16_t*)(a.ws + WS_V); bf16_t* P = (bf16_t*)(a.ws + WS_P);
    const size_t total = (size_t)TT * INW;
    for (size_t idx = (size_t)c.blk * 512 + c.tid; idx < total; idx += (size_t)c.G * 512) {
        const int row = (int)(idx / INW), col = (int)(idx % INW);
        float v = bf2f(PXB[idx]);
        if (row < T) {
            const int b = row / NSEQ, n = row % NSEQ;
            if (col < 1024) {
                const int d = col & 63, half = d >> 5, dd = d & 31, fi = dd & 15;
                const int pos = half ? (n & 63) : (n >> 6);
                const float cs = ROPE[(pos * 16 + fi) * 2], sn = ROPE[(pos * 16 + fi) * 2 + 1];
                const float o = bf2f(PXB[(dd < 16) ? idx + 16 : idx - 16]);
                v = (dd < 16) ? v * cs - o * sn : v * cs + o * sn;
                if (col < 512) Q[(size_t)row * AW + col] = (bf16_t)f2bf(v);
                else Kb[((size_t)b * SKV + CTXL + n) * AW + (col - 512)] = (bf16_t)f2bf(v);
            } else if (col < 1536) Vb[((size_t)b * SKV + CTXL + n) * AW + (col - 1024)] = (bf16_t)f2bf(v);
            else P[(size_t)row * PW + (col - 1536)] = (bf16_t)f2bf(v);
        } else {
            const int b = (row - T) / CTXL, j = (row - T) % CTXL;
            if (col >= 512 && col < 1024) Kb[((size_t)b * SKV + j) * AW + (col - 512)] = (bf16_t)f2bf(v);
            else if (col >= 1024 && col < 1536) Vb[((size_t)b * SKV + j) * AW + (col - 1024)] = (bf16_t)f2bf(v);
        }
    }
}

__device__ __forceinline__ void ph_attn_naive(const Args& a, const Ctx& c) {
    const bf16_t* Q = (const bf16_t*)(a.ws + WS_Q); const bf16_t* Kb = (const bf16_t*)(a.ws + WS_K); const bf16_t* Vb = (const bf16_t*)(a.ws + WS_V);
    bf16_t* ATT = (bf16_t*)(a.ws + WS_ATT);
    const float lam = *(const float*)(a.ws + WS_LAM);
    float* S = (float*)c.lds;
    float* qs = S + 8 * SKV;
    float* st = qs + 512;
    constexpr int NITEM = NB * NH * (NSEQ / 4);
    for (int it = c.blk; it < NITEM; it += c.G) {
        const int qg = it % (NSEQ / 4), h = (it / (NSEQ / 4)) % NH, b = it / (NSEQ / 4 * NH);
        const int row0 = b * NSEQ + qg * 4;
        { const int r = c.tid >> 7, d = c.tid & 127; qs[c.tid] = bf2f(Q[(size_t)(row0 + r) * AW + h * 128 + d]); }
        __syncthreads();
        for (int j = c.tid; j < SKV; j += 512) {
            const bf16_t* kr = Kb + ((size_t)b * SKV + j) * AW + h * 128;
            float s[4][2];
#pragma unroll
            for (int r = 0; r < 4; ++r) { s[r][0] = 0.f; s[r][1] = 0.f; }
#pragma unroll
            for (int m = 0; m < 2; ++m)
#pragma unroll
                for (int d8 = 0; d8 < 8; ++d8) {
                    const uint4 kv = *(const uint4*)(kr + m * 64 + d8 * 8);
                    const float k0 = bflo(kv.x), k1 = bfhi(kv.x), k2 = bflo(kv.y), k3 = bfhi(kv.y), k4 = bflo(kv.z), k5 = bfhi(kv.z), k6 = bflo(kv.w), k7 = bfhi(kv.w);
#pragma unroll
                    for (int r = 0; r < 4; ++r) { const float* qq = qs + r * 128 + m * 64 + d8 * 8;
                        s[r][m] += qq[0] * k0 + qq[1] * k1 + qq[2] * k2 + qq[3] * k3 + qq[4] * k4 + qq[5] * k5 + qq[6] * k6 + qq[7] * k7; }
                }
#pragma unroll
            for (int r = 0; r < 4; ++r) { S[(r * 2 + 0) * SKV + j] = s[r][0] * 0.125f; S[(r * 2 + 1) * SKV + j] = s[r][1] * 0.125f; }
        }
        __syncthreads();
        {
            float* sr = S + c.wave * SKV; float mx = -3.0e38f;
            for (int j = c.lane; j < SKV; j += 64) mx = fmaxf(mx, sr[j]);
            mx = wave_max(mx); float sum = 0.f;
            for (int j = c.lane; j < SKV; j += 64) { const float e = __expf(sr[j] - mx); sr[j] = e; sum += e; }
            sum = wave_sum(sum);
            if (c.lane == 0) st[c.wave] = 1.f / sum;
        }
        __syncthreads();
        for (int i = c.tid; i < 4 * SKV; i += 512) { const int r = i / SKV, j = i % SKV;
            S[(r * 2) * SKV + j] = S[(r * 2) * SKV + j] * st[r * 2] - lam * S[(r * 2 + 1) * SKV + j] * st[r * 2 + 1]; }
        __syncthreads();
        const int r = c.tid >> 7, d = c.tid & 127;
        float o = 0.f;
        { const float* ar = S + (r * 2) * SKV; const bf16_t* vp = Vb + (size_t)b * SKV * AW + h * 128 + d;
          for (int j = 0; j < SKV; ++j) o = fmaf(ar[j], bf2f(vp[(size_t)j * AW]), o); }
        const float sq = wave_sum(o * o);
        if (c.lane == 0) st[16 + c.wave] = sq;
        __syncthreads();
        const float tot = st[16 + 2 * r] + st[16 + 2 * r + 1];
        const float rs = rsqrtf(tot * (1.f / 128.f) + EPS);
        ATT[(size_t)(row0 + r) * DM + h * 128 + d] = (bf16_t)f2bf(o * rs * a.in[I_GSUBLN][d] * (1.f - LAM_INIT));
        __syncthreads();
    }
}
__device__ __forceinline__ void ph_pool_naive(const Args& a, const Ctx& c) {
    const bf16_t* P = (const bf16_t*)(a.ws + WS_P); bf16_t* ATT = (bf16_t*)(a.ws + WS_ATT);
    float* pd = (float*)c.lds;
    for (int row = c.blk; row < T; row += c.G) {
        const int b = row / NSEQ, n = row % NSEQ, ch = c.tid, g = ch >> 7, w = 2 << g;
        int lo = n - w / 2; if (lo < 0) lo = 0; int hi = n + (w - w / 2); if (hi > NSEQ) hi = NSEQ;
        float s = 0.f;
        for (int j = lo; j < hi; ++j) s += bf2f(P[(size_t)(b * NSEQ + j) * PW + ch]);
        pd[ch] = s / (float)(hi - lo) - bf2f(P[(size_t)row * PW + ch]);
        __syncthreads();
        const int e = ch & 127; float acc = 0.f;
        const float* wp = a.in[I_WPOOL] + (size_t)g * 128 * 128 + e;
        for (int cc = 0; cc < 128; ++cc) acc = fmaf(pd[g * 128 + cc], wp[cc * 128], acc);
        ATT[(size_t)row * DM + 512 + ch] = (bf16_t)f2bf((acc + a.in[I_BPOOL][ch]) * a.in[I_PSCALE][ch]);
        __syncthreads();
    }
}

__device__ __forceinline__ void ph_norm_router(const Args& a, const Ctx& c) {
    const bf16_t* YX = (const bf16_t*)(a.ws + WS_YX); bf16_t* HX2 = (bf16_t*)(a.ws + WS_HX);
    const float* MODS = (const float*)(a.ws + WS_MODS);
    int* TOPE = (int*)(a.ws + WS_TOPE); float* TOPW = (float*)(a.ws + WS_TOPW); int* BLKCNT = (int*)(a.ws + WS_BLKCNT);
    float* hrow = (float*)(c.lds + c.wave * 4096);
    int* hist = (int*)(c.lds + 8 * 4096);
    const float* wr = a.in[I_WROUTER];
    for (int vb = c.blk; vb < NVB; vb += c.G) {
        if (c.tid < 64) hist[c.tid] = 0;
        __syncthreads();
        for (int i = 0; i < 8; ++i) {
            const int t = vb * 64 + c.wave * 8 + i, b = t / NSEQ;
            const float* md = MODS + (size_t)b * 6144;
            float v[16]; float ss = 0.f;
#pragma unroll
            for (int j = 0; j < 4; ++j) { const uint2 w = *(const uint2*)(YX + (size_t)t * DM + 4 * c.lane + 256 * j);
                v[4 * j] = bflo(w.x); v[4 * j + 1] = bfhi(w.x); v[4 * j + 2] = bflo(w.y); v[4 * j + 3] = bfhi(w.y); }
#pragma unroll
            for (int j = 0; j < 16; ++j) ss += v[j] * v[j];
            const float r1 = rsqrtf(wave_sum(ss) * (1.f / DM) + EPS);
            float ss2 = 0.f;
#pragma unroll
            for (int j = 0; j < 4; ++j) {
                const int col = 4 * c.lane + 256 * j;
                const float4 xv = *(const float4*)(a.in[I_X] + (size_t)t * DM + col), gp = *(const float4*)(a.in[I_GPOSTMIX] + col), ga = *(const float4*)(md + 2048 + col);
                float4 x1; x1.x = xv.x + ga.x * (v[4 * j] * r1 * gp.x); x1.y = xv.y + ga.y * (v[4 * j + 1] * r1 * gp.y);
                x1.z = xv.z + ga.z * (v[4 * j + 2] * r1 * gp.z); x1.w = xv.w + ga.w * (v[4 * j + 3] * r1 * gp.w);
                *(float4*)(a.out + (size_t)t * DM + col) = x1;
                v[4 * j] = x1.x; v[4 * j + 1] = x1.y; v[4 * j + 2] = x1.z; v[4 * j + 3] = x1.w;
                ss2 += x1.x * x1.x + x1.y * x1.y + x1.z * x1.z + x1.w * x1.w;
            }
            const float r2 = rsqrtf(wave_sum(ss2) * (1.f / DM) + EPS);
#pragma unroll
            for (int j = 0; j < 4; ++j) {
                const int col = 4 * c.lane + 256 * j;
                const float4 g = *(const float4*)(a.in[I_GPREFFN] + col), sh = *(const float4*)(md + 3072 + col), sc = *(const float4*)(md + 4096 + col);
                float4 hv; hv.x = v[4 * j] * r2 * g.x * (1.f + sc.x) + sh.x; hv.y = v[4 * j + 1] * r2 * g.y * (1.f + sc.y) + sh.y;
                hv.z = v[4 * j + 2] * r2 * g.z * (1.f + sc.z) + sh.z; hv.w = v[4 * j + 3] * r2 * g.w * (1.f + sc.w) + sh.w;
                uint2 w; w.x = pk2(hv.x, hv.y); w.y = pk2(hv.z, hv.w);
                *(uint2*)(HX2 + (size_t)t * DM + col) = w;
                *(float4*)(hrow + col) = hv;
            }
            asm volatile("s_waitcnt lgkmcnt(0)" ::: "memory");
            float lg0 = 0.f, lg1 = 0.f;
            for (int k = 0; k < DM; k += 4) {
                const float4 hv = *(const float4*)(hrow + k);
                lg0 = fmaf(hv.x, wr[(size_t)(k + 0) * NE + c.lane], lg0); lg1 = fmaf(hv.y, wr[(size_t)(k + 1) * NE + c.lane], lg1);
                lg0 = fmaf(hv.z, wr[(size_t)(k + 2) * NE + c.lane], lg0); lg1 = fmaf(hv.w, wr[(size_t)(k + 3) * NE + c.lane], lg1);
            }
            const float score = 1.f / (1.f + expf(-(lg0 + lg1)));
            const float biased = score + a.in[I_RBIAS][c.lane];
            int grank = 0;
#pragma unroll
            for (int j = 0; j < 8; ++j) { const float vj = __shfl(biased, (c.lane & ~7) + j); grank += (vj > biased || (vj == biased && j < (c.lane & 7))) ? 1 : 0; }
            float gs = (grank < 2) ? biased : 0.f;
            gs += __shfl_xor(gs, 1); gs += __shfl_xor(gs, 2); gs += __shfl_xor(gs, 4);
            int gr = 0; const int myg = c.lane >> 3;
#pragma unroll
            for (int g = 0; g < 8; ++g) { const float sg = __shfl(gs, g * 8); gr += (sg > gs || (sg == gs && g < myg)) ? 1 : 0; }
            const float masked = (gr < 4) ? biased : -INFINITY;
            int cnt = 0;
#pragma unroll
            for (int j = 0; j < 64; ++j) { const float vj = __shfl(masked, j); cnt += (vj > masked || (vj == masked && j < c.lane)) ? 1 : 0; }
            const bool sel = cnt < TOPK;
            const float ssum = wave_sum(sel ? score : 0.f);
            if (sel) {
                const int lr = atomicAdd(&hist[c.lane], 1);
                TOPE[t * 8 + cnt] = c.lane | (lr << 8);
                TOPW[t * 8 + cnt] = score / ssum * 2.5f;
            }
        }
        __syncthreads();
        if (c.tid < 64) BLKCNT[vb * 64 + c.tid] = hist[c.tid];
        __syncthreads();
    }
}

__device__ __forceinline__ void ph_tables(const Args& a, const Ctx& c) {
    const int* BLKCNT = (const int*)(a.ws + WS_BLKCNT); const int* TOPE = (const int*)(a.ws + WS_TOPE); const float* TOPW = (const float*)(a.ws + WS_TOPW);
    int* SEG = (int*)(a.ws + WS_SEG); int* TOKSLOT = (int*)(a.ws + WS_TOKSLOT); int* SLOTTOK = (int*)(a.ws + WS_SLOTTOK); float* SLOTW = (float*)(a.ws + WS_SLOTW); int* SLOTE = (int*)(a.ws + WS_SLOTE);
    int* psum = (int*)c.lds;
    int* segstart = psum + 512;
    int* segcnt = segstart + 128;
    int* base = segcnt + 128;
    { const int e = c.tid & 63, p = c.tid >> 6; int s = 0;
      for (int v = 0; v < 32; ++v) s += BLKCNT[(p * 32 + v) * 64 + e];
      psum[p * 64 + e] = s; }
    __syncthreads();
    if (c.tid < 128) { const int h = c.tid >> 6, e = c.tid & 63;
        segcnt[c.tid] = psum[(h * 4 + 0) * 64 + e] + psum[(h * 4 + 1) * 64 + e] + psum[(h * 4 + 2) * 64 + e] + psum[(h * 4 + 3) * 64 + e]; }
    __syncthreads();
    if (c.tid < 128) { const int h = c.tid >> 6, e = c.tid & 63; int s = h * (NSLOT_R / 2);
        for (int e2 = 0; e2 < e; ++e2) s += segcnt[h * 64 + e2];
        segstart[c.tid] = s; }
    __syncthreads();
    if (c.blk == 0) {
        if (c.tid < 128) { const int h = c.tid >> 6, e = c.tid & 63; SEG[(h * 65 + e) * 2] = segstart[c.tid]; SEG[(h * 65 + e) * 2 + 1] = segcnt[c.tid]; }
        if (c.tid < 2) { SEG[(c.tid * 65 + 64) * 2] = NSLOT_R + HALF_T * c.tid; SEG[(c.tid * 65 + 64) * 2 + 1] = HALF_T; }
    }
    for (int vb = c.blk; vb < NVB; vb += c.G) {
        if (c.tid < 64) { const int e = c.tid, h = vb >> 7, p = vb >> 5; int s = segstart[h * 64 + e];
            for (int p2 = h * 4; p2 < p; ++p2) s += psum[p2 * 64 + e];
            for (int v = p * 32; v < vb; ++v) s += BLKCNT[v * 64 + e];
            base[e] = s; }
        __syncthreads();
        { const int t = vb * 64 + (c.tid >> 3), k = c.tid & 7; const int pe = TOPE[t * 8 + k], e = pe & 255, lr = pe >> 8;
          const int slot = base[e] + lr;
          SLOTTOK[slot] = t; SLOTW[slot] = TOPW[t * 8 + k]; SLOTE[slot] = e; TOKSLOT[t * 8 + k] = slot; }
        __syncthreads();
    }
}

__device__ __forceinline__ void ph_gateup_naive(const Args& a, const Ctx& c) {
    const bf16_t* HX2 = (const bf16_t*)(a.ws + WS_HX); const bf16_t* WGU = (const bf16_t*)(a.ws + WS_WGU); bf16_t* ACT = (bf16_t*)(a.ws + WS_ACT);
    const int* SLOTTOK = (const int*)(a.ws + WS_SLOTTOK); const float* SLOTW = (const float*)(a.ws + WS_SLOTW); const int* SLOTE = (const int*)(a.ws + WS_SLOTE);
    const size_t total = (size_t)NSLOT * FF;
    for (size_t idx = (size_t)c.blk * 512 + c.tid; idx < total; idx += (size_t)c.G * 512) {
        const int s = (int)(idx >> 8), f = (int)(idx & 255);
        int tok, e; float w;
        if (s < NSLOT_R) { tok = SLOTTOK[s]; e = SLOTE[s]; w = SLOTW[s]; } else { tok = s - NSLOT_R; e = 64; w = 1.f; }
        const int rg = 256 * (f >> 7) + (f & 127);
        const bf16_t* xr = HX2 + (size_t)tok * DM; const bf16_t* wb = WGU + ((size_t)e * 512 + rg) * DM;
        const float g = ndot(xr, wb, DM), u = ndot(xr, wb + (size_t)128 * DM, DM);
        ACT[idx] = (bf16_t)f2bf(silu_f(g) * u * w);
    }
}
__device__ __forceinline__ void ph_down_naive(const Args& a, const Ctx& c, int h) {
    const bf16_t* ACT = (const bf16_t*)(a.ws + WS_ACT); const bf16_t* WD = (const bf16_t*)(a.ws + WS_WD); bf16_t* Y = (bf16_t*)(a.ws + WS_Y);
    const int* SLOTE = (const int*)(a.ws + WS_SLOTE);
    const size_t total = (size_t)YROWS * DM;
    for (size_t idx = (size_t)c.blk * 512 + c.tid; idx < total; idx += (size_t)c.G * 512) {
        const int r = (int)(idx >> 10), j = (int)(idx & 1023);
        int s, e;
        if (r < NSLOT_R / 2) { s = h * (NSLOT_R / 2) + r; e = SLOTE[s]; } else { s = NSLOT_R + h * HALF_T + (r - NSLOT_R / 2); e = 64; }
        Y[idx] = (bf16_t)f2bf(ndot(ACT + (size_t)s * FF, WD + ((size_t)e * DM + j) * FF, FF));
    }
}
__device__ __forceinline__ void ph_combine(const Args& a, const Ctx& c, int h) {
    const bf16_t* Y = (const bf16_t*)(a.ws + WS_Y); const int* TOKSLOT = (const int*)(a.ws + WS_TOKSLOT); const float* MODS = (const float*)(a.ws + WS_MODS);
    const int gw = c.blk * 8 + c.wave, NGW = c.G * 8;
    for (int i = gw; i < HALF_T; i += NGW) {
        const int t = h * HALF_T + i, b = t / NSEQ;
        float v[16];
#pragma unroll
        for (int j = 0; j < 16; ++j) v[j] = 0.f;
#pragma unroll
        for (int k = 0; k < 9; ++k) {
            const int r = (k < 8) ? (TOKSLOT[t * 8 + k] - h * (NSLOT_R / 2)) : (NSLOT_R / 2 + i);
#pragma unroll
            for (int j = 0; j < 4; ++j) { const uint2 w = *(const uint2*)(Y + (size_t)r * DM + 4 * c.lane + 256 * j);
                v[4 * j] += bflo(w.x); v[4 * j + 1] += bfhi(w.x); v[4 * j + 2] += bflo(w.y); v[4 * j + 3] += bfhi(w.y); }
        }
        float ss = 0.f;
#pragma unroll
        for (int j = 0; j < 16; ++j) ss += v[j] * v[j];
        const float rs = rsqrtf(wave_sum(ss) * (1.f / DM) + EPS);
        const float* md = MODS + (size_t)b * 6144 + 5120;
#pragma unroll
        for (int j = 0; j < 4; ++j) {
            const int col = 4 * c.lane + 256 * j;
            float4 x1 = *(const float4*)(a.out + (size_t)t * DM + col); const float4 g = *(const float4*)(a.in[I_GPOSTFFN] + col), gf = *(const float4*)(md + col);
            x1.x += gf.x * (v[4 * j] * rs * g.x); x1.y += gf.y * (v[4 * j + 1] * rs * g.y); x1.z += gf.z * (v[4 * j + 2] * rs * g.z); x1.w += gf.w * (v[4 * j + 3] * rs * g.w);
            *(float4*)(a.out + (size_t)t * DM + col) = x1;
        }
    }
}

constexpr int NPHASE = 13;
__global__ void __launch_bounds__(512, 2) mega(Args a) {
    extern __shared__ __attribute__((aligned(16))) unsigned char lds[];
    Ctx c; c.tid = threadIdx.x; c.lane = c.tid & 63; c.wave = __builtin_amdgcn_readfirstlane(c.tid >> 6); c.blk = blockIdx.x; c.G = gridDim.x; c.lds = lds;
    volatile LAS unsigned* MISC = (volatile LAS unsigned*)((LAS unsigned char*)lds + MISC_OFF);
    for (int u = c.tid; u < (LDS_BYTES - LDSCTL_OFF) / 4; u += 512) ((LAS unsigned*)((LAS unsigned char*)lds + LDSCTL_OFF))[u] = 0u;
    __syncthreads();
    XcdBarrier bar; bar.bar = (unsigned*)(a.ws + WS_CTL); bar.x = 0; bar.st = nullptr;
    const bool multi = (a.ph_hi - a.ph_lo) > 1;
    if (multi) bar = xcd_barrier_post((unsigned*)(a.ws + WS_CTL), MISC + 8);
    for (int ph = a.ph_lo; ph < a.ph_hi; ++ph) {
        { int t_ = threadIdx.x; asm volatile("" : "+v"(t_));
          c.tid = t_; c.lane = t_ & 63; c.wave = __builtin_amdgcn_readfirstlane(t_ >> 6); }
        switch (ph) {
            case 0: ph_adaln(a, c); break;
            case 1: ph_prep(a, c); break;
            case 2: naive_gemm((const bf16_t*)(a.ws + WS_HX), (const bf16_t*)(a.ws + WS_WIN), (bf16_t*)(a.ws + WS_PXB), TT, INW, DM, c); break;
            case 3: ph_rope_scatter(a, c); break;
            case 4: ph_attn_naive(a, c); __syncthreads(); ph_pool_naive(a, c); break;
            case 5: naive_gemm((const bf16_t*)(a.ws + WS_ATT), (const bf16_t*)(a.ws + WS_WOUT), (bf16_t*)(a.ws + WS_YX), T, DM, DM, c); break;
            case 6: ph_norm_router(a, c); break;
            case 7: ph_tables(a, c); break;
            case 8: ph_gateup_naive(a, c); break;
            case 9: ph_down_naive(a, c, 0); break;
            case 10: ph_combine(a, c, 0); break;
            case 11: ph_down_naive(a, c, 1); break;
            case 12: ph_combine(a, c, 1); break;
            default: break;
        }
        if (ph + 1 < a.ph_hi) xcd_barrier(bar);
    }
}

extern "C" void kernel_launch(void* const* d_in, const int* in_sizes, int n_in, void* d_out, int out_size, void* d_ws, size_t ws_size, hipStream_t stream) {
    static int grid = 0;
    if (grid == 0) {
        if (n_in != 28 || in_sizes[0] != T * DM || out_size != T * DM || ws_size < WS_END) {
            fprintf(stderr, "kernel_launch: unexpected shapes or workspace: n_in %d in0 %d out %d ws %zu (need %zu)\n", n_in, n_in > 0 ? in_sizes[0] : -1, out_size, ws_size, (size_t)WS_END);
            grid = -1; return; }
        int dev = 0, cus = 0;
        if (hipGetDevice(&dev) != hipSuccess || hipDeviceGetAttribute(&cus, hipDeviceAttributeMultiprocessorCount, dev) != hipSuccess) { grid = -1; return; }
        if (hipFuncSetAttribute((const void*)mega, hipFuncAttributeMaxDynamicSharedMemorySize, LDS_BYTES) != hipSuccess) { fprintf(stderr, "kernel_launch: hipFuncSetAttribute failed\n"); grid = -1; return; }
        grid = cus;
    }
    if (grid < 0) return;
    (void)hipMemsetAsync((char*)d_ws + WS_CTL, 0, CTL_ZERO_BYTES, stream);
    Args a{};
    for (int i = 0; i < 28; ++i) a.in[i] = (const float*)d_in[i];
    a.out = (float*)d_out; a.ws = (unsigned char*)d_ws;
#if MK_PER_PHASE_LAUNCH
    for (int p = 0; p < NPHASE; ++p) { a.ph_lo = p; a.ph_hi = p + 1; hipLaunchKernelGGL(mega, dim3(grid), dim3(512), LDS_BYTES, stream, a); }
#else
    a.ph_lo = 0; a.ph_hi = NPHASE; hipLaunchKernelGGL(mega, dim3(grid), dim3(512), LDS_BYTES, stream, a);
#endif
    const hipError_t le = hipPeekAtLastError();
    if (le != hipSuccess) fprintf(stderr, "kernel_launch: launch failed: %s\n", hipGetErrorName(le));
}
```

```cpp
#include <hip/hip_runtime.h>
#include <cstdio>
#include <cstdint>

#ifndef FAST_INPROJ
#define FAST_INPROJ 1
#endif
#ifndef FAST_OUTPROJ
#define FAST_OUTPROJ 1
#endif
#ifndef FAST_GATEUP
#define FAST_GATEUP 1
#endif
#ifndef FAST_DOWN
#define FAST_DOWN 1
#endif
#ifndef MK_PER_PHASE_LAUNCH
#define MK_PER_PHASE_LAUNCH 0
#endif

constexpr int NB = 4, NSEQ = 4096, DM = 1024, T = NB * NSEQ, CTXL = 256, TC = NB * CTXL, TT = T + TC;
constexpr int NH = 4, DQK = 64, DV = 128, AW = 512, INW = 2048, PW = 512;
constexpr int SKV = CTXL + NSEQ;
constexpr int NE = 64, FF = 256, TOPK = 8;
constexpr int HALF_T = T / 2;
constexpr int NSLOT_R = T * TOPK;
constexpr int NSLOT = NSLOT_R + T;
constexpr int YROWS = HALF_T * (TOPK + 1);
constexpr float EPS = 1e-6f;
constexpr float LAM_INIT = 0.2f;
constexpr int NVB = 256;

typedef unsigned short bf16_t;
typedef unsigned int u32;

constexpr size_t KiB = 1024, MiB = 1024 * 1024;
constexpr size_t WS_CTL = 0;
constexpr size_t CTL_ZERO_BYTES = 64 * KiB;
constexpr size_t WS_MODS = 64 * KiB;
constexpr size_t WS_LAM = 192 * KiB;
constexpr size_t WS_ROPE = 196 * KiB;
constexpr size_t WS_SEG = 208 * KiB;
constexpr size_t WS_BLKCNT = 256 * KiB;
constexpr size_t WS_TOPE = 512 * KiB;
constexpr size_t WS_TOPW = 1 * MiB;
constexpr size_t WS_TOKSLOT = 1 * MiB + 512 * KiB;
constexpr size_t WS_SLOTTOK = 2 * MiB;
constexpr size_t WS_SLOTW = 2 * MiB + 512 * KiB;
constexpr size_t WS_SLOTE = 3 * MiB;
constexpr size_t WS_WD = 4 * MiB;
constexpr size_t WS_WGU = WS_WD + 33280 * KiB;
constexpr size_t WS_HX = WS_WGU + 65 * MiB;
constexpr size_t WS_WIN = WS_HX + 34 * MiB;
constexpr size_t WS_WOUT = WS_WIN + 4 * MiB;
constexpr size_t WS_Q = WS_WOUT + 2 * MiB;
constexpr size_t WS_K = WS_Q + 16 * MiB;
constexpr size_t WS_V = WS_K + 17 * MiB;
constexpr size_t WS_P = WS_V + 17 * MiB;
constexpr size_t WS_ATT = WS_P + 16 * MiB;
constexpr size_t WS_YX = WS_ATT + 32 * MiB;
constexpr size_t WS_PXB = WS_ATT;
constexpr size_t WS_ACT = 227 * MiB + 256 * KiB;
constexpr size_t WS_Y = WS_WGU;
constexpr size_t WS_END = WS_ACT + (size_t)(NSLOT + 256) * FF * 2;
static_assert(WS_YX + 32 * MiB <= WS_END + 64 * MiB, "map");
static_assert(WS_Y + (size_t)(YROWS + 256) * DM * 2 <= WS_ACT, "Y must not reach ACT");
static_assert(WS_PXB + (size_t)TT * INW * 2 <= WS_END, "PXB fits");

constexpr int LDS_BYTES = 147456;
constexpr int LDS_MAIN = 140 * 1024;
constexpr int LDSCTL_OFF = LDS_MAIN;
constexpr int MISC_OFF = LDSCTL_OFF + 320;

#define GAS __attribute__((address_space(1)))
#define LAS __attribute__((address_space(3)))

__device__ __forceinline__ u32 f2bf(float f) { u32 u = __float_as_uint(f); return (u + 0x7fffu + ((u >> 16) & 1u)) >> 16; }
__device__ __forceinline__ u32 pk2(float lo, float hi) { return f2bf(lo) | (f2bf(hi) << 16); }
__device__ __forceinline__ float bflo(u32 w) { return __uint_as_float(w << 16); }
__device__ __forceinline__ float bfhi(u32 w) { return __uint_as_float(w & 0xffff0000u); }
__device__ __forceinline__ float bf2f(bf16_t b) { return __uint_as_float(((u32)b) << 16); }
__device__ __forceinline__ float shx(float v, int m, int lane) { return __int_as_float(__builtin_amdgcn_ds_bpermute((lane ^ m) << 2, __float_as_int(v))); }
__device__ __forceinline__ float shl(float v, int src) { return __int_as_float(__builtin_amdgcn_ds_bpermute(src << 2, __float_as_int(v))); }
__device__ __forceinline__ float wave_sum(float v, int lane) {
#pragma unroll
    for (int o = 1; o < 64; o <<= 1) v += shx(v, o, lane);
    return v;
}
__device__ __forceinline__ float wave_max(float v, int lane) {
#pragma unroll
    for (int o = 1; o < 64; o <<= 1) v = fmaxf(v, shx(v, o, lane));
    return v;
}
__device__ __forceinline__ float silu_f(float v) { return v / (1.f + __expf(-v)); }
__device__ __forceinline__ float dot8(uint4 a, uint4 b, float acc) {
    acc = fmaf(bflo(a.x), bflo(b.x), acc); acc = fmaf(bfhi(a.x), bfhi(b.x), acc);
    acc = fmaf(bflo(a.y), bflo(b.y), acc); acc = fmaf(bfhi(a.y), bfhi(b.y), acc);
    acc = fmaf(bflo(a.z), bflo(b.z), acc); acc = fmaf(bfhi(a.z), bfhi(b.z), acc);
    acc = fmaf(bflo(a.w), bflo(b.w), acc); acc = fmaf(bfhi(a.w), bfhi(b.w), acc);
    return acc;
}
__device__ __forceinline__ float ndot(const bf16_t* a, const bf16_t* b, int K) {
    float a0 = 0.f, a1 = 0.f;
    for (int k = 0; k < K; k += 16) {
        const uint4 x0 = *(const uint4*)(a + k), y0 = *(const uint4*)(b + k), x1 = *(const uint4*)(a + k + 8), y1 = *(const uint4*)(b + k + 8);
        a0 = dot8(x0, y0, a0); a1 = dot8(x1, y1, a1);
    }
    return a0 + a1;
}

#define XB_TMO      128
#define XB_XCNT(j)  (256  + 64 * (j))
#define XB_XSUB(j)  (1280 + 64 * (j))
#define XB_XGEN(j)  (2304 + 64 * (j))
#define XB_TOP      3328
#define XB_TOPGEN   3392
#define XCD_BAR_WORDS 3456
#define XB_SPIN_CAP (1u << 22)
__device__ __forceinline__ unsigned xb_ld(unsigned* p)              { return __hip_atomic_load(p, __ATOMIC_RELAXED, __HIP_MEMORY_SCOPE_AGENT); }
__device__ __forceinline__ unsigned xb_add(unsigned* p, unsigned v) { return __hip_atomic_fetch_add(p, v, __ATOMIC_RELAXED, __HIP_MEMORY_SCOPE_AGENT); }
__device__ __forceinline__ unsigned xb_xcc_id() { return (unsigned)__builtin_amdgcn_s_getreg((3 << 11) | 20) & 0xFu; }
#define XB_SPIN(cond, bar) do { unsigned _sp = 0; while (cond) { __builtin_amdgcn_s_sleep(1); \
    if ((++_sp & 255u) == 0u) { if (xb_ld(&(bar)[XB_TMO])) break; if (_sp > XB_SPIN_CAP) { atomicAdd(&(bar)[XB_TMO], 1u); break; } } } } while (0)
struct XcdBarrier { unsigned* bar; unsigned x; volatile LAS unsigned* st; };
__device__ __forceinline__ XcdBarrier xcd_barrier_post(unsigned* bar, volatile LAS unsigned* st) {
    XcdBarrier b; b.bar = bar; b.x = xb_xcc_id(); b.st = st;
    if (threadIdx.x == 0) (void)xb_add(&bar[XB_XCNT(b.x)], 1u);
    return b;
}
__device__ __forceinline__ void xcd_barrier_complete(unsigned* bar, unsigned x, unsigned& nloc, unsigned& nx) {
    const unsigned G = gridDim.x * gridDim.y * gridDim.z;
    unsigned sum, cnt, mine, sp = 0u;
    for (;;) {
        sum = 0u; cnt = 0u; mine = 0u;
#pragma unroll
        for (unsigned j = 0; j < 16; ++j) { const unsigned c = xb_ld(&bar[XB_XCNT(j)]); sum += c; cnt += (c > 0u) ? 1u : 0u; mine = (j == x) ? c : mine; }
        if (sum == G) break;
        __builtin_amdgcn_s_sleep(1);
        if ((++sp & 255u) == 0u) { if (xb_ld(&bar[XB_TMO])) break; if (sp > XB_SPIN_CAP) { atomicAdd(&bar[XB_TMO], 1u); break; } }
    }
    nloc = mine > 0u ? mine : 1u; nx = cnt > 0u ? cnt : 1u;
}
__device__ __forceinline__ void xcd_barrier(const XcdBarrier& b) {
    asm volatile("s_waitcnt vmcnt(0)" ::: "memory");
    __syncthreads();
    if (threadIdx.x == 0) {
        unsigned* bar = b.bar;
        __builtin_amdgcn_s_waitcnt(0);
        unsigned nloc = b.st[0], nx = b.st[1];
        if (nloc == 0u) { xcd_barrier_complete(bar, b.x, nloc, nx); b.st[0] = nloc; b.st[1] = nx; }
        const unsigned old = xb_add(&bar[XB_XSUB(b.x)], 1u);
        const unsigned gen = old / nloc;
        if (old + 1u == (gen + 1u) * nloc) {
            __builtin_amdgcn_fence(__ATOMIC_RELEASE, "agent");
            asm volatile("s_waitcnt vmcnt(0)" ::: "memory");
            const unsigned og = xb_add(&bar[XB_TOP], 1u);
            const unsigned tg = og / nx;
            if (og + 1u == (tg + 1u) * nx) xb_add(&bar[XB_TOPGEN], 1u);
            else XB_SPIN(xb_ld(&bar[XB_TOPGEN]) == tg, bar);
            __builtin_amdgcn_fence(__ATOMIC_ACQUIRE, "agent");
            xb_add(&bar[XB_XGEN(b.x)], 1u);
            asm volatile("s_waitcnt vmcnt(0)" ::: "memory");
        } else {
            XB_SPIN(xb_ld(&bar[XB_XGEN(b.x)]) == gen, bar);
            __builtin_amdgcn_fence(__ATOMIC_ACQUIRE, "agent");
            asm volatile("s_waitcnt vmcnt(0)" ::: "memory");
        }
    }
    __syncthreads();
}

struct Args {
    const float* in[28];
    float* out;
    unsigned char* ws;
    int ph_lo, ph_hi;
};
enum { I_X = 0, I_C, I_CTX, I_CCTX, I_WADA, I_BADA, I_GPREMIX, I_GPOSTMIX, I_GPREFFN, I_GPOSTFFN, I_WIN, I_LQ1, I_LK1, I_LQ2, I_LK2,
       I_GSUBLN, I_WPOOL, I_BPOOL, I_PSCALE, I_WOUT, I_WROUTER, I_RBIAS, I_WEG, I_WEU, I_WED, I_WSG, I_WSU, I_WSD };

typedef __attribute__((address_space(4))) const Args CArgs;
struct Ctx {
    int tid, lane, wave, blk, G;
    unsigned char* lds;
};

__device__ __forceinline__ void ph_adaln(CArgs& a, const Ctx& c) {
    float* MODS = (float*)(a.ws + WS_MODS);
    float* red = (float*)c.lds;
    const float* w_ada = a.in[I_WADA];
    for (int it = c.blk; it < 96; it += c.G) {
        const int j = it * 64 + c.lane;
        float acc[5] = {0.f, 0.f, 0.f, 0.f, 0.f};
        const int k0 = c.wave * 128;
        for (int k = k0; k < k0 + 128; ++k) {
            const float w = w_ada[(size_t)k * 6144 + j];
#pragma unroll
            for (int r = 0; r < 5; ++r) { const float cv = (r < 4) ? a.in[I_C][r * DM + k] : a.in[I_CCTX][k]; acc[r] = fmaf(silu_f(cv), w, acc[r]); }
        }
#pragma unroll
        for (int r = 0; r < 5; ++r) red[(c.wave * 5 + r) * 64 + c.lane] = acc[r];
        __syncthreads();
        if (c.tid < 320) {
            const int r = c.tid >> 6, l = c.tid & 63; float s = 0.f;
#pragma unroll
            for (int w = 0; w < 8; ++w) s += red[(w * 5 + r) * 64 + l];
            MODS[r * 6144 + it * 64 + l] = s + a.in[I_BADA][it * 64 + l];
        }
        __syncthreads();
    }
    if (c.blk == c.G - 1) {
        float* ROPE = (float*)(a.ws + WS_ROPE);
        for (int i = c.tid; i < 1024; i += 512) {
            const int pos = i >> 4, fi = i & 15;
            const float freq = powf(10000.f, -(float)fi / 16.f);
            const float ang = (float)pos * freq;
            ROPE[i * 2] = cosf(ang); ROPE[i * 2 + 1] = sinf(ang);
        }
        if (c.wave == 0) {
            const float s1 = wave_sum(a.in[I_LQ1][c.lane] * a.in[I_LK1][c.lane], c.lane);
            const float s2 = wave_sum(a.in[I_LQ2][c.lane] * a.in[I_LK2][c.lane], c.lane);
            if (c.lane == 0) *(float*)(a.ws + WS_LAM) = expf(s1) - expf(s2) + LAM_INIT;
        }
    }
}

__device__ __forceinline__ void transpose_item(const float* W, int K, int N, bf16_t* WT, int k0, int n0, int drow0, float* scr, int lane) {
#pragma unroll 8
    for (int i = 0; i < 32; ++i) { const int kk = 2 * i + (lane >> 5); scr[kk * 33 + (lane & 31)] = W[(size_t)(k0 + kk) * N + n0 + (lane & 31)]; }
    asm volatile("s_waitcnt lgkmcnt(0)" ::: "memory");
    const int cc = lane & 7;
#pragma unroll
    for (int j = 0; j < 4; ++j) { const int n = (lane >> 3) + 8 * j; const float* s = scr + (8 * cc) * 33 + n;
        uint4 o; o.x = pk2(s[0 * 33], s[1 * 33]); o.y = pk2(s[2 * 33], s[3 * 33]); o.z = pk2(s[4 * 33], s[5 * 33]); o.w = pk2(s[6 * 33], s[7 * 33]);
        *(uint4*)(WT + (size_t)(drow0 + n) * K + k0 + 8 * cc) = o; }
    asm volatile("s_waitcnt lgkmcnt(0)" ::: "memory");
}
__device__ __forceinline__ void ph_prep(CArgs& a, const Ctx& c) {
    float* scr = (float*)(c.lds + c.wave * 16384);
    const int gw = c.blk * 8 + c.wave, NGW = c.G * 8;
    constexpr int I_IN = 16 * 64, I_OUT = 16 * 32, I_G = 16 * 8, I_D = 4 * 32;
    constexpr int NIT = I_IN + I_OUT + 65 * (2 * I_G + I_D);
    bf16_t* WIN = (bf16_t*)(a.ws + WS_WIN); bf16_t* WOUT = (bf16_t*)(a.ws + WS_WOUT); bf16_t* WGU = (bf16_t*)(a.ws + WS_WGU); bf16_t* WD = (bf16_t*)(a.ws + WS_WD);
    for (int it = gw; it < NIT; it += NGW) {
        int r = it;
        if (r < I_IN) { const int kb = r / 64, nb = r % 64; transpose_item(a.in[I_WIN], DM, INW, WIN, kb * 64, nb * 32, nb * 32, scr, c.lane); continue; } r -= I_IN;
        if (r < I_OUT) { const int kb = r / 32, nb = r % 32; transpose_item(a.in[I_WOUT], DM, DM, WOUT, kb * 64, nb * 32, nb * 32, scr, c.lane); continue; } r -= I_OUT;
        const int e = r / (2 * I_G + I_D); r -= e * (2 * I_G + I_D);
        if (r < 2 * I_G) {
            const int up = r / I_G; r -= up * I_G; const int kb = r / 8, nb = r % 8, n0 = nb * 32;
            const float* src = (e < 64) ? a.in[up ? I_WEU : I_WEG] + (size_t)e * DM * FF : a.in[up ? I_WSU : I_WSG];
            transpose_item(src, DM, FF, WGU + (size_t)e * 512 * DM, kb * 64, n0, 256 * (n0 >> 7) + (n0 & 127) + (up ? 128 : 0), scr, c.lane);
        } else {
            r -= 2 * I_G; const int kb = r / 32, nb = r % 32;
            const float* src = (e < 64) ? a.in[I_WED] + (size_t)e * FF * DM : a.in[I_WSD];
            transpose_item(src, FF, DM, WD + (size_t)e * DM * FF, kb * 64, nb * 32, nb * 32, scr, c.lane);
        }
    }
    const float* MODS = (const float*)(a.ws + WS_MODS); bf16_t* HX = (bf16_t*)(a.ws + WS_HX);
    for (int m = gw; m < TT; m += NGW) {
        const float* xr = (m < T) ? a.in[I_X] + (size_t)m * DM : a.in[I_CTX] + (size_t)(m - T) * DM;
        const float* md = MODS + (size_t)((m < T) ? (m / NSEQ) : 4) * 6144;
        float4 v[4]; float ss = 0.f;
#pragma unroll
        for (int j = 0; j < 4; ++j) { v[j] = *(const float4*)(xr + 4 * c.lane + 256 * j); ss += v[j].x * v[j].x + v[j].y * v[j].y + v[j].z * v[j].z + v[j].w * v[j].w; }
        const float rs = rsqrtf(wave_sum(ss, c.lane) * (1.f / DM) + EPS);
#pragma unroll
        for (int j = 0; j < 4; ++j) {
            const int col = 4 * c.lane + 256 * j;
            const float4 g = *(const float4*)(a.in[I_GPREMIX] + col), sh = *(const float4*)(md + col), sc = *(const float4*)(md + 1024 + col);
            const float o0 = v[j].x * rs * g.x * (1.f + sc.x) + sh.x, o1 = v[j].y * rs * g.y * (1.f + sc.y) + sh.y;
            const float o2 = v[j].z * rs * g.z * (1.f + sc.z) + sh.z, o3 = v[j].w * rs * g.w * (1.f + sc.w) + sh.w;
            uint2 w; w.x = pk2(o0, o1); w.y = pk2(o2, o3);
            *(uint2*)(HX + (size_t)m * DM + col) = w;
        }
    }
}

__device__ __forceinline__ void naive_gemm(const bf16_t* A, const bf16_t* Bt, bf16_t* C, int M, int N, int K, const Ctx& c) {
    const size_t total = (size_t)M * N;
    for (size_t idx = (size_t)c.blk * 512 + c.tid; idx < total; idx += (size_t)c.G * 512) {
        const int row = (int)(idx / N), col = (int)(idx % N);
        C[idx] = (bf16_t)f2bf(ndot(A + (size_t)row * K, Bt + (size_t)col * K, K));
    }
}

__device__ __forceinline__ void ph_rope_scatter(CArgs& a, const Ctx& c) {
    const bf16_t* PXB = (const bf16_t*)(a.ws + WS_PXB); const float* ROPE = (const float*)(a.ws + WS_ROPE);
    bf16_t* Q = (bf16_t*)(a.ws + WS_Q); bf16_t* Kb = (bf16_t*)(a.ws + WS_K); bf16_t* Vb = (bf16_t*)(a.ws + WS_V); bf16_t* P = (bf16_t*)(a.ws + WS_P);
    const size_t total = (size_t)TT * INW;
    for (size_t idx = (size_t)c.blk * 512 + c.tid; idx < total; idx += (size_t)c.G * 512) {
        const int row = (int)(idx / INW), col = (int)(idx % INW);
        float v = bf2f(PXB[idx]);
        if (row < T) {
            const int b = row / NSEQ, n = row % NSEQ;
            if (col < 1024) {
                const int d = col & 63, half = d >> 5, dd = d & 31, fi = dd & 15;
                const int pos = half ? (n & 63) : (n >> 6);
                const float cs = ROPE[(pos * 16 + fi) * 2], sn = ROPE[(pos * 16 + fi) * 2 + 1];
                const float o = bf2f(PXB[(dd < 16) ? idx + 16 : idx - 16]);
                v = (dd < 16) ? v * cs - o * sn : v * cs + o * sn;
                if (col < 512) Q[(size_t)row * AW + col] = (bf16_t)f2bf(v);
                else Kb[((size_t)b * SKV + CTXL + n) * AW + (col - 512)] = (bf16_t)f2bf(v);
            } else if (col < 1536) Vb[((size_t)b * SKV + CTXL + n) * AW + (col - 1024)] = (bf16_t)f2bf(v);
            else P[(size_t)row * PW + (col - 1536)] = (bf16_t)f2bf(v);
        } else {
            const int b = (row - T) / CTXL, j = (row - T) % CTXL;
            if (col >= 512 && col < 1024) Kb[((size_t)b * SKV + j) * AW + (col - 512)] = (bf16_t)f2bf(v);
            else if (col >= 1024 && col < 1536) Vb[((size_t)b * SKV + j) * AW + (col - 1024)] = (bf16_t)f2bf(v);
        }
    }
}

__device__ __forceinline__ void ph_attn_naive(CArgs& a, const Ctx& c) {
    const bf16_t* Q = (const bf16_t*)(a.ws + WS_Q); const bf16_t* Kb = (const bf16_t*)(a.ws + WS_K); const bf16_t* Vb = (const bf16_t*)(a.ws + WS_V);
    bf16_t* ATT = (bf16_t*)(a.ws + WS_ATT);
    const float lam = *(const float*)(a.ws + WS_LAM);
    float* S = (float*)c.lds;
    float* qs = S + 8 * SKV;
    float* st = qs + 512;
    constexpr int NITEM = NB * NH * (NSEQ / 4);
    for (int it = c.blk; it < NITEM; it += c.G) {
        const int qg = it % (NSEQ / 4), h = (it / (NSEQ / 4)) % NH, b = it / (NSEQ / 4 * NH);
        const int row0 = b * NSEQ + qg * 4;
        { const int r = c.tid >> 7, d = c.tid & 127; qs[c.tid] = bf2f(Q[(size_t)(row0 + r) * AW + h * 128 + d]); }
        __syncthreads();
        for (int j = c.tid; j < SKV; j += 512) {
            const bf16_t* kr = Kb + ((size_t)b * SKV + j) * AW + h * 128;
            float s[4][2];
#pragma unroll
            for (int r = 0; r < 4; ++r) { s[r][0] = 0.f; s[r][1] = 0.f; }
#pragma unroll
            for (int m = 0; m < 2; ++m)
#pragma unroll
                for (int d8 = 0; d8 < 8; ++d8) {
                    const uint4 kv = *(const uint4*)(kr + m * 64 + d8 * 8);
                    const float k0 = bflo(kv.x), k1 = bfhi(kv.x), k2 = bflo(kv.y), k3 = bfhi(kv.y), k4 = bflo(kv.z), k5 = bfhi(kv.z), k6 = bflo(kv.w), k7 = bfhi(kv.w);
#pragma unroll
                    for (int r = 0; r < 4; ++r) { const float* qq = qs + r * 128 + m * 64 + d8 * 8;
                        s[r][m] += qq[0] * k0 + qq[1] * k1 + qq[2] * k2 + qq[3] * k3 + qq[4] * k4 + qq[5] * k5 + qq[6] * k6 + qq[7] * k7; }
                }
#pragma unroll
            for (int r = 0; r < 4; ++r) { S[(r * 2 + 0) * SKV + j] = s[r][0] * 0.125f; S[(r * 2 + 1) * SKV + j] = s[r][1] * 0.125f; }
        }
        __syncthreads();
        {
            float* sr = S + c.wave * SKV; float mx = -3.0e38f;
            for (int j = c.lane; j < SKV; j += 64) mx = fmaxf(mx, sr[j]);
            mx = wave_max(mx, c.lane); float sum = 0.f;
            for (int j = c.lane; j < SKV; j += 64) { const float e = __expf(sr[j] - mx); sr[j] = e; sum += e; }
            sum = wave_sum(sum, c.lane);
            if (c.lane == 0) st[c.wave] = 1.f / sum;
        }
        __syncthreads();
        for (int i = c.tid; i < 4 * SKV; i += 512) { const int r = i / SKV, j = i % SKV;
            S[(r * 2) * SKV + j] = S[(r * 2) * SKV + j] * st[r * 2] - lam * S[(r * 2 + 1) * SKV + j] * st[r * 2 + 1]; }
        __syncthreads();
        const int r = c.tid >> 7, d = c.tid & 127;
        float o = 0.f;
        { const float* ar = S + (r * 2) * SKV; const bf16_t* vp = Vb + (size_t)b * SKV * AW + h * 128 + d;
          for (int j = 0; j < SKV; ++j) o = fmaf(ar[j], bf2f(vp[(size_t)j * AW]), o); }
        const float sq = wave_sum(o * o, c.lane);
        if (c.lane == 0) st[16 + c.wave] = sq;
        __syncthreads();
        const float tot = st[16 + 2 * r] + st[16 + 2 * r + 1];
        const float rs = rsqrtf(tot * (1.f / 128.f) + EPS);
        ATT[(size_t)(row0 + r) * DM + h * 128 + d] = (bf16_t)f2bf(o * rs * a.in[I_GSUBLN][d] * (1.f - LAM_INIT));
        __syncthreads();
    }
}
__device__ __forceinline__ void ph_pool_naive(CArgs& a, const Ctx& c) {
    const bf16_t* P = (const bf16_t*)(a.ws + WS_P); bf16_t* ATT = (bf16_t*)(a.ws + WS_ATT);
    float* pd = (float*)c.lds;
    for (int row = c.blk; row < T; row += c.G) {
        const int b = row / NSEQ, n = row % NSEQ, ch = c.tid, g = ch >> 7, w = 2 << g;
        int lo = n - w / 2; if (lo < 0) lo = 0; int hi = n + (w - w / 2); if (hi > NSEQ) hi = NSEQ;
        float s = 0.f;
        for (int j = lo; j < hi; ++j) s += bf2f(P[(size_t)(b * NSEQ + j) * PW + ch]);
        pd[ch] = s / (float)(hi - lo) - bf2f(P[(size_t)row * PW + ch]);
        __syncthreads();
        const int e = ch & 127; float acc = 0.f;
        const float* wp = a.in[I_WPOOL] + (size_t)g * 128 * 128 + e;
        for (int cc = 0; cc < 128; ++cc) acc = fmaf(pd[g * 128 + cc], wp[cc * 128], acc);
        ATT[(size_t)row * DM + 512 + ch] = (bf16_t)f2bf((acc + a.in[I_BPOOL][ch]) * a.in[I_PSCALE][ch]);
        __syncthreads();
    }
}

__device__ __forceinline__ void ph_norm_router(CArgs& a, const Ctx& c) {
    const bf16_t* YX = (const bf16_t*)(a.ws + WS_YX); bf16_t* HX2 = (bf16_t*)(a.ws + WS_HX);
    const float* MODS = (const float*)(a.ws + WS_MODS);
    int* TOPE = (int*)(a.ws + WS_TOPE); float* TOPW = (float*)(a.ws + WS_TOPW); int* BLKCNT = (int*)(a.ws + WS_BLKCNT);
    float* hrow = (float*)(c.lds + c.wave * 4096);
    int* hist = (int*)(c.lds + 8 * 4096);
    const float* wr = a.in[I_WROUTER];
    for (int vb = c.blk; vb < NVB; vb += c.G) {
        if (c.tid < 64) hist[c.tid] = 0;
        __syncthreads();
        for (int i = 0; i < 8; ++i) {
            const int t = vb * 64 + c.wave * 8 + i, b = t / NSEQ;
            const float* md = MODS + (size_t)b * 6144;
            float v[16]; float ss = 0.f;
#pragma unroll
            for (int j = 0; j < 4; ++j) { const uint2 w = *(const uint2*)(YX + (size_t)t * DM + 4 * c.lane + 256 * j);
                v[4 * j] = bflo(w.x); v[4 * j + 1] = bfhi(w.x); v[4 * j + 2] = bflo(w.y); v[4 * j + 3] = bfhi(w.y); }
#pragma unroll
            for (int j = 0; j < 16; ++j) ss += v[j] * v[j];
            const float r1 = rsqrtf(wave_sum(ss, c.lane) * (1.f / DM) + EPS);
            float ss2 = 0.f;
#pragma unroll
            for (int j = 0; j < 4; ++j) {
                const int col = 4 * c.lane + 256 * j;
                const float4 xv = *(const float4*)(a.in[I_X] + (size_t)t * DM + col), gp = *(const float4*)(a.in[I_GPOSTMIX] + col), ga = *(const float4*)(md + 2048 + col);
                float4 x1; x1.x = xv.x + ga.x * (v[4 * j] * r1 * gp.x); x1.y = xv.y + ga.y * (v[4 * j + 1] * r1 * gp.y);
                x1.z = xv.z + ga.z * (v[4 * j + 2] * r1 * gp.z); x1.w = xv.w + ga.w * (v[4 * j + 3] * r1 * gp.w);
                *(float4*)(a.out + (size_t)t * DM + col) = x1;
                v[4 * j] = x1.x; v[4 * j + 1] = x1.y; v[4 * j + 2] = x1.z; v[4 * j + 3] = x1.w;
                ss2 += x1.x * x1.x + x1.y * x1.y + x1.z * x1.z + x1.w * x1.w;
            }
            const float r2 = rsqrtf(wave_sum(ss2, c.lane) * (1.f / DM) + EPS);
#pragma unroll
            for (int j = 0; j < 4; ++j) {
                const int col = 4 * c.lane + 256 * j;
                const float4 g = *(const float4*)(a.in[I_GPREFFN] + col), sh = *(const float4*)(md + 3072 + col), sc = *(const float4*)(md + 4096 + col);
                float4 hv; hv.x = v[4 * j] * r2 * g.x * (1.f + sc.x) + sh.x; hv.y = v[4 * j + 1] * r2 * g.y * (1.f + sc.y) + sh.y;
                hv.z = v[4 * j + 2] * r2 * g.z * (1.f + sc.z) + sh.z; hv.w = v[4 * j + 3] * r2 * g.w * (1.f + sc.w) + sh.w;
                uint2 w; w.x = pk2(hv.x, hv.y); w.y = pk2(hv.z, hv.w);
                *(uint2*)(HX2 + (size_t)t * DM + col) = w;
                *(float4*)(hrow + col) = hv;
            }
            asm volatile("s_waitcnt lgkmcnt(0)" ::: "memory");
            float lg0 = 0.f, lg1 = 0.f;
            for (int k = 0; k < DM; k += 4) {
                const float4 hv = *(const float4*)(hrow + k);
                lg0 = fmaf(hv.x, wr[(size_t)(k + 0) * NE + c.lane], lg0); lg1 = fmaf(hv.y, wr[(size_t)(k + 1) * NE + c.lane], lg1);
                lg0 = fmaf(hv.z, wr[(size_t)(k + 2) * NE + c.lane], lg0); lg1 = fmaf(hv.w, wr[(size_t)(k + 3) * NE + c.lane], lg1);
            }
            const float score = 1.f / (1.f + expf(-(lg0 + lg1)));
            const float biased = score + a.in[I_RBIAS][c.lane];
            int grank = 0;
#pragma unroll
            for (int j = 0; j < 8; ++j) { const float vj = shl(biased, (c.lane & ~7) + j); grank += (vj > biased || (vj == biased && j < (c.lane & 7))) ? 1 : 0; }
            float gs = (grank < 2) ? biased : 0.f;
            gs += shx(gs, 1, c.lane); gs += shx(gs, 2, c.lane); gs += shx(gs, 4, c.lane);
            int gr = 0; const int myg = c.lane >> 3;
#pragma unroll
            for (int g = 0; g < 8; ++g) { const float sg = __int_as_float(__builtin_amdgcn_readlane(__float_as_int(gs), g * 8)); gr += (sg > gs || (sg == gs && g < myg)) ? 1 : 0; }
            const float masked = (gr < 4) ? biased : -INFINITY;
            int cnt = 0;
#pragma unroll
            for (int j = 0; j < 64; ++j) { const float vj = __int_as_float(__builtin_amdgcn_readlane(__float_as_int(masked), j)); cnt += (vj > masked || (vj == masked && j < c.lane)) ? 1 : 0; }
            const bool sel = cnt < TOPK;
            const float ssum = wave_sum(sel ? score : 0.f, c.lane);
            if (sel) {
                const int lr = atomicAdd(&hist[c.lane], 1);
                TOPE[t * 8 + cnt] = c.lane | (lr << 8);
                TOPW[t * 8 + cnt] = score / ssum * 2.5f;
            }
        }
        __syncthreads();
        if (c.tid < 64) BLKCNT[vb * 64 + c.tid] = hist[c.tid];
        __syncthreads();
    }
}

__device__ __forceinline__ void ph_tables(CArgs& a, const Ctx& c) {
    const int* BLKCNT = (const int*)(a.ws + WS_BLKCNT); const int* TOPE = (const int*)(a.ws + WS_TOPE); const float* TOPW = (const float*)(a.ws + WS_TOPW);
    int* SEG = (int*)(a.ws + WS_SEG); int* TOKSLOT = (int*)(a.ws + WS_TOKSLOT); int* SLOTTOK = (int*)(a.ws + WS_SLOTTOK); float* SLOTW = (float*)(a.ws + WS_SLOTW); int* SLOTE = (int*)(a.ws + WS_SLOTE);
    int* psum = (int*)c.lds;
    int* segstart = psum + 512;
    int* segcnt = segstart + 128;
    int* base = segcnt + 128;
    { const int e = c.tid & 63, p = c.tid >> 6; int s = 0;
      for (int v = 0; v < 32; ++v) s += BLKCNT[(p * 32 + v) * 64 + e];
      psum[p * 64 + e] = s; }
    __syncthreads();
    if (c.tid < 128) { const int h = c.tid >> 6, e = c.tid & 63;
        segcnt[c.tid] = psum[(h * 4 + 0) * 64 + e] + psum[(h * 4 + 1) * 64 + e] + psum[(h * 4 + 2) * 64 + e] + psum[(h * 4 + 3) * 64 + e]; }
    __syncthreads();
    if (c.tid < 128) { const int h = c.tid >> 6, e = c.tid & 63; int s = h * (NSLOT_R / 2);
        for (int e2 = 0; e2 < e; ++e2) s += segcnt[h * 64 + e2];
        segstart[c.tid] = s; }
    __syncthreads();
    if (c.blk == 0) {
        if (c.tid < 128) { const int h = c.tid >> 6, e = c.tid & 63; SEG[(h * 65 + e) * 2] = segstart[c.tid]; SEG[(h * 65 + e) * 2 + 1] = segcnt[c.tid]; }
        if (c.tid < 2) { SEG[(c.tid * 65 + 64) * 2] = NSLOT_R + HALF_T * c.tid; SEG[(c.tid * 65 + 64) * 2 + 1] = HALF_T; }
    }
    for (int vb = c.blk; vb < NVB; vb += c.G) {
        if (c.tid < 64) { const int e = c.tid, h = vb >> 7, p = vb >> 5; int s = segstart[h * 64 + e];
            for (int p2 = h * 4; p2 < p; ++p2) s += psum[p2 * 64 + e];
            for (int v = p * 32; v < vb; ++v) s += BLKCNT[v * 64 + e];
            base[e] = s; }
        __syncthreads();
        { const int t = vb * 64 + (c.tid >> 3), k = c.tid & 7; const int pe = TOPE[t * 8 + k], e = pe & 255, lr = pe >> 8;
          const int slot = base[e] + lr;
          SLOTTOK[slot] = t; SLOTW[slot] = TOPW[t * 8 + k]; SLOTE[slot] = e; TOKSLOT[t * 8 + k] = slot; }
        __syncthreads();
    }
}

__device__ __forceinline__ void ph_gateup_naive(CArgs& a, const Ctx& c) {
    const bf16_t* HX2 = (const bf16_t*)(a.ws + WS_HX); const bf16_t* WGU = (const bf16_t*)(a.ws + WS_WGU); bf16_t* ACT = (bf16_t*)(a.ws + WS_ACT);
    const int* SLOTTOK = (const int*)(a.ws + WS_SLOTTOK); const float* SLOTW = (const float*)(a.ws + WS_SLOTW); const int* SLOTE = (const int*)(a.ws + WS_SLOTE);
    const size_t total = (size_t)NSLOT * FF;
    for (size_t idx = (size_t)c.blk * 512 + c.tid; idx < total; idx += (size_t)c.G * 512) {
        const int s = (int)(idx >> 8), f = (int)(idx & 255);
        int tok, e; float w;
        if (s < NSLOT_R) { tok = SLOTTOK[s]; e = SLOTE[s]; w = SLOTW[s]; } else { tok = s - NSLOT_R; e = 64; w = 1.f; }
        const int rg = 256 * (f >> 7) + (f & 127);
        const bf16_t* xr = HX2 + (size_t)tok * DM; const bf16_t* wb = WGU + ((size_t)e * 512 + rg) * DM;
        const float g = ndot(xr, wb, DM), u = ndot(xr, wb + (size_t)128 * DM, DM);
        ACT[idx] = (bf16_t)f2bf(silu_f(g) * u * w);
    }
}
__device__ __forceinline__ void ph_down_naive(CArgs& a, const Ctx& c, int h) {
    const bf16_t* ACT = (const bf16_t*)(a.ws + WS_ACT); const bf16_t* WD = (const bf16_t*)(a.ws + WS_WD); bf16_t* Y = (bf16_t*)(a.ws + WS_Y);
    const int* SLOTE = (const int*)(a.ws + WS_SLOTE);
    const size_t total = (size_t)YROWS * DM;
    for (size_t idx = (size_t)c.blk * 512 + c.tid; idx < total; idx += (size_t)c.G * 512) {
        const int r = (int)(idx >> 10), j = (int)(idx & 1023);
        int s, e;
        if (r < NSLOT_R / 2) { s = h * (NSLOT_R / 2) + r; e = SLOTE[s]; } else { s = NSLOT_R + h * HALF_T + (r - NSLOT_R / 2); e = 64; }
        Y[idx] = (bf16_t)f2bf(ndot(ACT + (size_t)s * FF, WD + ((size_t)e * DM + j) * FF, FF));
    }
}
__device__ __forceinline__ void ph_combine(CArgs& a, const Ctx& c, int h) {
    const bf16_t* Y = (const bf16_t*)(a.ws + WS_Y); const int* TOKSLOT = (const int*)(a.ws + WS_TOKSLOT); const float* MODS = (const float*)(a.ws + WS_MODS);
    const int gw = c.blk * 8 + c.wave, NGW = c.G * 8;
    for (int i = gw; i < HALF_T; i += NGW) {
        const int t = h * HALF_T + i, b = t / NSEQ;
        float v[16];
#pragma unroll
        for (int j = 0; j < 16; ++j) v[j] = 0.f;
#pragma unroll
        for (int k = 0; k < 9; ++k) {
            const int r = (k < 8) ? (TOKSLOT[t * 8 + k] - h * (NSLOT_R / 2)) : (NSLOT_R / 2 + i);
#pragma unroll
            for (int j = 0; j < 4; ++j) { const uint2 w = *(const uint2*)(Y + (size_t)r * DM + 4 * c.lane + 256 * j);
                v[4 * j] += bflo(w.x); v[4 * j + 1] += bfhi(w.x); v[4 * j + 2] += bflo(w.y); v[4 * j + 3] += bfhi(w.y); }
        }
        float ss = 0.f;
#pragma unroll
        for (int j = 0; j < 16; ++j) ss += v[j] * v[j];
        const float rs = rsqrtf(wave_sum(ss, c.lane) * (1.f / DM) + EPS);
        const float* md = MODS + (size_t)b * 6144 + 5120;
#pragma unroll
        for (int j = 0; j < 4; ++j) {
            const int col = 4 * c.lane + 256 * j;
            float4 x1 = *(const float4*)(a.out + (size_t)t * DM + col); const float4 g = *(const float4*)(a.in[I_GPOSTFFN] + col), gf = *(const float4*)(md + col);
            x1.x += gf.x * (v[4 * j] * rs * g.x); x1.y += gf.y * (v[4 * j + 1] * rs * g.y); x1.z += gf.z * (v[4 * j + 2] * rs * g.z); x1.w += gf.w * (v[4 * j + 3] * rs * g.w);
            *(float4*)(a.out + (size_t)t * DM + col) = x1;
        }
    }
}


constexpr int LDS_TAB = 128 * 1024;
constexpr int LDS_OAN = 132 * 1024;
namespace pg8 {
typedef short bf16x8 __attribute__((ext_vector_type(8)));
typedef float f32x4 __attribute__((ext_vector_type(4)));
typedef unsigned u32x4 __attribute__((ext_vector_type(4)));
typedef unsigned u32x2 __attribute__((ext_vector_type(2)));
constexpr int BM = 256, BK = 64, HALF = 128, HTB = HALF * BK * 2, STAGE_BYTES = 8 * HTB;
__device__ __forceinline__ int lds_byte(int r, int c) { const int st = (r >> 4) * 2 + (c >> 5), rr = r & 15, cc = c & 31, ob = rr * 64 + cc * 2; return st * 1024 + (ob ^ (((ob >> 9) & 1) << 5)); }
__device__ __forceinline__ void stage_rc(int b, int& R, int& C) { const int st = b / 1024, sb = b % 1024, swz = sb ^ (((sb >> 9) & 1) << 5); R = (st >> 1) * 16 + swz / 64; C = (st & 1) * 32 + (swz % 64) / 2; }
__device__ __forceinline__ int perm32(int rho) { const int n = rho >> 4, i = rho & 15; return 8 * (i >> 2) + 4 * n + (i & 3); }
__device__ __forceinline__ int xcd_remap(int L, int nwg) { const int q = nwg / 8, r = nwg % 8, xcd = L % 8, off = L / 8; return (xcd < r ? xcd * (q + 1) : r * (q + 1) + (xcd - r) * q) + off; }
__device__ __forceinline__ unsigned cvt_pk_bf16(float lo, float hi) { unsigned r; asm volatile("v_cvt_pk_bf16_f32 %0, %1, %2" : "=v"(r) : "v"(lo), "v"(hi)); return r; }

struct Unit { int row0, nvalid, pn, aux; };

template <class Epi, class Sched, bool ALIGN_EPI, int K>
__device__ __forceinline__ void gemm_phase(LAS unsigned char* lds, const Sched& S, const Epi& E, const int tid) {
    const int wid = __builtin_amdgcn_readfirstlane(tid >> 6), lane = tid & 63, wr = wid >> 2, wc = wid & 3, fr = lane & 15, fq = lane >> 4;
    constexpr int nt = K / BK;
    unsigned voffB[2];
#pragma unroll
    for (int i = 0; i < 2; ++i) { int R, C; stage_rc(tid * 16 + i * 8192, R, C); const int Rb = Epi::PERM ? ((R & ~31) + perm32(R & 31)) : R;
        voffB[i] = (unsigned)(Rb * K + C) * 2u; }
    LAS u32x4* const oAnL = (LAS u32x4*)(lds + LDS_OAN) + tid;
    const size_t kstep = (size_t)(BK * 2);
    const size_t hstepB = (size_t)HALF * K * 2;
    const unsigned ldsw = (unsigned)wid * 1024u;
    const int aoff = lds_byte(wr * 64 + fr, fq * 8), boff = lds_byte(wc * 32 + fr, fq * 8);
#define PG8_SA(b, h) (((b) * 2 + (h)) * HTB)
#define PG8_SB(b, h) ((4 + (b) * 2 + (h)) * HTB)
#define PG8_STAGE(bufoff, gbase, voff) do { _Pragma("unroll") for (int _i = 0; _i < 2; ++_i) \
        __builtin_amdgcn_global_load_lds((const unsigned*)((const char*)(gbase) + (voff)[_i]), (LAS unsigned*)(lds + (bufoff) + ldsw + _i * 8192), 16, 0, 0); } while (0)
#define PG8_LDA(dst, b, h) do { _Pragma("unroll") for (int m = 0; m < 4; ++m) _Pragma("unroll") for (int k = 0; k < 2; ++k) dst[m][k] = *(const LAS bf16x8*)(lds + PG8_SA(b, h) + aoff + m * 2048 + k * 1024); } while (0)
#define PG8_LDB(dst, b, h) do { _Pragma("unroll") for (int n = 0; n < 2; ++n) _Pragma("unroll") for (int k = 0; k < 2; ++k) dst[n][k] = *(const LAS bf16x8*)(lds + PG8_SB(b, h) + boff + n * 2048 + k * 1024); } while (0)
#define PG8_MMA(ai, bj, At, Bt) do { __builtin_amdgcn_s_setprio(1); _Pragma("unroll") for (int m = 0; m < 4; ++m) _Pragma("unroll") for (int n = 0; n < 2; ++n) _Pragma("unroll") for (int k = 0; k < 2; ++k) \
        acc[ai][bj][m][n] = __builtin_amdgcn_mfma_f32_16x16x32_bf16(Bt[n][k], At[m][k], acc[ai][bj][m][n], 0, 0, 0); __builtin_amdgcn_s_setprio(0); } while (0)
#define PG8_WAIT_V(n) asm volatile("s_waitcnt vmcnt(" #n ")" ::: "memory")
#define PG8_WAIT_L(n) asm volatile("s_waitcnt lgkmcnt(" #n ")" ::: "memory")
#define PG8_BAR __builtin_amdgcn_s_barrier()
#define PG8_SCHED __builtin_amdgcn_sched_barrier(0)
    Unit cur, nxt; int ui = 0;
    if (!S.next(0, cur)) return;
    f32x4 acc[2][2][4][2];
#pragma unroll
    for (int a = 0; a < 2; ++a)
#pragma unroll
        for (int b = 0; b < 2; ++b)
#pragma unroll
            for (int m = 0; m < 4; ++m)
#pragma unroll
                for (int n = 0; n < 2; ++n) acc[a][b][m][n] = (f32x4){0.f, 0.f, 0.f, 0.f};
    bf16x8 At[4][2], B0[2][2], B1[2][2];
    unsigned oAc[2][2];
    S.a_off(cur, tid, oAc);
    const char* const Ab = S.a_base();
    const char* cB = S.b_base(cur);
    PG8_STAGE(PG8_SB(0, 0), cB, voffB); PG8_STAGE(PG8_SB(0, 1), cB + hstepB, voffB); PG8_STAGE(PG8_SA(0, 0), Ab, oAc[0]); PG8_STAGE(PG8_SA(0, 1), Ab, oAc[1]);
    if (wr == 1) PG8_BAR;
    PG8_WAIT_V(2); PG8_BAR;
    PG8_STAGE(PG8_SB(1, 0), cB + kstep, voffB); PG8_STAGE(PG8_SA(1, 0), Ab + kstep, oAc[0]); PG8_STAGE(PG8_SB(1, 1), cB + hstepB + kstep, voffB);
    PG8_WAIT_V(6); PG8_BAR;
    for (;;) {
        const bool has_next = S.next(ui + 1, nxt);
        if (has_next) { unsigned t_[2][2]; S.a_off(nxt, tid, t_); *oAnL = (u32x4){t_[0][0], t_[0][1], t_[1][0], t_[1][1]}; }
        const char* nB = has_next ? S.b_base(nxt) : cB;
#pragma unroll 1
        for (int t = 0; t < nt; t += 2) {
            const bool last = (t == nt - 2);
            const char* a1 = Ab + (size_t)(t + 1) * kstep;
            const char* a2 = last ? Ab : Ab + (size_t)(t + 2) * kstep; const char* b2 = last ? nB : cB + (size_t)(t + 2) * kstep;
            const char* a3 = a2 + kstep; const char* b3 = b2 + kstep;
            PG8_LDB(B0, 0, 0); PG8_LDB(B1, 0, 1); PG8_SCHED; PG8_LDA(At, 0, 0); PG8_STAGE(PG8_SA(1, 1), a1, oAc[1]);
            if (last && has_next) { const u32x4 q = *oAnL; oAc[0][0] = q.x; oAc[0][1] = q.y; oAc[1][0] = q.z; oAc[1][1] = q.w; }
            PG8_WAIT_V(8); PG8_WAIT_L(0); PG8_BAR; PG8_MMA(0, 0, At, B0); PG8_MMA(0, 1, At, B1); PG8_BAR; PG8_SCHED;
            PG8_LDA(At, 0, 1); PG8_STAGE(PG8_SB(0, 0), b2, voffB); PG8_STAGE(PG8_SB(0, 1), b2 + hstepB, voffB); PG8_STAGE(PG8_SA(0, 0), a2, oAc[0]);
            PG8_WAIT_V(8); PG8_WAIT_L(0); PG8_BAR; PG8_MMA(1, 0, At, B0); PG8_MMA(1, 1, At, B1); PG8_BAR; PG8_SCHED;
            PG8_LDB(B0, 1, 0); PG8_LDB(B1, 1, 1); PG8_SCHED; PG8_LDA(At, 1, 0); PG8_STAGE(PG8_SA(0, 1), a2, oAc[1]);
            PG8_WAIT_V(8); PG8_WAIT_L(0); PG8_BAR; PG8_MMA(0, 0, At, B0); PG8_MMA(0, 1, At, B1); PG8_BAR; PG8_SCHED;
            PG8_LDA(At, 1, 1); PG8_STAGE(PG8_SB(1, 0), b3, voffB); PG8_STAGE(PG8_SB(1, 1), b3 + hstepB, voffB); PG8_STAGE(PG8_SA(1, 0), a3, oAc[0]);
            PG8_WAIT_V(8); PG8_WAIT_L(0); PG8_BAR; PG8_MMA(1, 0, At, B0); PG8_MMA(1, 1, At, B1); PG8_BAR; PG8_SCHED;
        }
        if constexpr (ALIGN_EPI) { if (wr == 0) PG8_BAR; }
        E(acc, cur, wr, wc, fr, fq);
        if (!has_next) break;
#pragma unroll
        for (int a = 0; a < 2; ++a)
#pragma unroll
            for (int b = 0; b < 2; ++b)
#pragma unroll
                for (int m = 0; m < 4; ++m)
#pragma unroll
                    for (int n = 0; n < 2; ++n) acc[a][b][m][n] = (f32x4){0.f, 0.f, 0.f, 0.f};
        cur = nxt; cB = nB; ++ui;
        if constexpr (ALIGN_EPI) { if (wr == 1) PG8_BAR; }
    }
    PG8_WAIT_V(0);
    if constexpr (!ALIGN_EPI) { if (wr == 0) PG8_BAR; }
    PG8_BAR;
#undef PG8_SA
#undef PG8_SB
#undef PG8_STAGE
#undef PG8_LDA
#undef PG8_LDB
#undef PG8_MMA
#undef PG8_WAIT_V
#undef PG8_WAIT_L
#undef PG8_BAR
#undef PG8_SCHED
}

struct DenseSched {
    const char* A; const char* Bt; int nN, nwg, G, c, nmain;
    __device__ __forceinline__ bool next(int i, Unit& u) const {
        const int L = i * G + c; if (L >= nwg) return false;
        const int wgid = xcd_remap(L, nwg);
        if (wgid < nmain) { const int nig = 8 * nN, gid = wgid / nig, w = wgid % nig; u.row0 = 256 * (gid * 8 + (w % 8)); u.pn = w / 8; }
        else { const int j = wgid - nmain; u.row0 = T + 256 * (j >> 2); u.pn = 2 + (j & 3); }
        u.nvalid = 256; u.aux = 0; return true;
    }
    __device__ __forceinline__ const char* a_base() const { return A; }
    __device__ __forceinline__ const char* b_base(const Unit& u) const { return Bt + (size_t)u.pn * 256 * DM * 2; }
    __device__ __forceinline__ void a_off(const Unit& u, int tid, unsigned (&o)[2][2]) const {
#pragma unroll
        for (int i = 0; i < 2; ++i) { int R, C; stage_rc(tid * 16 + i * 8192, R, C);
#pragma unroll
            for (int h = 0; h < 2; ++h) o[h][i] = (unsigned)((u.row0 + 128 * h + R) * DM + C) * 2u; }
    }
};
constexpr int GT_MAXSEG = 132;
struct GroupedSched {
    const char* A; const char* Bt; const int* slottok; const LAS int* tab; int nseg, npn, nwg, G, c, K, brows;
    __device__ __forceinline__ bool next(int i, Unit& u) const {
        const int L = i * G + c; if (L >= nwg) return false;
        const int wgid = xcd_remap(L, nwg), tl = wgid / npn; u.pn = wgid % npn;
        int s = 0; while (tab[s + 1] <= tl) ++s;
        const int off = 256 * (tl - tab[s]);
        u.row0 = tab[GT_MAXSEG + s] + off; const int rem = tab[2 * GT_MAXSEG + s] - off; u.nvalid = rem < 256 ? rem : 256; u.aux = tab[3 * GT_MAXSEG + s];
        return true;
    }
    __device__ __forceinline__ const char* a_base() const { return A; }
    __device__ __forceinline__ const char* b_base(const Unit& u) const { return Bt + ((size_t)u.aux * brows + (size_t)u.pn * 256) * K * 2; }
    __device__ __forceinline__ void a_off(const Unit& u, int tid, unsigned (&o)[2][2]) const {
#pragma unroll
        for (int i = 0; i < 2; ++i) { int R, C; stage_rc(tid * 16 + i * 8192, R, C);
#pragma unroll
            for (int h = 0; h < 2; ++h) {
                int r = 128 * h + R;
                if (slottok) { if (r >= u.nvalid) r = u.nvalid - 1; const int slot = u.row0 + r; const int tok = (u.aux < 64) ? slottok[slot] : slot - NSLOT_R; o[h][i] = (unsigned)(tok * K + C) * 2u; }
                else o[h][i] = (unsigned)((u.row0 + r) * K + C) * 2u;
            } }
    }
};
__device__ __forceinline__ int grouped_table(LAS int* tab, const int* SEG, int h0, int h1, const int tid) {
    const int nseg = (h1 - h0) * 65;
    if (tid < nseg) { const int h = h0 + tid / 65, e = tid % 65; const int st = SEG[(h * 65 + e) * 2], cn = SEG[(h * 65 + e) * 2 + 1];
        tab[GT_MAXSEG + tid] = st; tab[2 * GT_MAXSEG + tid] = cn; tab[3 * GT_MAXSEG + tid] = e; tab[4 * GT_MAXSEG + tid] = (cn + 255) >> 8; }
    __syncthreads();
    if (tid <= nseg) { int s = 0; for (int j = 0; j < tid; ++j) s += tab[4 * GT_MAXSEG + j]; tab[tid] = s; }
    __syncthreads();
    return tab[nseg];
}

struct EpiStore {
    static constexpr bool PERM = true;
    bf16_t* C; int ldc; int rowsub, rowsub_sh;
    __device__ __forceinline__ void operator()(const f32x4 (&acc)[2][2][4][2], const Unit& u, int wr, int wc, int fr, int fq) const {
        const int col0 = u.pn * 256 + wc * 32 + 8 * fq, crow0 = u.row0 - (u.aux < 64 ? rowsub : rowsub_sh);
        int rb = wr * 64 + fr; asm volatile("" : "+v"(rb));
#pragma unroll
        for (int ai = 0; ai < 2; ++ai)
#pragma unroll
            for (int m = 0; m < 4; ++m) { const int r = ai * 128 + m * 16 + rb;
                if (r < u.nvalid) { bf16_t* rowp = C + (size_t)(crow0 + r) * ldc + col0;
#pragma unroll
                    for (int bj = 0; bj < 2; ++bj) { const f32x4 v0 = acc[ai][bj][m][0], v1 = acc[ai][bj][m][1];
                        u32x4 w; w.x = cvt_pk_bf16(v0[0], v0[1]); w.y = cvt_pk_bf16(v0[2], v0[3]); w.z = cvt_pk_bf16(v1[0], v1[1]); w.w = cvt_pk_bf16(v1[2], v1[3]);
                        *(u32x4*)(rowp + bj * 128) = w; } } }
    }
};
struct EpiGateUp {
    static constexpr bool PERM = true;
    bf16_t* ACT; const float* slotw;
    __device__ __forceinline__ void operator()(const f32x4 (&acc)[2][2][4][2], const Unit& u, int wr, int wc, int fr, int fq) const {
        const int col0 = u.pn * 128 + wc * 32 + 8 * fq;
        int rb = wr * 64 + fr; asm volatile("" : "+v"(rb));
#pragma unroll
        for (int ai = 0; ai < 2; ++ai)
#pragma unroll
            for (int m = 0; m < 4; ++m) { const int r = ai * 128 + m * 16 + rb;
                if (r < u.nvalid) { const int slot = u.row0 + r; const float w = (u.aux < 64) ? slotw[slot] : 1.f;
                    float o[8];
#pragma unroll
                    for (int n = 0; n < 2; ++n)
#pragma unroll
                        for (int i = 0; i < 4; ++i) { const float g = acc[ai][0][m][n][i], up = acc[ai][1][m][n][i]; o[4 * n + i] = g / (1.f + __expf(-g)) * up * w; }
                    u32x4 pk; pk.x = cvt_pk_bf16(o[0], o[1]); pk.y = cvt_pk_bf16(o[2], o[3]); pk.z = cvt_pk_bf16(o[4], o[5]); pk.w = cvt_pk_bf16(o[6], o[7]);
                    *(u32x4*)(ACT + (size_t)slot * FF + col0) = pk; } }
    }
};
struct EpiInProj {
    static constexpr bool PERM = false;
    bf16_t *Q, *Kb, *Vb, *P; const float* rope;
    __device__ __forceinline__ void operator()(const f32x4 (&acc)[2][2][4][2], const Unit& u, int wr, int wc, int fr, int fq) const {
        const bool latent = u.row0 < T; const int sec = u.pn >> 1;
        const bool dorope = latent && sec < 2;
        bf16_t* dstU; int n0 = 0;
        if (latent) { const int b = u.row0 / NSEQ; n0 = u.row0 % NSEQ; const size_t kvrow = (size_t)b * SKV + CTXL + n0;
            dstU = sec == 0 ? Q + (size_t)u.row0 * AW : sec == 1 ? Kb + kvrow * AW : sec == 2 ? Vb + kvrow * AW : P + (size_t)u.row0 * PW; }
        else { const int b = (u.row0 - T) / CTXL; dstU = (sec == 1 ? Kb : Vb) + (size_t)b * SKV * AW; }
        dstU += (u.pn & 1) * 256;
        int rb = wr * 64 + fr; asm volatile("" : "+v"(rb));
        const int lcol = wc * 32 + 4 * fq;
#pragma unroll
        for (int ai = 0; ai < 2; ++ai)
#pragma unroll
            for (int m = 0; m < 4; ++m) {
                const int r = ai * 128 + m * 16 + rb;
                f32x4 c4 = (f32x4){1.f, 1.f, 1.f, 1.f}, s4 = (f32x4){0.f, 0.f, 0.f, 0.f};
                if (dorope) { const int pos = (wc & 1) ? (r & 63) : ((n0 >> 6) + (r >> 6)); const float* rp = rope + (pos * 16 + 4 * fq) * 2;
                    const f32x4 cs0 = *(const f32x4*)rp, cs1 = *(const f32x4*)(rp + 4); c4 = (f32x4){cs0[0], cs0[2], cs1[0], cs1[2]}; s4 = (f32x4){cs0[1], cs0[3], cs1[1], cs1[3]}; }
                bf16_t* dst = dstU + r * 512 + lcol;
#pragma unroll
                for (int bj = 0; bj < 2; ++bj) {
                    const f32x4 x1 = acc[ai][bj][m][0], x2 = acc[ai][bj][m][1];
                    const f32x4 o1 = x1 * c4 - x2 * s4, o2 = x2 * c4 + x1 * s4;
                    u32x2 w1, w2; w1.x = cvt_pk_bf16(o1[0], o1[1]); w1.y = cvt_pk_bf16(o1[2], o1[3]); w2.x = cvt_pk_bf16(o2[0], o2[1]); w2.y = cvt_pk_bf16(o2[2], o2[3]);
                    *(u32x2*)(dst + bj * 128) = w1; *(u32x2*)(dst + bj * 128 + 16) = w2;
                }
            }
    }
};
}

__device__ __forceinline__ void ph_inproj_fast(CArgs& a, const Ctx& c) {
    pg8::DenseSched S{(const char*)(a.ws + WS_HX), (const char*)(a.ws + WS_WIN), 8, 528, c.G, c.blk, 512};
    pg8::EpiInProj E{(bf16_t*)(a.ws + WS_Q), (bf16_t*)(a.ws + WS_K), (bf16_t*)(a.ws + WS_V), (bf16_t*)(a.ws + WS_P), (const float*)(a.ws + WS_ROPE)};
    pg8::gemm_phase<pg8::EpiInProj, pg8::DenseSched, true, DM>((LAS unsigned char*)c.lds, S, E, c.tid);
}
__device__ __forceinline__ void ph_outproj_fast(CArgs& a, const Ctx& c) {
    pg8::DenseSched S{(const char*)(a.ws + WS_ATT), (const char*)(a.ws + WS_WOUT), 4, 256, c.G, c.blk, 256};
    pg8::EpiStore E{(bf16_t*)(a.ws + WS_YX), DM, 0, 0};
    pg8::gemm_phase<pg8::EpiStore, pg8::DenseSched, true, DM>((LAS unsigned char*)c.lds, S, E, c.tid);
}
__device__ __forceinline__ void ph_gateup_fast(CArgs& a, const Ctx& c) {
    LAS int* tab = (LAS int*)((LAS unsigned char*)c.lds + LDS_TAB);
    const int ntile = pg8::grouped_table(tab, (const int*)(a.ws + WS_SEG), 0, 2, c.tid);
    pg8::GroupedSched S{(const char*)(a.ws + WS_HX), (const char*)(a.ws + WS_WGU), (const int*)(a.ws + WS_SLOTTOK), tab, 130, 2, ntile * 2, c.G, c.blk, DM, 512};
    pg8::EpiGateUp E{(bf16_t*)(a.ws + WS_ACT), (const float*)(a.ws + WS_SLOTW)};
    pg8::gemm_phase<pg8::EpiGateUp, pg8::GroupedSched, true, DM>((LAS unsigned char*)c.lds, S, E, c.tid);
}
__device__ __forceinline__ void ph_down_fast(CArgs& a, const Ctx& c, int h) {
    LAS int* tab = (LAS int*)((LAS unsigned char*)c.lds + LDS_TAB);
    const int ntile = pg8::grouped_table(tab, (const int*)(a.ws + WS_SEG), h, h + 1, c.tid);
    pg8::GroupedSched S{(const char*)(a.ws + WS_ACT), (const char*)(a.ws + WS_WD), nullptr, tab, 65, 4, ntile * 4, c.G, c.blk, FF, DM};
    pg8::EpiStore E{(bf16_t*)(a.ws + WS_Y), DM, h * (NSLOT_R / 2), NSLOT_R + h * HALF_T - NSLOT_R / 2};
    pg8::gemm_phase<pg8::EpiStore, pg8::GroupedSched, true, FF>((LAS unsigned char*)c.lds, S, E, c.tid);
}

constexpr int NPHASE = 13;
__device__ __forceinline__ void run_phase(int ph, CArgs& a, const Ctx& c) {
    switch (ph) {
        case 0: ph_adaln(a, c); break;
        case 1: ph_prep(a, c); break;
#if FAST_INPROJ
        case 2: ph_inproj_fast(a, c); break;
        case 3: break;
#else
        case 2: naive_gemm((const bf16_t*)(a.ws + WS_HX), (const bf16_t*)(a.ws + WS_WIN), (bf16_t*)(a.ws + WS_PXB), TT, INW, DM, c); break;
        case 3: ph_rope_scatter(a, c); break;
#endif
        case 4: ph_attn_naive(a, c); __syncthreads(); ph_pool_naive(a, c); break;
#if FAST_OUTPROJ
        case 5: ph_outproj_fast(a, c); break;
#else
        case 5: naive_gemm((const bf16_t*)(a.ws + WS_ATT), (const bf16_t*)(a.ws + WS_WOUT), (bf16_t*)(a.ws + WS_YX), T, DM, DM, c); break;
#endif
        case 6: ph_norm_router(a, c); break;
        case 7: ph_tables(a, c); break;
#if FAST_GATEUP
        case 8: ph_gateup_fast(a, c); break;
#else
        case 8: ph_gateup_naive(a, c); break;
#endif
#if FAST_DOWN
        case 9: ph_down_fast(a, c, 0); break;
        case 11: ph_down_fast(a, c, 1); break;
#else
        case 9: ph_down_naive(a, c, 0); break;
        case 11: ph_down_naive(a, c, 1); break;
#endif
        case 10: ph_combine(a, c, 0); break;
        case 12: ph_combine(a, c, 1); break;
        default: break;
    }
}
__global__ void __launch_bounds__(512, 2) mega(Args a_) {
    extern __shared__ __attribute__((aligned(16))) unsigned char lds[];
    const int lo = a_.ph_lo, hi = a_.ph_hi;
    { volatile LAS unsigned* z = (volatile LAS unsigned*)((LAS unsigned char*)lds + LDSCTL_OFF); for (int u = threadIdx.x; u < (LDS_BYTES - LDSCTL_OFF) / 4; u += 512) z[u] = 0u; }
    __syncthreads();
    volatile LAS unsigned* MISC = (volatile LAS unsigned*)((LAS unsigned char*)lds + MISC_OFF);
    XcdBarrier bar; bar.bar = (unsigned*)(a_.ws + WS_CTL); bar.x = 0; bar.st = nullptr;
    if (hi - lo > 1) bar = xcd_barrier_post((unsigned*)(a_.ws + WS_CTL), MISC + 8);
#define PHASE(k) if (lo <= (k) && (k) < hi) { \
        int t_ = threadIdx.x; asm volatile("" : "+v"(t_)); \
        CArgs* ap_ = (CArgs*)__builtin_amdgcn_kernarg_segment_ptr(); asm volatile("" : "+s"(ap_)); \
        Ctx c; c.tid = t_; c.lane = t_ & 63; c.wave = __builtin_amdgcn_readfirstlane(t_ >> 6); c.blk = blockIdx.x; c.G = gridDim.x; c.lds = lds; \
        run_phase((k), *ap_, c); \
        if ((k) + 1 < hi) xcd_barrier(bar); }
    PHASE(0) PHASE(1) PHASE(2) PHASE(3) PHASE(4) PHASE(5) PHASE(6) PHASE(7) PHASE(8) PHASE(9) PHASE(10) PHASE(11) PHASE(12)
#undef PHASE
}

extern "C" void kernel_launch(void* const* d_in, const int* in_sizes, int n_in, void* d_out, int out_size, void* d_ws, size_t ws_size, hipStream_t stream) {
    static int grid = 0;
    if (grid == 0) {
        if (n_in != 28 || in_sizes[0] != T * DM || out_size != T * DM || ws_size < WS_END) {
            fprintf(stderr, "kernel_launch: unexpected shapes or workspace: n_in %d in0 %d out %d ws %zu (need %zu)\n", n_in, n_in > 0 ? in_sizes[0] : -1, out_size, ws_size, (size_t)WS_END);
            grid = -1; return; }
        int dev = 0, cus = 0;
        if (hipGetDevice(&dev) != hipSuccess || hipDeviceGetAttribute(&cus, hipDeviceAttributeMultiprocessorCount, dev) != hipSuccess) { grid = -1; return; }
        if (hipFuncSetAttribute((const void*)mega, hipFuncAttributeMaxDynamicSharedMemorySize, LDS_BYTES) != hipSuccess) { fprintf(stderr, "kernel_launch: hipFuncSetAttribute failed\n"); grid = -1; return; }
        grid = cus;
    }
    if (grid < 0) return;
    (void)hipMemsetAsync((char*)d_ws + WS_CTL, 0, CTL_ZERO_BYTES, stream);
    Args a{};
    for (int i = 0; i < 28; ++i) a.in[i] = (const float*)d_in[i];
    a.out = (float*)d_out; a.ws = (unsigned char*)d_ws;
#if MK_PER_PHASE_LAUNCH
    for (int p = 0; p < NPHASE; ++p) { a.ph_lo = p; a.ph_hi = p + 1; hipLaunchKernelGGL(mega, dim3(grid), dim3(512), LDS_BYTES, stream, a); }
#else
    a.ph_lo = 0; a.ph_hi = NPHASE; hipLaunchKernelGGL(mega, dim3(grid), dim3(512), LDS_BYTES, stream, a);
#endif
    const hipError_t le = hipPeekAtLastError();
    if (le != hipSuccess) fprintf(stderr, "kernel_launch: launch failed: %s\n", hipGetErrorName(le));
}
```

```cpp
#include <hip/hip_runtime.h>
#include <cstdio>
#include <cstdint>

#ifndef FAST_INPROJ
#define FAST_INPROJ 1
#endif
#ifndef FAST_OUTPROJ
#define FAST_OUTPROJ 1
#endif
#ifndef FAST_GATEUP
#define FAST_GATEUP 1
#endif
#ifndef FAST_DOWN
#define FAST_DOWN 1
#endif
#ifndef FAST_ATTN
#define FAST_ATTN 1
#endif
#ifndef MK_PER_PHASE_LAUNCH
#define MK_PER_PHASE_LAUNCH 0
#endif

constexpr int NB = 4, NSEQ = 4096, DM = 1024, T = NB * NSEQ, CTXL = 256, TC = NB * CTXL, TT = T + TC;
constexpr int NH = 4, DQK = 64, DV = 128, AW = 512, INW = 2048, PW = 512;
constexpr int SKV = CTXL + NSEQ;
constexpr int NE = 64, FF = 256, TOPK = 8;
constexpr int HALF_T = T / 2;
constexpr int NSLOT_R = T * TOPK;
constexpr int NSLOT = NSLOT_R + T;
constexpr int YROWS = HALF_T * (TOPK + 1);
constexpr float EPS = 1e-6f;
constexpr float LAM_INIT = 0.2f;
constexpr int NVB = 256;

typedef unsigned short bf16_t;
typedef unsigned int u32;

constexpr size_t KiB = 1024, MiB = 1024 * 1024;
constexpr size_t WS_CTL = 0;
constexpr size_t CTL_ZERO_BYTES = 64 * KiB;
constexpr size_t WS_MODS = 64 * KiB;
constexpr size_t WS_LAM = 192 * KiB;
constexpr size_t WS_ROPE = 196 * KiB;
constexpr size_t WS_SEG = 208 * KiB;
constexpr size_t WS_BLKCNT = 256 * KiB;
constexpr size_t WS_TOPE = 512 * KiB;
constexpr size_t WS_TOPW = 1 * MiB;
constexpr size_t WS_TOKSLOT = 1 * MiB + 512 * KiB;
constexpr size_t WS_SLOTTOK = 2 * MiB;
constexpr size_t WS_SLOTW = 2 * MiB + 512 * KiB;
constexpr size_t WS_SLOTE = 3 * MiB;
constexpr size_t WS_WD = 4 * MiB;
constexpr size_t WS_WGU = WS_WD + 33280 * KiB;
constexpr size_t WS_HX = WS_WGU + 65 * MiB;
constexpr size_t WS_WIN = WS_HX + 34 * MiB;
constexpr size_t WS_WOUT = WS_WIN + 4 * MiB;
constexpr size_t WS_Q = WS_WOUT + 2 * MiB;
constexpr size_t WS_K = WS_Q + 16 * MiB;
constexpr size_t WS_V = WS_K + 17 * MiB;
constexpr size_t WS_P = WS_V + 17 * MiB;
constexpr size_t WS_ATT = WS_P + 16 * MiB;
constexpr size_t WS_YX = WS_ATT + 32 * MiB;
constexpr size_t WS_PXB = WS_ATT;
constexpr size_t WS_ACT = 227 * MiB + 256 * KiB;
constexpr size_t WS_Y = WS_WGU;
constexpr size_t WS_END = WS_ACT + (size_t)(NSLOT + 256) * FF * 2;
static_assert(WS_YX + 32 * MiB <= WS_END + 64 * MiB, "map");
static_assert(WS_Y + (size_t)(YROWS + 256) * DM * 2 <= WS_ACT, "Y must not reach ACT");
static_assert(WS_PXB + (size_t)TT * INW * 2 <= WS_END, "PXB fits");

constexpr int LDS_BYTES = 147456;
constexpr int LDS_MAIN = 140 * 1024;
constexpr int LDSCTL_OFF = LDS_MAIN;
constexpr int MISC_OFF = LDSCTL_OFF + 320;

#define GAS __attribute__((address_space(1)))
#define LAS __attribute__((address_space(3)))

__device__ __forceinline__ u32 f2bf(float f) { u32 u = __float_as_uint(f); return (u + 0x7fffu + ((u >> 16) & 1u)) >> 16; }
__device__ __forceinline__ u32 pk2(float lo, float hi) { return f2bf(lo) | (f2bf(hi) << 16); }
__device__ __forceinline__ float bflo(u32 w) { return __uint_as_float(w << 16); }
__device__ __forceinline__ float bfhi(u32 w) { return __uint_as_float(w & 0xffff0000u); }
__device__ __forceinline__ float bf2f(bf16_t b) { return __uint_as_float(((u32)b) << 16); }
__device__ __forceinline__ float shx(float v, int m, int lane) { return __int_as_float(__builtin_amdgcn_ds_bpermute((lane ^ m) << 2, __float_as_int(v))); }
__device__ __forceinline__ float shl(float v, int src) { return __int_as_float(__builtin_amdgcn_ds_bpermute(src << 2, __float_as_int(v))); }
__device__ __forceinline__ float wave_sum(float v, int lane) {
#pragma unroll
    for (int o = 1; o < 64; o <<= 1) v += shx(v, o, lane);
    return v;
}
__device__ __forceinline__ float wave_max(float v, int lane) {
#pragma unroll
    for (int o = 1; o < 64; o <<= 1) v = fmaxf(v, shx(v, o, lane));
    return v;
}
__device__ __forceinline__ float silu_f(float v) { return v / (1.f + __expf(-v)); }
__device__ __forceinline__ float dot8(uint4 a, uint4 b, float acc) {
    acc = fmaf(bflo(a.x), bflo(b.x), acc); acc = fmaf(bfhi(a.x), bfhi(b.x), acc);
    acc = fmaf(bflo(a.y), bflo(b.y), acc); acc = fmaf(bfhi(a.y), bfhi(b.y), acc);
    acc = fmaf(bflo(a.z), bflo(b.z), acc); acc = fmaf(bfhi(a.z), bfhi(b.z), acc);
    acc = fmaf(bflo(a.w), bflo(b.w), acc); acc = fmaf(bfhi(a.w), bfhi(b.w), acc);
    return acc;
}
__device__ __forceinline__ float ndot(const bf16_t* a, const bf16_t* b, int K) {
    float a0 = 0.f, a1 = 0.f;
    for (int k = 0; k < K; k += 16) {
        const uint4 x0 = *(const uint4*)(a + k), y0 = *(const uint4*)(b + k), x1 = *(const uint4*)(a + k + 8), y1 = *(const uint4*)(b + k + 8);
        a0 = dot8(x0, y0, a0); a1 = dot8(x1, y1, a1);
    }
    return a0 + a1;
}

#define XB_TMO      128
#define XB_XCNT(j)  (256  + 64 * (j))
#define XB_XSUB(j)  (1280 + 64 * (j))
#define XB_XGEN(j)  (2304 + 64 * (j))
#define XB_TOP      3328
#define XB_TOPGEN   3392
#define XCD_BAR_WORDS 3456
#define XB_SPIN_CAP (1u << 22)
__device__ __forceinline__ unsigned xb_ld(unsigned* p)              { return __hip_atomic_load(p, __ATOMIC_RELAXED, __HIP_MEMORY_SCOPE_AGENT); }
__device__ __forceinline__ unsigned xb_add(unsigned* p, unsigned v) { return __hip_atomic_fetch_add(p, v, __ATOMIC_RELAXED, __HIP_MEMORY_SCOPE_AGENT); }
__device__ __forceinline__ unsigned xb_xcc_id() { return (unsigned)__builtin_amdgcn_s_getreg((3 << 11) | 20) & 0xFu; }
#define XB_SPIN(cond, bar) do { unsigned _sp = 0; while (cond) { __builtin_amdgcn_s_sleep(1); \
    if ((++_sp & 255u) == 0u) { if (xb_ld(&(bar)[XB_TMO])) break; if (_sp > XB_SPIN_CAP) { atomicAdd(&(bar)[XB_TMO], 1u); break; } } } } while (0)
struct XcdBarrier { unsigned* bar; unsigned x; volatile LAS unsigned* st; };
__device__ __forceinline__ XcdBarrier xcd_barrier_post(unsigned* bar, volatile LAS unsigned* st) {
    XcdBarrier b; b.bar = bar; b.x = xb_xcc_id(); b.st = st;
    if (threadIdx.x == 0) (void)xb_add(&bar[XB_XCNT(b.x)], 1u);
    return b;
}
__device__ __forceinline__ void xcd_barrier_complete(unsigned* bar, unsigned x, unsigned& nloc, unsigned& nx) {
    const unsigned G = gridDim.x * gridDim.y * gridDim.z;
    unsigned sum, cnt, mine, sp = 0u;
    for (;;) {
        sum = 0u; cnt = 0u; mine = 0u;
#pragma unroll
        for (unsigned j = 0; j < 16; ++j) { const unsigned c = xb_ld(&bar[XB_XCNT(j)]); sum += c; cnt += (c > 0u) ? 1u : 0u; mine = (j == x) ? c : mine; }
        if (sum == G) break;
        __builtin_amdgcn_s_sleep(1);
        if ((++sp & 255u) == 0u) { if (xb_ld(&bar[XB_TMO])) break; if (sp > XB_SPIN_CAP) { atomicAdd(&bar[XB_TMO], 1u); break; } }
    }
    nloc = mine > 0u ? mine : 1u; nx = cnt > 0u ? cnt : 1u;
}
__device__ __forceinline__ void xcd_barrier(const XcdBarrier& b) {
    asm volatile("s_waitcnt vmcnt(0)" ::: "memory");
    __syncthreads();
    if (threadIdx.x == 0) {
        unsigned* bar = b.bar;
        __builtin_amdgcn_s_waitcnt(0);
        unsigned nloc = b.st[0], nx = b.st[1];
        if (nloc == 0u) { xcd_barrier_complete(bar, b.x, nloc, nx); b.st[0] = nloc; b.st[1] = nx; }
        const unsigned old = xb_add(&bar[XB_XSUB(b.x)], 1u);
        const unsigned gen = old / nloc;
        if (old + 1u == (gen + 1u) * nloc) {
            __builtin_amdgcn_fence(__ATOMIC_RELEASE, "agent");
            asm volatile("s_waitcnt vmcnt(0)" ::: "memory");
            const unsigned og = xb_add(&bar[XB_TOP], 1u);
            const unsigned tg = og / nx;
            if (og + 1u == (tg + 1u) * nx) xb_add(&bar[XB_TOPGEN], 1u);
            else XB_SPIN(xb_ld(&bar[XB_TOPGEN]) == tg, bar);
            __builtin_amdgcn_fence(__ATOMIC_ACQUIRE, "agent");
            xb_add(&bar[XB_XGEN(b.x)], 1u);
            asm volatile("s_waitcnt vmcnt(0)" ::: "memory");
        } else {
            XB_SPIN(xb_ld(&bar[XB_XGEN(b.x)]) == gen, bar);
            __builtin_amdgcn_fence(__ATOMIC_ACQUIRE, "agent");
            asm volatile("s_waitcnt vmcnt(0)" ::: "memory");
        }
    }
    __syncthreads();
}

struct Args {
    const float* in[28];
    float* out;
    unsigned char* ws;
    int ph_lo, ph_hi;
};
enum { I_X = 0, I_C, I_CTX, I_CCTX, I_WADA, I_BADA, I_GPREMIX, I_GPOSTMIX, I_GPREFFN, I_GPOSTFFN, I_WIN, I_LQ1, I_LK1, I_LQ2, I_LK2,
       I_GSUBLN, I_WPOOL, I_BPOOL, I_PSCALE, I_WOUT, I_WROUTER, I_RBIAS, I_WEG, I_WEU, I_WED, I_WSG, I_WSU, I_WSD };

typedef __attribute__((address_space(4))) const Args CArgs;
struct Ctx {
    int tid, lane, wave, blk, G;
    unsigned char* lds;
};

__device__ __forceinline__ void ph_adaln(CArgs& a, const Ctx& c) {
    float* MODS = (float*)(a.ws + WS_MODS);
    float* red = (float*)c.lds;
    const float* w_ada = a.in[I_WADA];
    for (int it = c.blk; it < 96; it += c.G) {
        const int j = it * 64 + c.lane;
        float acc[5] = {0.f, 0.f, 0.f, 0.f, 0.f};
        const int k0 = c.wave * 128;
        for (int k = k0; k < k0 + 128; ++k) {
            const float w = w_ada[(size_t)k * 6144 + j];
#pragma unroll
            for (int r = 0; r < 5; ++r) { const float cv = (r < 4) ? a.in[I_C][r * DM + k] : a.in[I_CCTX][k]; acc[r] = fmaf(silu_f(cv), w, acc[r]); }
        }
#pragma unroll
        for (int r = 0; r < 5; ++r) red[(c.wave * 5 + r) * 64 + c.lane] = acc[r];
        __syncthreads();
        if (c.tid < 320) {
            const int r = c.tid >> 6, l = c.tid & 63; float s = 0.f;
#pragma unroll
            for (int w = 0; w < 8; ++w) s += red[(w * 5 + r) * 64 + l];
            MODS[r * 6144 + it * 64 + l] = s + a.in[I_BADA][it * 64 + l];
        }
        __syncthreads();
    }
    if (c.blk == c.G - 1) {
        float* ROPE = (float*)(a.ws + WS_ROPE);
        for (int i = c.tid; i < 1024; i += 512) {
            const int pos = i >> 4, fi = i & 15;
            const float freq = powf(10000.f, -(float)fi / 16.f);
            const float ang = (float)pos * freq;
            ROPE[i * 2] = cosf(ang); ROPE[i * 2 + 1] = sinf(ang);
        }
        if (c.wave == 0) {
            const float s1 = wave_sum(a.in[I_LQ1][c.lane] * a.in[I_LK1][c.lane], c.lane);
            const float s2 = wave_sum(a.in[I_LQ2][c.lane] * a.in[I_LK2][c.lane], c.lane);
            if (c.lane == 0) *(float*)(a.ws + WS_LAM) = expf(s1) - expf(s2) + LAM_INIT;
        }
    }
}

__device__ __forceinline__ void transpose_item(const float* W, int K, int N, bf16_t* WT, int k0, int n0, int drow0, float* scr, int lane) {
#pragma unroll 8
    for (int i = 0; i < 32; ++i) { const int kk = 2 * i + (lane >> 5); scr[kk * 33 + (lane & 31)] = W[(size_t)(k0 + kk) * N + n0 + (lane & 31)]; }
    asm volatile("s_waitcnt lgkmcnt(0)" ::: "memory");
    const int cc = lane & 7;
#pragma unroll
    for (int j = 0; j < 4; ++j) { const int n = (lane >> 3) + 8 * j; const float* s = scr + (8 * cc) * 33 + n;
        uint4 o; o.x = pk2(s[0 * 33], s[1 * 33]); o.y = pk2(s[2 * 33], s[3 * 33]); o.z = pk2(s[4 * 33], s[5 * 33]); o.w = pk2(s[6 * 33], s[7 * 33]);
        *(uint4*)(WT + (size_t)(drow0 + n) * K + k0 + 8 * cc) = o; }
    asm volatile("s_waitcnt lgkmcnt(0)" ::: "memory");
}
__device__ __forceinline__ void ph_prep(CArgs& a, const Ctx& c) {
    float* scr = (float*)(c.lds + c.wave * 16384);
    const int gw = c.blk * 8 + c.wave, NGW = c.G * 8;
    constexpr int I_IN = 16 * 64, I_OUT = 16 * 32, I_G = 16 * 8, I_D = 4 * 32;
    constexpr int NIT = I_IN + I_OUT + 65 * (2 * I_G + I_D);
    bf16_t* WIN = (bf16_t*)(a.ws + WS_WIN); bf16_t* WOUT = (bf16_t*)(a.ws + WS_WOUT); bf16_t* WGU = (bf16_t*)(a.ws + WS_WGU); bf16_t* WD = (bf16_t*)(a.ws + WS_WD);
    for (int it = gw; it < NIT; it += NGW) {
        int r = it;
        if (r < I_IN) { const int kb = r / 64, nb = r % 64; transpose_item(a.in[I_WIN], DM, INW, WIN, kb * 64, nb * 32, nb * 32, scr, c.lane); continue; } r -= I_IN;
        if (r < I_OUT) { const int kb = r / 32, nb = r % 32; transpose_item(a.in[I_WOUT], DM, DM, WOUT, kb * 64, nb * 32, nb * 32, scr, c.lane); continue; } r -= I_OUT;
        const int e = r / (2 * I_G + I_D); r -= e * (2 * I_G + I_D);
        if (r < 2 * I_G) {
            const int up = r / I_G; r -= up * I_G; const int kb = r / 8, nb = r % 8, n0 = nb * 32;
            const float* src = (e < 64) ? a.in[up ? I_WEU : I_WEG] + (size_t)e * DM * FF : a.in[up ? I_WSU : I_WSG];
            transpose_item(src, DM, FF, WGU + (size_t)e * 512 * DM, kb * 64, n0, 256 * (n0 >> 7) + (n0 & 127) + (up ? 128 : 0), scr, c.lane);
        } else {
            r -= 2 * I_G; const int kb = r / 32, nb = r % 32;
            const float* src = (e < 64) ? a.in[I_WED] + (size_t)e * FF * DM : a.in[I_WSD];
            transpose_item(src, FF, DM, WD + (size_t)e * DM * FF, kb * 64, nb * 32, nb * 32, scr, c.lane);
        }
    }
    const float* MODS = (const float*)(a.ws + WS_MODS); bf16_t* HX = (bf16_t*)(a.ws + WS_HX);
    for (int m = gw; m < TT; m += NGW) {
        const float* xr = (m < T) ? a.in[I_X] + (size_t)m * DM : a.in[I_CTX] + (size_t)(m - T) * DM;
        const float* md = MODS + (size_t)((m < T) ? (m / NSEQ) : 4) * 6144;
        float4 v[4]; float ss = 0.f;
#pragma unroll
        for (int j = 0; j < 4; ++j) { v[j] = *(const float4*)(xr + 4 * c.lane + 256 * j); ss += v[j].x * v[j].x + v[j].y * v[j].y + v[j].z * v[j].z + v[j].w * v[j].w; }
        const float rs = rsqrtf(wave_sum(ss, c.lane) * (1.f / DM) + EPS);
#pragma unroll
        for (int j = 0; j < 4; ++j) {
            const int col = 4 * c.lane + 256 * j;
            const float4 g = *(const float4*)(a.in[I_GPREMIX] + col), sh = *(const float4*)(md + col), sc = *(const float4*)(md + 1024 + col);
            const float o0 = v[j].x * rs * g.x * (1.f + sc.x) + sh.x, o1 = v[j].y * rs * g.y * (1.f + sc.y) + sh.y;
            const float o2 = v[j].z * rs * g.z * (1.f + sc.z) + sh.z, o3 = v[j].w * rs * g.w * (1.f + sc.w) + sh.w;
            uint2 w; w.x = pk2(o0, o1); w.y = pk2(o2, o3);
            *(uint2*)(HX + (size_t)m * DM + col) = w;
        }
    }
}

__device__ __forceinline__ void naive_gemm(const bf16_t* A, const bf16_t* Bt, bf16_t* C, int M, int N, int K, const Ctx& c) {
    const size_t total = (size_t)M * N;
    for (size_t idx = (size_t)c.blk * 512 + c.tid; idx < total; idx += (size_t)c.G * 512) {
        const int row = (int)(idx / N), col = (int)(idx % N);
        C[idx] = (bf16_t)f2bf(ndot(A + (size_t)row * K, Bt + (size_t)col * K, K));
    }
}

__device__ __forceinline__ void ph_rope_scatter(CArgs& a, const Ctx& c) {
    const bf16_t* PXB = (const bf16_t*)(a.ws + WS_PXB); const float* ROPE = (const float*)(a.ws + WS_ROPE);
    bf16_t* Q = (bf16_t*)(a.ws + WS_Q); bf16_t* Kb = (bf16_t*)(a.ws + WS_K); bf16_t* Vb = (bf16_t*)(a.ws + WS_V); bf16_t* P = (bf16_t*)(a.ws + WS_P);
    const size_t total = (size_t)TT * INW;
    for (size_t idx = (size_t)c.blk * 512 + c.tid; idx < total; idx += (size_t)c.G * 512) {
        const int row = (int)(idx / INW), col = (int)(idx % INW);
        float v = bf2f(PXB[idx]);
        if (row < T) {
            const int b = row / NSEQ, n = row % NSEQ;
            if (col < 1024) {
                const int d = col & 63, half = d >> 5, dd = d & 31, fi = dd & 15;
                const int pos = half ? (n & 63) : (n >> 6);
                const float cs = ROPE[(pos * 16 + fi) * 2], sn = ROPE[(pos * 16 + fi) * 2 + 1];
                const float o = bf2f(PXB[(dd < 16) ? idx + 16 : idx - 16]);
                v = (dd < 16) ? v * cs - o * sn : v * cs + o * sn;
                if (col < 512) Q[(size_t)row * AW + col] = (bf16_t)f2bf(v);
                else Kb[((size_t)b * SKV + CTXL + n) * AW + (col - 512)] = (bf16_t)f2bf(v);
            } else if (col < 1536) Vb[((size_t)b * SKV + CTXL + n) * AW + (col - 1024)] = (bf16_t)f2bf(v);
            else P[(size_t)row * PW + (col - 1536)] = (bf16_t)f2bf(v);
        } else {
            const int b = (row - T) / CTXL, j = (row - T) % CTXL;
            if (col >= 512 && col < 1024) Kb[((size_t)b * SKV + j) * AW + (col - 512)] = (bf16_t)f2bf(v);
            else if (col >= 1024 && col < 1536) Vb[((size_t)b * SKV + j) * AW + (col - 1024)] = (bf16_t)f2bf(v);
        }
    }
}

__device__ __forceinline__ void ph_attn_naive(CArgs& a, const Ctx& c) {
    const bf16_t* Q = (const bf16_t*)(a.ws + WS_Q); const bf16_t* Kb = (const bf16_t*)(a.ws + WS_K); const bf16_t* Vb = (const bf16_t*)(a.ws + WS_V);
    bf16_t* ATT = (bf16_t*)(a.ws + WS_ATT);
    const float lam = *(const float*)(a.ws + WS_LAM);
    float* S = (float*)c.lds;
    float* qs = S + 8 * SKV;
    float* st = qs + 512;
    constexpr int NITEM = NB * NH * (NSEQ / 4);
    for (int it = c.blk; it < NITEM; it += c.G) {
        const int qg = it % (NSEQ / 4), h = (it / (NSEQ / 4)) % NH, b = it / (NSEQ / 4 * NH);
        const int row0 = b * NSEQ + qg * 4;
        { const int r = c.tid >> 7, d = c.tid & 127; qs[c.tid] = bf2f(Q[(size_t)(row0 + r) * AW + h * 128 + d]); }
        __syncthreads();
        for (int j = c.tid; j < SKV; j += 512) {
            const bf16_t* kr = Kb + ((size_t)b * SKV + j) * AW + h * 128;
            float s[4][2];
#pragma unroll
            for (int r = 0; r < 4; ++r) { s[r][0] = 0.f; s[r][1] = 0.f; }
#pragma unroll
            for (int m = 0; m < 2; ++m)
#pragma unroll
                for (int d8 = 0; d8 < 8; ++d8) {
                    const uint4 kv = *(const uint4*)(kr + m * 64 + d8 * 8);
                    const float k0 = bflo(kv.x), k1 = bfhi(kv.x), k2 = bflo(kv.y), k3 = bfhi(kv.y), k4 = bflo(kv.z), k5 = bfhi(kv.z), k6 = bflo(kv.w), k7 = bfhi(kv.w);
#pragma unroll
                    for (int r = 0; r < 4; ++r) { const float* qq = qs + r * 128 + m * 64 + d8 * 8;
                        s[r][m] += qq[0] * k0 + qq[1] * k1 + qq[2] * k2 + qq[3] * k3 + qq[4] * k4 + qq[5] * k5 + qq[6] * k6 + qq[7] * k7; }
                }
#pragma unroll
            for (int r = 0; r < 4; ++r) { S[(r * 2 + 0) * SKV + j] = s[r][0] * 0.125f; S[(r * 2 + 1) * SKV + j] = s[r][1] * 0.125f; }
        }
        __syncthreads();
        {
            float* sr = S + c.wave * SKV; float mx = -3.0e38f;
            for (int j = c.lane; j < SKV; j += 64) mx = fmaxf(mx, sr[j]);
            mx = wave_max(mx, c.lane); float sum = 0.f;
            for (int j = c.lane; j < SKV; j += 64) { const float e = __expf(sr[j] - mx); sr[j] = e; sum += e; }
            sum = wave_sum(sum, c.lane);
            if (c.lane == 0) st[c.wave] = 1.f / sum;
        }
        __syncthreads();
        for (int i = c.tid; i < 4 * SKV; i += 512) { const int r = i / SKV, j = i % SKV;
            S[(r * 2) * SKV + j] = S[(r * 2) * SKV + j] * st[r * 2] - lam * S[(r * 2 + 1) * SKV + j] * st[r * 2 + 1]; }
        __syncthreads();
        const int r = c.tid >> 7, d = c.tid & 127;
        float o = 0.f;
        { const float* ar = S + (r * 2) * SKV; const bf16_t* vp = Vb + (size_t)b * SKV * AW + h * 128 + d;
          for (int j = 0; j < SKV; ++j) o = fmaf(ar[j], bf2f(vp[(size_t)j * AW]), o); }
        const float sq = wave_sum(o * o, c.lane);
        if (c.lane == 0) st[16 + c.wave] = sq;
        __syncthreads();
        const float tot = st[16 + 2 * r] + st[16 + 2 * r + 1];
        const float rs = rsqrtf(tot * (1.f / 128.f) + EPS);
        ATT[(size_t)(row0 + r) * DM + h * 128 + d] = (bf16_t)f2bf(o * rs * a.in[I_GSUBLN][d] * (1.f - LAM_INIT));
        __syncthreads();
    }
}
__device__ __forceinline__ void ph_pool_naive(CArgs& a, const Ctx& c) {
    const bf16_t* P = (const bf16_t*)(a.ws + WS_P); bf16_t* ATT = (bf16_t*)(a.ws + WS_ATT);
    float* pd = (float*)c.lds;
    for (int row = c.blk; row < T; row += c.G) {
        const int b = row / NSEQ, n = row % NSEQ, ch = c.tid, g = ch >> 7, w = 2 << g;
        int lo = n - w / 2; if (lo < 0) lo = 0; int hi = n + (w - w / 2); if (hi > NSEQ) hi = NSEQ;
        float s = 0.f;
        for (int j = lo; j < hi; ++j) s += bf2f(P[(size_t)(b * NSEQ + j) * PW + ch]);
        pd[ch] = s / (float)(hi - lo) - bf2f(P[(size_t)row * PW + ch]);
        __syncthreads();
        const int e = ch & 127; float acc = 0.f;
        const float* wp = a.in[I_WPOOL] + (size_t)g * 128 * 128 + e;
        for (int cc = 0; cc < 128; ++cc) acc = fmaf(pd[g * 128 + cc], wp[cc * 128], acc);
        ATT[(size_t)row * DM + 512 + ch] = (bf16_t)f2bf((acc + a.in[I_BPOOL][ch]) * a.in[I_PSCALE][ch]);
        __syncthreads();
    }
}

__device__ __forceinline__ void ph_norm_router(CArgs& a, const Ctx& c) {
    const bf16_t* YX = (const bf16_t*)(a.ws + WS_YX); bf16_t* HX2 = (bf16_t*)(a.ws + WS_HX);
    const float* MODS = (const float*)(a.ws + WS_MODS);
    int* TOPE = (int*)(a.ws + WS_TOPE); float* TOPW = (float*)(a.ws + WS_TOPW); int* BLKCNT = (int*)(a.ws + WS_BLKCNT);
    float* hrow = (float*)(c.lds + c.wave * 4096);
    int* hist = (int*)(c.lds + 8 * 4096);
    const float* wr = a.in[I_WROUTER];
    for (int vb = c.blk; vb < NVB; vb += c.G) {
        if (c.tid < 64) hist[c.tid] = 0;
        __syncthreads();
        for (int i = 0; i < 8; ++i) {
            const int t = vb * 64 + c.wave * 8 + i, b = t / NSEQ;
            const float* md = MODS + (size_t)b * 6144;
            float v[16]; float ss = 0.f;
#pragma unroll
            for (int j = 0; j < 4; ++j) { const uint2 w = *(const uint2*)(YX + (size_t)t * DM + 4 * c.lane + 256 * j);
                v[4 * j] = bflo(w.x); v[4 * j + 1] = bfhi(w.x); v[4 * j + 2] = bflo(w.y); v[4 * j + 3] = bfhi(w.y); }
#pragma unroll
            for (int j = 0; j < 16; ++j) ss += v[j] * v[j];
            const float r1 = rsqrtf(wave_sum(ss, c.lane) * (1.f / DM) + EPS);
            float ss2 = 0.f;
#pragma unroll
            for (int j = 0; j < 4; ++j) {
                const int col = 4 * c.lane + 256 * j;
                const float4 xv = *(const float4*)(a.in[I_X] + (size_t)t * DM + col), gp = *(const float4*)(a.in[I_GPOSTMIX] + col), ga = *(const float4*)(md + 2048 + col);
                float4 x1; x1.x = xv.x + ga.x * (v[4 * j] * r1 * gp.x); x1.y = xv.y + ga.y * (v[4 * j + 1] * r1 * gp.y);
                x1.z = xv.z + ga.z * (v[4 * j + 2] * r1 * gp.z); x1.w = xv.w + ga.w * (v[4 * j + 3] * r1 * gp.w);
                *(float4*)(a.out + (size_t)t * DM + col) = x1;
                v[4 * j] = x1.x; v[4 * j + 1] = x1.y; v[4 * j + 2] = x1.z; v[4 * j + 3] = x1.w;
                ss2 += x1.x * x1.x + x1.y * x1.y + x1.z * x1.z + x1.w * x1.w;
            }
            const float r2 = rsqrtf(wave_sum(ss2, c.lane) * (1.f / DM) + EPS);
#pragma unroll
            for (int j = 0; j < 4; ++j) {
                const int col = 4 * c.lane + 256 * j;
                const float4 g = *(const float4*)(a.in[I_GPREFFN] + col), sh = *(const float4*)(md + 3072 + col), sc = *(const float4*)(md + 4096 + col);
                float4 hv; hv.x = v[4 * j] * r2 * g.x * (1.f + sc.x) + sh.x; hv.y = v[4 * j + 1] * r2 * g.y * (1.f + sc.y) + sh.y;
                hv.z = v[4 * j + 2] * r2 * g.z * (1.f + sc.z) + sh.z; hv.w = v[4 * j + 3] * r2 * g.w * (1.f + sc.w) + sh.w;
                uint2 w; w.x = pk2(hv.x, hv.y); w.y = pk2(hv.z, hv.w);
                *(uint2*)(HX2 + (size_t)t * DM + col) = w;
                *(float4*)(hrow + col) = hv;
            }
            asm volatile("s_waitcnt lgkmcnt(0)" ::: "memory");
            float lg0 = 0.f, lg1 = 0.f;
            for (int k = 0; k < DM; k += 4) {
                const float4 hv = *(const float4*)(hrow + k);
                lg0 = fmaf(hv.x, wr[(size_t)(k + 0) * NE + c.lane], lg0); lg1 = fmaf(hv.y, wr[(size_t)(k + 1) * NE + c.lane], lg1);
                lg0 = fmaf(hv.z, wr[(size_t)(k + 2) * NE + c.lane], lg0); lg1 = fmaf(hv.w, wr[(size_t)(k + 3) * NE + c.lane], lg1);
            }
            const float score = 1.f / (1.f + expf(-(lg0 + lg1)));
            const float biased = score + a.in[I_RBIAS][c.lane];
            int grank = 0;
#pragma unroll
            for (int j = 0; j < 8; ++j) { const float vj = shl(biased, (c.lane & ~7) + j); grank += (vj > biased || (vj == biased && j < (c.lane & 7))) ? 1 : 0; }
            float gs = (grank < 2) ? biased : 0.f;
            gs += shx(gs, 1, c.lane); gs += shx(gs, 2, c.lane); gs += shx(gs, 4, c.lane);
            int gr = 0; const int myg = c.lane >> 3;
#pragma unroll
            for (int g = 0; g < 8; ++g) { const float sg = __int_as_float(__builtin_amdgcn_readlane(__float_as_int(gs), g * 8)); gr += (sg > gs || (sg == gs && g < myg)) ? 1 : 0; }
            const float masked = (gr < 4) ? biased : -INFINITY;
            int cnt = 0;
#pragma unroll
            for (int j = 0; j < 64; ++j) { const float vj = __int_as_float(__builtin_amdgcn_readlane(__float_as_int(masked), j)); cnt += (vj > masked || (vj == masked && j < c.lane)) ? 1 : 0; }
            const bool sel = cnt < TOPK;
            const float ssum = wave_sum(sel ? score : 0.f, c.lane);
            if (sel) {
                const int lr = atomicAdd(&hist[c.lane], 1);
                TOPE[t * 8 + cnt] = c.lane | (lr << 8);
                TOPW[t * 8 + cnt] = score / ssum * 2.5f;
            }
        }
        __syncthreads();
        if (c.tid < 64) BLKCNT[vb * 64 + c.tid] = hist[c.tid];
        __syncthreads();
    }
}

__device__ __forceinline__ void ph_tables(CArgs& a, const Ctx& c) {
    const int* BLKCNT = (const int*)(a.ws + WS_BLKCNT); const int* TOPE = (const int*)(a.ws + WS_TOPE); const float* TOPW = (const float*)(a.ws + WS_TOPW);
    int* SEG = (int*)(a.ws + WS_SEG); int* TOKSLOT = (int*)(a.ws + WS_TOKSLOT); int* SLOTTOK = (int*)(a.ws + WS_SLOTTOK); float* SLOTW = (float*)(a.ws + WS_SLOTW); int* SLOTE = (int*)(a.ws + WS_SLOTE);
    int* psum = (int*)c.lds;
    int* segstart = psum + 512;
    int* segcnt = segstart + 128;
    int* base = segcnt + 128;
    { const int e = c.tid & 63, p = c.tid >> 6; int s = 0;
      for (int v = 0; v < 32; ++v) s += BLKCNT[(p * 32 + v) * 64 + e];
      psum[p * 64 + e] = s; }
    __syncthreads();
    if (c.tid < 128) { const int h = c.tid >> 6, e = c.tid & 63;
        segcnt[c.tid] = psum[(h * 4 + 0) * 64 + e] + psum[(h * 4 + 1) * 64 + e] + psum[(h * 4 + 2) * 64 + e] + psum[(h * 4 + 3) * 64 + e]; }
    __syncthreads();
    if (c.tid < 128) { const int h = c.tid >> 6, e = c.tid & 63; int s = h * (NSLOT_R / 2);
        for (int e2 = 0; e2 < e; ++e2) s += segcnt[h * 64 + e2];
        segstart[c.tid] = s; }
    __syncthreads();
    if (c.blk == 0) {
        if (c.tid < 128) { const int h = c.tid >> 6, e = c.tid & 63; SEG[(h * 65 + e) * 2] = segstart[c.tid]; SEG[(h * 65 + e) * 2 + 1] = segcnt[c.tid]; }
        if (c.tid < 2) { SEG[(c.tid * 65 + 64) * 2] = NSLOT_R + HALF_T * c.tid; SEG[(c.tid * 65 + 64) * 2 + 1] = HALF_T; }
    }
    for (int vb = c.blk; vb < NVB; vb += c.G) {
        if (c.tid < 64) { const int e = c.tid, h = vb >> 7, p = vb >> 5; int s = segstart[h * 64 + e];
            for (int p2 = h * 4; p2 < p; ++p2) s += psum[p2 * 64 + e];
            for (int v = p * 32; v < vb; ++v) s += BLKCNT[v * 64 + e];
            base[e] = s; }
        __syncthreads();
        { const int t = vb * 64 + (c.tid >> 3), k = c.tid & 7; const int pe = TOPE[t * 8 + k], e = pe & 255, lr = pe >> 8;
          const int slot = base[e] + lr;
          SLOTTOK[slot] = t; SLOTW[slot] = TOPW[t * 8 + k]; SLOTE[slot] = e; TOKSLOT[t * 8 + k] = slot; }
        __syncthreads();
    }
}

__device__ __forceinline__ void ph_gateup_naive(CArgs& a, const Ctx& c) {
    const bf16_t* HX2 = (const bf16_t*)(a.ws + WS_HX); const bf16_t* WGU = (const bf16_t*)(a.ws + WS_WGU); bf16_t* ACT = (bf16_t*)(a.ws + WS_ACT);
    const int* SLOTTOK = (const int*)(a.ws + WS_SLOTTOK); const float* SLOTW = (const float*)(a.ws + WS_SLOTW); const int* SLOTE = (const int*)(a.ws + WS_SLOTE);
    const size_t total = (size_t)NSLOT * FF;
    for (size_t idx = (size_t)c.blk * 512 + c.tid; idx < total; idx += (size_t)c.G * 512) {
        const int s = (int)(idx >> 8), f = (int)(idx & 255);
        int tok, e; float w;
        if (s < NSLOT_R) { tok = SLOTTOK[s]; e = SLOTE[s]; w = SLOTW[s]; } else { tok = s - NSLOT_R; e = 64; w = 1.f; }
        const int rg = 256 * (f >> 7) + (f & 127);
        const bf16_t* xr = HX2 + (size_t)tok * DM; const bf16_t* wb = WGU + ((size_t)e * 512 + rg) * DM;
        const float g = ndot(xr, wb, DM), u = ndot(xr, wb + (size_t)128 * DM, DM);
        ACT[idx] = (bf16_t)f2bf(silu_f(g) * u * w);
    }
}
__device__ __forceinline__ void ph_down_naive(CArgs& a, const Ctx& c, int h) {
    const bf16_t* ACT = (const bf16_t*)(a.ws + WS_ACT); const bf16_t* WD = (const bf16_t*)(a.ws + WS_WD); bf16_t* Y = (bf16_t*)(a.ws + WS_Y);
    const int* SLOTE = (const int*)(a.ws + WS_SLOTE);
    const size_t total = (size_t)YROWS * DM;
    for (size_t idx = (size_t)c.blk * 512 + c.tid; idx < total; idx += (size_t)c.G * 512) {
        const int r = (int)(idx >> 10), j = (int)(idx & 1023);
        int s, e;
        if (r < NSLOT_R / 2) { s = h * (NSLOT_R / 2) + r; e = SLOTE[s]; } else { s = NSLOT_R + h * HALF_T + (r - NSLOT_R / 2); e = 64; }
        Y[idx] = (bf16_t)f2bf(ndot(ACT + (size_t)s * FF, WD + ((size_t)e * DM + j) * FF, FF));
    }
}
__device__ __forceinline__ void ph_combine(CArgs& a, const Ctx& c, int h) {
    const bf16_t* Y = (const bf16_t*)(a.ws + WS_Y); const int* TOKSLOT = (const int*)(a.ws + WS_TOKSLOT); const float* MODS = (const float*)(a.ws + WS_MODS);
    const int gw = c.blk * 8 + c.wave, NGW = c.G * 8;
    for (int i = gw; i < HALF_T; i += NGW) {
        const int t = h * HALF_T + i, b = t / NSEQ;
        float v[16];
#pragma unroll
        for (int j = 0; j < 16; ++j) v[j] = 0.f;
#pragma unroll
        for (int k = 0; k < 9; ++k) {
            const int r = (k < 8) ? (TOKSLOT[t * 8 + k] - h * (NSLOT_R / 2)) : (NSLOT_R / 2 + i);
#pragma unroll
            for (int j = 0; j < 4; ++j) { const uint2 w = *(const uint2*)(Y + (size_t)r * DM + 4 * c.lane + 256 * j);
                v[4 * j] += bflo(w.x); v[4 * j + 1] += bfhi(w.x); v[4 * j + 2] += bflo(w.y); v[4 * j + 3] += bfhi(w.y); }
        }
        float ss = 0.f;
#pragma unroll
        for (int j = 0; j < 16; ++j) ss += v[j] * v[j];
        const float rs = rsqrtf(wave_sum(ss, c.lane) * (1.f / DM) + EPS);
        const float* md = MODS + (size_t)b * 6144 + 5120;
#pragma unroll
        for (int j = 0; j < 4; ++j) {
            const int col = 4 * c.lane + 256 * j;
            float4 x1 = *(const float4*)(a.out + (size_t)t * DM + col); const float4 g = *(const float4*)(a.in[I_GPOSTFFN] + col), gf = *(const float4*)(md + col);
            x1.x += gf.x * (v[4 * j] * rs * g.x); x1.y += gf.y * (v[4 * j + 1] * rs * g.y); x1.z += gf.z * (v[4 * j + 2] * rs * g.z); x1.w += gf.w * (v[4 * j + 3] * rs * g.w);
            *(float4*)(a.out + (size_t)t * DM + col) = x1;
        }
    }
}


constexpr int LDS_TAB = 128 * 1024;
constexpr int LDS_OAN = 132 * 1024;
namespace pg8 {
typedef short bf16x8 __attribute__((ext_vector_type(8)));
typedef float f32x4 __attribute__((ext_vector_type(4)));
typedef unsigned u32x4 __attribute__((ext_vector_type(4)));
typedef unsigned u32x2 __attribute__((ext_vector_type(2)));
constexpr int BM = 256, BK = 64, HALF = 128, HTB = HALF * BK * 2, STAGE_BYTES = 8 * HTB;
__device__ __forceinline__ int lds_byte(int r, int c) { const int st = (r >> 4) * 2 + (c >> 5), rr = r & 15, cc = c & 31, ob = rr * 64 + cc * 2; return st * 1024 + (ob ^ (((ob >> 9) & 1) << 5)); }
__device__ __forceinline__ void stage_rc(int b, int& R, int& C) { const int st = b / 1024, sb = b % 1024, swz = sb ^ (((sb >> 9) & 1) << 5); R = (st >> 1) * 16 + swz / 64; C = (st & 1) * 32 + (swz % 64) / 2; }
__device__ __forceinline__ int perm32(int rho) { const int n = rho >> 4, i = rho & 15; return 8 * (i >> 2) + 4 * n + (i & 3); }
__device__ __forceinline__ int xcd_remap(int L, int nwg) { const int q = nwg / 8, r = nwg % 8, xcd = L % 8, off = L / 8; return (xcd < r ? xcd * (q + 1) : r * (q + 1) + (xcd - r) * q) + off; }
__device__ __forceinline__ unsigned cvt_pk_bf16(float lo, float hi) { unsigned r; asm volatile("v_cvt_pk_bf16_f32 %0, %1, %2" : "=v"(r) : "v"(lo), "v"(hi)); return r; }

struct Unit { int row0, nvalid, pn, aux; };

template <class Epi, class Sched, bool ALIGN_EPI, int K>
__device__ __forceinline__ void gemm_phase(LAS unsigned char* lds, const Sched& S, const Epi& E, const int tid) {
    const int wid = __builtin_amdgcn_readfirstlane(tid >> 6), lane = tid & 63, wr = wid >> 2, wc = wid & 3, fr = lane & 15, fq = lane >> 4;
    constexpr int nt = K / BK;
    unsigned voffB[2];
#pragma unroll
    for (int i = 0; i < 2; ++i) { int R, C; stage_rc(tid * 16 + i * 8192, R, C); const int Rb = Epi::PERM ? ((R & ~31) + perm32(R & 31)) : R;
        voffB[i] = (unsigned)(Rb * K + C) * 2u; }
    LAS u32x4* const oAnL = (LAS u32x4*)(lds + LDS_OAN) + tid;
    const size_t kstep = (size_t)(BK * 2);
    const size_t hstepB = (size_t)HALF * K * 2;
    const unsigned ldsw = (unsigned)wid * 1024u;
    const int aoff = lds_byte(wr * 64 + fr, fq * 8), boff = lds_byte(wc * 32 + fr, fq * 8);
#define PG8_SA(b, h) (((b) * 2 + (h)) * HTB)
#define PG8_SB(b, h) ((4 + (b) * 2 + (h)) * HTB)
#define PG8_STAGE(bufoff, gbase, voff) do { _Pragma("unroll") for (int _i = 0; _i < 2; ++_i) \
        __builtin_amdgcn_global_load_lds((const unsigned*)((const char*)(gbase) + (voff)[_i]), (LAS unsigned*)(lds + (bufoff) + ldsw + _i * 8192), 16, 0, 0); } while (0)
#define PG8_LDA(dst, b, h) do { _Pragma("unroll") for (int m = 0; m < 4; ++m) _Pragma("unroll") for (int k = 0; k < 2; ++k) dst[m][k] = *(const LAS bf16x8*)(lds + PG8_SA(b, h) + aoff + m * 2048 + k * 1024); } while (0)
#define PG8_LDB(dst, b, h) do { _Pragma("unroll") for (int n = 0; n < 2; ++n) _Pragma("unroll") for (int k = 0; k < 2; ++k) dst[n][k] = *(const LAS bf16x8*)(lds + PG8_SB(b, h) + boff + n * 2048 + k * 1024); } while (0)
#define PG8_MMA(ai, bj, At, Bt) do { __builtin_amdgcn_s_setprio(1); _Pragma("unroll") for (int m = 0; m < 4; ++m) _Pragma("unroll") for (int n = 0; n < 2; ++n) _Pragma("unroll") for (int k = 0; k < 2; ++k) \
        acc[ai][bj][m][n] = __builtin_amdgcn_mfma_f32_16x16x32_bf16(Bt[n][k], At[m][k], acc[ai][bj][m][n], 0, 0, 0); __builtin_amdgcn_s_setprio(0); } while (0)
#define PG8_WAIT_V(n) asm volatile("s_waitcnt vmcnt(" #n ")" ::: "memory")
#define PG8_WAIT_L(n) asm volatile("s_waitcnt lgkmcnt(" #n ")" ::: "memory")
#define PG8_BAR __builtin_amdgcn_s_barrier()
#define PG8_SCHED __builtin_amdgcn_sched_barrier(0)
    Unit cur, nxt; int ui = 0;
    if (!S.next(0, cur)) return;
    f32x4 acc[2][2][4][2];
#pragma unroll
    for (int a = 0; a < 2; ++a)
#pragma unroll
        for (int b = 0; b < 2; ++b)
#pragma unroll
            for (int m = 0; m < 4; ++m)
#pragma unroll
                for (int n = 0; n < 2; ++n) acc[a][b][m][n] = (f32x4){0.f, 0.f, 0.f, 0.f};
    bf16x8 At[4][2], B0[2][2], B1[2][2];
    unsigned oAc[2][2];
    S.a_off(cur, tid, oAc);
    const char* const Ab = S.a_base();
    const char* cB = S.b_base(cur);
    PG8_STAGE(PG8_SB(0, 0), cB, voffB); PG8_STAGE(PG8_SB(0, 1), cB + hstepB, voffB); PG8_STAGE(PG8_SA(0, 0), Ab, oAc[0]); PG8_STAGE(PG8_SA(0, 1), Ab, oAc[1]);
    if (wr == 1) PG8_BAR;
    PG8_WAIT_V(2); PG8_BAR;
    PG8_STAGE(PG8_SB(1, 0), cB + kstep, voffB); PG8_STAGE(PG8_SA(1, 0), Ab + kstep, oAc[0]); PG8_STAGE(PG8_SB(1, 1), cB + hstepB + kstep, voffB);
    PG8_WAIT_V(6); PG8_BAR;
    for (;;) {
        const bool has_next = S.next(ui + 1, nxt);
        if (has_next) { unsigned t_[2][2]; S.a_off(nxt, tid, t_); *oAnL = (u32x4){t_[0][0], t_[0][1], t_[1][0], t_[1][1]}; }
        const char* nB = has_next ? S.b_base(nxt) : cB;
#pragma unroll 1
        for (int t = 0; t < nt; t += 2) {
            const bool last = (t == nt - 2);
            const char* a1 = Ab + (size_t)(t + 1) * kstep;
            const char* a2 = last ? Ab : Ab + (size_t)(t + 2) * kstep; const char* b2 = last ? nB : cB + (size_t)(t + 2) * kstep;
            const char* a3 = a2 + kstep; const char* b3 = b2 + kstep;
            PG8_LDB(B0, 0, 0); PG8_LDB(B1, 0, 1); PG8_SCHED; PG8_LDA(At, 0, 0); PG8_STAGE(PG8_SA(1, 1), a1, oAc[1]);
            if (last && has_next) { const u32x4 q = *oAnL; oAc[0][0] = q.x; oAc[0][1] = q.y; oAc[1][0] = q.z; oAc[1][1] = q.w; }
            PG8_WAIT_V(8); PG8_WAIT_L(0); PG8_BAR; PG8_MMA(0, 0, At, B0); PG8_MMA(0, 1, At, B1); PG8_BAR; PG8_SCHED;
            PG8_LDA(At, 0, 1); PG8_STAGE(PG8_SB(0, 0), b2, voffB); PG8_STAGE(PG8_SB(0, 1), b2 + hstepB, voffB); PG8_STAGE(PG8_SA(0, 0), a2, oAc[0]);
            PG8_WAIT_V(8); PG8_WAIT_L(0); PG8_BAR; PG8_MMA(1, 0, At, B0); PG8_MMA(1, 1, At, B1); PG8_BAR; PG8_SCHED;
            PG8_LDB(B0, 1, 0); PG8_LDB(B1, 1, 1); PG8_SCHED; PG8_LDA(At, 1, 0); PG8_STAGE(PG8_SA(0, 1), a2, oAc[1]);
            PG8_WAIT_V(8); PG8_WAIT_L(0); PG8_BAR; PG8_MMA(0, 0, At, B0); PG8_MMA(0, 1, At, B1); PG8_BAR; PG8_SCHED;
            PG8_LDA(At, 1, 1); PG8_STAGE(PG8_SB(1, 0), b3, voffB); PG8_STAGE(PG8_SB(1, 1), b3 + hstepB, voffB); PG8_STAGE(PG8_SA(1, 0), a3, oAc[0]);
            PG8_WAIT_V(8); PG8_WAIT_L(0); PG8_BAR; PG8_MMA(1, 0, At, B0); PG8_MMA(1, 1, At, B1); PG8_BAR; PG8_SCHED;
        }
        if constexpr (ALIGN_EPI) { if (wr == 0) PG8_BAR; }
        E(acc, cur, wr, wc, fr, fq);
        if (!has_next) break;
#pragma unroll
        for (int a = 0; a < 2; ++a)
#pragma unroll
            for (int b = 0; b < 2; ++b)
#pragma unroll
                for (int m = 0; m < 4; ++m)
#pragma unroll
                    for (int n = 0; n < 2; ++n) acc[a][b][m][n] = (f32x4){0.f, 0.f, 0.f, 0.f};
        cur = nxt; cB = nB; ++ui;
        if constexpr (ALIGN_EPI) { if (wr == 1) PG8_BAR; }
    }
    PG8_WAIT_V(0);
    if constexpr (!ALIGN_EPI) { if (wr == 0) PG8_BAR; }
    PG8_BAR;
#undef PG8_SA
#undef PG8_SB
#undef PG8_STAGE
#undef PG8_LDA
#undef PG8_LDB
#undef PG8_MMA
#undef PG8_WAIT_V
#undef PG8_WAIT_L
#undef PG8_BAR
#undef PG8_SCHED
}

struct DenseSched {
    const char* A; const char* Bt; int nN, nwg, G, c, nmain;
    __device__ __forceinline__ bool next(int i, Unit& u) const {
        const int L = i * G + c; if (L >= nwg) return false;
        const int wgid = xcd_remap(L, nwg);
        if (wgid < nmain) { const int nig = 8 * nN, gid = wgid / nig, w = wgid % nig; u.row0 = 256 * (gid * 8 + (w % 8)); u.pn = w / 8; }
        else { const int j = wgid - nmain; u.row0 = T + 256 * (j >> 2); u.pn = 2 + (j & 3); }
        u.nvalid = 256; u.aux = 0; return true;
    }
    __device__ __forceinline__ const char* a_base() const { return A; }
    __device__ __forceinline__ const char* b_base(const Unit& u) const { return Bt + (size_t)u.pn * 256 * DM * 2; }
    __device__ __forceinline__ void a_off(const Unit& u, int tid, unsigned (&o)[2][2]) const {
#pragma unroll
        for (int i = 0; i < 2; ++i) { int R, C; stage_rc(tid * 16 + i * 8192, R, C);
#pragma unroll
            for (int h = 0; h < 2; ++h) o[h][i] = (unsigned)((u.row0 + 128 * h + R) * DM + C) * 2u; }
    }
};
constexpr int GT_MAXSEG = 132;
struct GroupedSched {
    const char* A; const char* Bt; const int* slottok; const LAS int* tab; int nseg, npn, nwg, G, c, K, brows;
    __device__ __forceinline__ bool next(int i, Unit& u) const {
        const int L = i * G + c; if (L >= nwg) return false;
        const int wgid = xcd_remap(L, nwg), tl = wgid / npn; u.pn = wgid % npn;
        int s = 0; while (tab[s + 1] <= tl) ++s;
        const int off = 256 * (tl - tab[s]);
        u.row0 = tab[GT_MAXSEG + s] + off; const int rem = tab[2 * GT_MAXSEG + s] - off; u.nvalid = rem < 256 ? rem : 256; u.aux = tab[3 * GT_MAXSEG + s];
        return true;
    }
    __device__ __forceinline__ const char* a_base() const { return A; }
    __device__ __forceinline__ const char* b_base(const Unit& u) const { return Bt + ((size_t)u.aux * brows + (size_t)u.pn * 256) * K * 2; }
    __device__ __forceinline__ void a_off(const Unit& u, int tid, unsigned (&o)[2][2]) const {
#pragma unroll
        for (int i = 0; i < 2; ++i) { int R, C; stage_rc(tid * 16 + i * 8192, R, C);
#pragma unroll
            for (int h = 0; h < 2; ++h) {
                int r = 128 * h + R;
                if (slottok) { if (r >= u.nvalid) r = u.nvalid - 1; const int slot = u.row0 + r; const int tok = (u.aux < 64) ? slottok[slot] : slot - NSLOT_R; o[h][i] = (unsigned)(tok * K + C) * 2u; }
                else o[h][i] = (unsigned)((u.row0 + r) * K + C) * 2u;
            } }
    }
};
__device__ __forceinline__ int grouped_table(LAS int* tab, const int* SEG, int h0, int h1, const int tid) {
    const int nseg = (h1 - h0) * 65;
    if (tid < nseg) { const int h = h0 + tid / 65, e = tid % 65; const int st = SEG[(h * 65 + e) * 2], cn = SEG[(h * 65 + e) * 2 + 1];
        tab[GT_MAXSEG + tid] = st; tab[2 * GT_MAXSEG + tid] = cn; tab[3 * GT_MAXSEG + tid] = e; tab[4 * GT_MAXSEG + tid] = (cn + 255) >> 8; }
    __syncthreads();
    if (tid <= nseg) { int s = 0; for (int j = 0; j < tid; ++j) s += tab[4 * GT_MAXSEG + j]; tab[tid] = s; }
    __syncthreads();
    return tab[nseg];
}

struct EpiStore {
    static constexpr bool PERM = true;
    bf16_t* C; int ldc; int rowsub, rowsub_sh;
    __device__ __forceinline__ void operator()(const f32x4 (&acc)[2][2][4][2], const Unit& u, int wr, int wc, int fr, int fq) const {
        const int col0 = u.pn * 256 + wc * 32 + 8 * fq, crow0 = u.row0 - (u.aux < 64 ? rowsub : rowsub_sh);
        int rb = wr * 64 + fr; asm volatile("" : "+v"(rb));
#pragma unroll
        for (int ai = 0; ai < 2; ++ai)
#pragma unroll
            for (int m = 0; m < 4; ++m) { const int r = ai * 128 + m * 16 + rb;
                if (r < u.nvalid) { bf16_t* rowp = C + (size_t)(crow0 + r) * ldc + col0;
#pragma unroll
                    for (int bj = 0; bj < 2; ++bj) { const f32x4 v0 = acc[ai][bj][m][0], v1 = acc[ai][bj][m][1];
                        u32x4 w; w.x = cvt_pk_bf16(v0[0], v0[1]); w.y = cvt_pk_bf16(v0[2], v0[3]); w.z = cvt_pk_bf16(v1[0], v1[1]); w.w = cvt_pk_bf16(v1[2], v1[3]);
                        *(u32x4*)(rowp + bj * 128) = w; } } }
    }
};
struct EpiGateUp {
    static constexpr bool PERM = true;
    bf16_t* ACT; const float* slotw;
    __device__ __forceinline__ void operator()(const f32x4 (&acc)[2][2][4][2], const Unit& u, int wr, int wc, int fr, int fq) const {
        const int col0 = u.pn * 128 + wc * 32 + 8 * fq;
        int rb = wr * 64 + fr; asm volatile("" : "+v"(rb));
#pragma unroll
        for (int ai = 0; ai < 2; ++ai)
#pragma unroll
            for (int m = 0; m < 4; ++m) { const int r = ai * 128 + m * 16 + rb;
                if (r < u.nvalid) { const int slot = u.row0 + r; const float w = (u.aux < 64) ? slotw[slot] : 1.f;
                    float o[8];
#pragma unroll
                    for (int n = 0; n < 2; ++n)
#pragma unroll
                        for (int i = 0; i < 4; ++i) { const float g = acc[ai][0][m][n][i], up = acc[ai][1][m][n][i]; o[4 * n + i] = g / (1.f + __expf(-g)) * up * w; }
                    u32x4 pk; pk.x = cvt_pk_bf16(o[0], o[1]); pk.y = cvt_pk_bf16(o[2], o[3]); pk.z = cvt_pk_bf16(o[4], o[5]); pk.w = cvt_pk_bf16(o[6], o[7]);
                    *(u32x4*)(ACT + (size_t)slot * FF + col0) = pk; } }
    }
};
struct EpiInProj {
    static constexpr bool PERM = false;
    bf16_t *Q, *Kb, *Vb, *P; const float* rope;
    __device__ __forceinline__ void operator()(const f32x4 (&acc)[2][2][4][2], const Unit& u, int wr, int wc, int fr, int fq) const {
        const bool latent = u.row0 < T; const int sec = u.pn >> 1;
        const bool dorope = latent && sec < 2;
        bf16_t* dstU; int n0 = 0;
        if (latent) { const int b = u.row0 / NSEQ; n0 = u.row0 % NSEQ; const size_t kvrow = (size_t)b * SKV + CTXL + n0;
            dstU = sec == 0 ? Q + (size_t)u.row0 * AW : sec == 1 ? Kb + kvrow * AW : sec == 2 ? Vb + kvrow * AW : P + (size_t)u.row0 * PW; }
        else { const int b = (u.row0 - T) / CTXL; dstU = (sec == 1 ? Kb : Vb) + (size_t)b * SKV * AW; }
        dstU += (u.pn & 1) * 256;
        int rb = wr * 64 + fr; asm volatile("" : "+v"(rb));
        const int lcol = wc * 32 + 4 * fq;
#pragma unroll
        for (int ai = 0; ai < 2; ++ai)
#pragma unroll
            for (int m = 0; m < 4; ++m) {
                const int r = ai * 128 + m * 16 + rb;
                f32x4 c4 = (f32x4){1.f, 1.f, 1.f, 1.f}, s4 = (f32x4){0.f, 0.f, 0.f, 0.f};
                if (dorope) { const int pos = (wc & 1) ? (r & 63) : ((n0 >> 6) + (r >> 6)); const float* rp = rope + (pos * 16 + 4 * fq) * 2;
                    const f32x4 cs0 = *(const f32x4*)rp, cs1 = *(const f32x4*)(rp + 4); c4 = (f32x4){cs0[0], cs0[2], cs1[0], cs1[2]}; s4 = (f32x4){cs0[1], cs0[3], cs1[1], cs1[3]}; }
                bf16_t* dst = dstU + r * 512 + lcol;
#pragma unroll
                for (int bj = 0; bj < 2; ++bj) {
                    const f32x4 x1 = acc[ai][bj][m][0], x2 = acc[ai][bj][m][1];
                    const f32x4 o1 = x1 * c4 - x2 * s4, o2 = x2 * c4 + x1 * s4;
                    u32x2 w1, w2; w1.x = cvt_pk_bf16(o1[0], o1[1]); w1.y = cvt_pk_bf16(o1[2], o1[3]); w2.x = cvt_pk_bf16(o2[0], o2[1]); w2.y = cvt_pk_bf16(o2[2], o2[3]);
                    *(u32x2*)(dst + bj * 128) = w1; *(u32x2*)(dst + bj * 128 + 16) = w2;
                }
            }
    }
};
}

__device__ __forceinline__ void ph_inproj_fast(CArgs& a, const Ctx& c) {
    pg8::DenseSched S{(const char*)(a.ws + WS_HX), (const char*)(a.ws + WS_WIN), 8, 528, c.G, c.blk, 512};
    pg8::EpiInProj E{(bf16_t*)(a.ws + WS_Q), (bf16_t*)(a.ws + WS_K), (bf16_t*)(a.ws + WS_V), (bf16_t*)(a.ws + WS_P), (const float*)(a.ws + WS_ROPE)};
    pg8::gemm_phase<pg8::EpiInProj, pg8::DenseSched, true, DM>((LAS unsigned char*)c.lds, S, E, c.tid);
}
__device__ __forceinline__ void ph_outproj_fast(CArgs& a, const Ctx& c) {
    pg8::DenseSched S{(const char*)(a.ws + WS_ATT), (const char*)(a.ws + WS_WOUT), 4, 256, c.G, c.blk, 256};
    pg8::EpiStore E{(bf16_t*)(a.ws + WS_YX), DM, 0, 0};
    pg8::gemm_phase<pg8::EpiStore, pg8::DenseSched, true, DM>((LAS unsigned char*)c.lds, S, E, c.tid);
}
__device__ __forceinline__ void ph_gateup_fast(CArgs& a, const Ctx& c) {
    LAS int* tab = (LAS int*)((LAS unsigned char*)c.lds + LDS_TAB);
    const int ntile = pg8::grouped_table(tab, (const int*)(a.ws + WS_SEG), 0, 2, c.tid);
    pg8::GroupedSched S{(const char*)(a.ws + WS_HX), (const char*)(a.ws + WS_WGU), (const int*)(a.ws + WS_SLOTTOK), tab, 130, 2, ntile * 2, c.G, c.blk, DM, 512};
    pg8::EpiGateUp E{(bf16_t*)(a.ws + WS_ACT), (const float*)(a.ws + WS_SLOTW)};
    pg8::gemm_phase<pg8::EpiGateUp, pg8::GroupedSched, true, DM>((LAS unsigned char*)c.lds, S, E, c.tid);
}
__device__ __forceinline__ void ph_down_fast(CArgs& a, const Ctx& c, int h) {
    LAS int* tab = (LAS int*)((LAS unsigned char*)c.lds + LDS_TAB);
    const int ntile = pg8::grouped_table(tab, (const int*)(a.ws + WS_SEG), h, h + 1, c.tid);
    pg8::GroupedSched S{(const char*)(a.ws + WS_ACT), (const char*)(a.ws + WS_WD), nullptr, tab, 65, 4, ntile * 4, c.G, c.blk, FF, DM};
    pg8::EpiStore E{(bf16_t*)(a.ws + WS_Y), DM, h * (NSLOT_R / 2), NSLOT_R + h * HALF_T - NSLOT_R / 2};
    pg8::gemm_phase<pg8::EpiStore, pg8::GroupedSched, true, FF>((LAS unsigned char*)c.lds, S, E, c.tid);
}


namespace att {
using bf16x8 = __attribute__((ext_vector_type(8))) short;
using s16x4  = __attribute__((ext_vector_type(4))) short;
using f32x16 = __attribute__((ext_vector_type(16))) float;
using u32x4  = __attribute__((ext_vector_type(4))) unsigned;
constexpr int KVBLK = 64, LDK = 512;
constexpr float SCALE = 0.125f, THR = 8.f;
constexpr int SHM_V = KVBLK * 128 * 2, SHM_K = KVBLK * 128 * 2, OFF_WS = 2 * SHM_V + 2 * SHM_K;
#define KSWZ(row, colB) ((row) * 256 + ((colB) ^ (((row) & 7) << 4)))
#define SBAR() __builtin_amdgcn_sched_barrier(0)
__device__ __forceinline__ int crow(int r, int hi) { return (r & 3) + 8 * (r >> 2) + 4 * hi; }
__device__ __forceinline__ unsigned cvtpk(float lo, float hi) { unsigned r; asm volatile("v_cvt_pk_bf16_f32 %0, %1, %2" : "=v"(r) : "v"(lo), "v"(hi)); return r; }
__device__ __forceinline__ void partialSM(f32x16& p0, f32x16& p1, float& m_reg, float& mn, float& alpha) {
  constexpr float C = SCALE * 1.4426950408889634f;
  float pmax = p0[0];
#pragma unroll
  for (int r = 1; r < 16; ++r) pmax = fmaxf(pmax, p0[r]);
#pragma unroll
  for (int r = 0; r < 16; ++r) pmax = fmaxf(pmax, p1[r]);
  { auto rr = __builtin_amdgcn_permlane32_swap(__float_as_uint(pmax), __float_as_uint(pmax), false, false);
    pmax = fmaxf(__uint_as_float(rr[0]), __uint_as_float(rr[1])); }
  if (__builtin_expect(__all(pmax - m_reg <= THR / SCALE), 1)) { mn = m_reg; alpha = 1.f; }
  else { mn = fmaxf(m_reg, pmax); alpha = __builtin_amdgcn_exp2f((m_reg - mn) * C); m_reg = mn; }
  const float mnC = -mn * C;
#pragma unroll
  for (int r = 0; r < 16; ++r) p0[r] = fmaf(p0[r], C, mnC);
#pragma unroll
  for (int r = 0; r < 16; ++r) p1[r] = fmaf(p1[r], C, mnC);
#pragma unroll
  for (int r = 0; r < 16; ++r) p0[r] = __builtin_amdgcn_exp2f(p0[r]);
}
__device__ __forceinline__ void finishSM(f32x16& p0, f32x16& p1, float alpha, float& l_reg, bf16x8& pa0, bf16x8& pa1, bf16x8& pa2, bf16x8& pa3) {
#pragma unroll
  for (int r = 0; r < 16; ++r) p1[r] = __builtin_amdgcn_exp2f(p1[r]);
  float ps = 0;
#pragma unroll
  for (int r = 0; r < 16; ++r) ps += p0[r];
#pragma unroll
  for (int r = 0; r < 16; ++r) ps += p1[r];
  { auto rr = __builtin_amdgcn_permlane32_swap(__float_as_uint(ps), __float_as_uint(ps), false, false);
    ps = __uint_as_float(rr[0]) + __uint_as_float(rr[1]); }
  l_reg = l_reg * alpha + ps;
#define PK4(P, BASE, OUT) do { unsigned a0 = cvtpk(P[BASE + 0], P[BASE + 1]), a1 = cvtpk(P[BASE + 2], P[BASE + 3]);   \
    unsigned b0 = cvtpk(P[BASE + 4], P[BASE + 5]), b1 = cvtpk(P[BASE + 6], P[BASE + 7]);                              \
    auto r0 = __builtin_amdgcn_permlane32_swap(a0, b0, false, false); auto r1 = __builtin_amdgcn_permlane32_swap(a1, b1, false, false); \
    u32x4 w = {r0[0], r1[0], r0[1], r1[1]}; OUT = *reinterpret_cast<bf16x8*>(&w); } while (0)
  PK4(p0, 0, pa0); PK4(p0, 8, pa1); PK4(p1, 0, pa2); PK4(p1, 8, pa3);
#undef PK4
}
__device__ __forceinline__ void qkt(f32x16& p0, f32x16& p1, const char* Ks, const bf16x8* qr, int r32, int hi, int mcol) {
  p0 = f32x16{}; p1 = f32x16{};
#pragma unroll
  for (int d0 = 0; d0 < 4; ++d0) { const int cb = (mcol + d0 * 16 + hi * 8) * 2;
    const bf16x8 b0 = *reinterpret_cast<const bf16x8*>(Ks + KSWZ(r32, cb));
    const bf16x8 b1 = *reinterpret_cast<const bf16x8*>(Ks + KSWZ(32 + r32, cb));
    p0 = __builtin_amdgcn_mfma_f32_32x32x16_bf16(b0, qr[d0], p0, 0, 0, 0);
    p1 = __builtin_amdgcn_mfma_f32_32x32x16_bf16(b1, qr[d0], p1, 0, 0, 0); }
}
__device__ __forceinline__ int v_st(int k, int c) { const int kk = (k & ~0xC) | ((k & 4) << 1) | ((k & 8) >> 1); return ((kk >> 3) * 4 + (c >> 5)) * 512 + ((kk & 7) * 32 + (c & 31)) * 2; }
__device__ __forceinline__ int v_rd_base(int lane) { return ((lane & 3) << 3) | (((lane >> 2) & 3) << 6) | (((lane >> 4) & 1) << 5) | (((lane >> 5) & 1) << 8); }
constexpr int v_rd_off(int d0, int ks, int half) { return d0 * 512 + ks * 4096 + half * 2048; }
template <int OFF> __device__ __forceinline__ s16x4 tr_read(int vb) {
  s16x4 r; asm volatile("ds_read_b64_tr_b16 %0, %1 offset:%2" : "=&v"(r) : "v"(vb), "i"(OFF) : "memory"); return r;
}
template <int D0> __device__ __forceinline__ void pv_one(f32x16& od, int vb, bf16x8 pa0, bf16x8 pa1, bf16x8 pa2, bf16x8 pa3) {
  const s16x4 l0 = tr_read<v_rd_off(D0, 0, 0)>(vb), h0 = tr_read<v_rd_off(D0, 0, 1)>(vb), l1 = tr_read<v_rd_off(D0, 1, 0)>(vb), h1 = tr_read<v_rd_off(D0, 1, 1)>(vb);
  const s16x4 l2 = tr_read<v_rd_off(D0, 2, 0)>(vb), h2 = tr_read<v_rd_off(D0, 2, 1)>(vb), l3 = tr_read<v_rd_off(D0, 3, 0)>(vb), h3 = tr_read<v_rd_off(D0, 3, 1)>(vb);
  asm volatile("s_waitcnt lgkmcnt(0)" ::: "memory"); SBAR();
#define PK(L, H) (bf16x8){L[0], L[1], L[2], L[3], H[0], H[1], H[2], H[3]}
  od = __builtin_amdgcn_mfma_f32_32x32x16_bf16(pa0, PK(l0, h0), od, 0, 0, 0);
  od = __builtin_amdgcn_mfma_f32_32x32x16_bf16(pa1, PK(l1, h1), od, 0, 0, 0);
  od = __builtin_amdgcn_mfma_f32_32x32x16_bf16(pa2, PK(l2, h2), od, 0, 0, 0);
  od = __builtin_amdgcn_mfma_f32_32x32x16_bf16(pa3, PK(l3, h3), od, 0, 0, 0);
#undef PK
}
__device__ __forceinline__ void pv_d0(f32x16* o, int vb, bf16x8 pa0, bf16x8 pa1, bf16x8 pa2, bf16x8 pa3) {
  pv_one<0>(o[0], vb, pa0, pa1, pa2, pa3); pv_one<1>(o[1], vb, pa0, pa1, pa2, pa3); pv_one<2>(o[2], vb, pa0, pa1, pa2, pa3); pv_one<3>(o[3], vb, pa0, pa1, pa2, pa3);
}
__device__ __forceinline__ void unit(const bf16_t* __restrict__ Qb, const bf16_t* __restrict__ Kh, const bf16_t* __restrict__ Vh, bf16_t* __restrict__ Ob,
                                     const float lam, const float* __restrict__ gsub, char* lds, const int tid) {
  const int wid = __builtin_amdgcn_readfirstlane(tid >> 6), lane = tid & 63, r32 = lane & 31, hi = lane >> 5, qsub = wid & 3, map = wid >> 2, mcol = map * 64;
  char* V_lds = lds; char* K_lds = lds + 2 * SHM_V;
  float* ws = (float*)(lds + OFF_WS) + wid * 64; float* li_l = ws; float* al_l = ws + 32;
  float m_reg = -1e30f, l_reg = 0; f32x16 o[4] = {}; bf16x8 qr[4];
  const bf16_t* Qw = Qb + (size_t)(qsub * 32 + r32) * AW + mcol + hi * 8;
#pragma unroll
  for (int d0 = 0; d0 < 4; ++d0) qr[d0] = *reinterpret_cast<const bf16x8*>(Qw + d0 * 16);
  const int sr = tid >> 4, sc = (tid & 15) * 8, vst0 = v_st(sr, sc), vst1 = v_st(32 + sr, sc);
  const int vb0 = (int)(uintptr_t)V_lds + v_rd_base(lane);
  struct { bf16x8 vs0, vs1, ks0, ks1; } sr_[2];
#define SLOAD(i, k0) do { sr_[i].vs0 = *reinterpret_cast<const bf16x8*>(&Vh[(size_t)((k0) + sr) * LDK + sc]); sr_[i].vs1 = *reinterpret_cast<const bf16x8*>(&Vh[(size_t)((k0) + 32 + sr) * LDK + sc]); \
    sr_[i].ks0 = *reinterpret_cast<const bf16x8*>(&Kh[(size_t)((k0) + sr) * LDK + sc]); sr_[i].ks1 = *reinterpret_cast<const bf16x8*>(&Kh[(size_t)((k0) + 32 + sr) * LDK + sc]); } while (0)
#define SWRITE(b, i) do { *(bf16x8*)(V_lds + (b) * SHM_V + vst0) = sr_[i].vs0; *(bf16x8*)(V_lds + (b) * SHM_V + vst1) = sr_[i].vs1; const int kc = sc * 2; \
    *(bf16x8*)(K_lds + (b) * SHM_K + KSWZ(sr, kc)) = sr_[i].ks0; *(bf16x8*)(K_lds + (b) * SHM_K + KSWZ(32 + sr, kc)) = sr_[i].ks1; } while (0)
#define SWAIT() asm volatile("s_waitcnt vmcnt(4)" ::: "memory")
#define RESC(a) do { if (__any((a) < 1.f)) { if (hi == 0) al_l[r32] = (a); asm volatile("s_waitcnt lgkmcnt(0)" ::: "memory"); \
    _Pragma("unroll") for (int d = 0; d < 4; ++d) _Pragma("unroll") for (int r = 0; r < 16; ++r) o[d][r] *= al_l[crow(r, hi)]; } } while (0)
  f32x16 pA0, pA1, pB0, pB1; float mnA, mnB, alA, alB; bf16x8 pa0, pa1, pa2, pa3; constexpr int NT = SKV / KVBLK;
  SLOAD(0, 0); asm volatile("s_waitcnt vmcnt(0)" ::: "memory"); SWRITE(0, 0); __syncthreads();
  qkt(pA0, pA1, K_lds, qr, r32, hi, mcol); partialSM(pA0, pA1, m_reg, mnA, alA);
  SLOAD(1, KVBLK); SLOAD(0, 2 * KVBLK);
  SWAIT(); SWRITE(1, 1); __syncthreads();
  for (int j = 1; j + 1 < NT; j += 2) {
    SBAR(); qkt(pB0, pB1, K_lds + SHM_K, qr, r32, hi, mcol);
    finishSM(pA0, pA1, alA, l_reg, pa0, pa1, pa2, pa3); SBAR();
    SLOAD(1, (j + 2) * KVBLK); SBAR();
    pv_d0(o, vb0, pa0, pa1, pa2, pa3); partialSM(pB0, pB1, m_reg, mnB, alB);
    __syncthreads(); SWAIT(); SWRITE(0, 0);
    RESC(alB); __syncthreads();
    SBAR(); qkt(pA0, pA1, K_lds, qr, r32, hi, mcol);
    finishSM(pB0, pB1, alB, l_reg, pa0, pa1, pa2, pa3); SBAR();
    if (j + 3 < NT) SLOAD(0, (j + 3) * KVBLK); SBAR();
    pv_d0(o, vb0 + SHM_V, pa0, pa1, pa2, pa3); partialSM(pA0, pA1, m_reg, mnA, alA);
    __syncthreads(); SWAIT(); SWRITE(1, 1);
    RESC(alA); __syncthreads();
  }
  SBAR(); qkt(pB0, pB1, K_lds + SHM_K, qr, r32, hi, mcol);
  finishSM(pA0, pA1, alA, l_reg, pa0, pa1, pa2, pa3); SBAR();
  pv_d0(o, vb0, pa0, pa1, pa2, pa3); partialSM(pB0, pB1, m_reg, mnB, alB);
  __syncthreads(); RESC(alB);
  finishSM(pB0, pB1, alB, l_reg, pa0, pa1, pa2, pa3); SBAR();
  pv_d0(o, vb0 + SHM_V, pa0, pa1, pa2, pa3);
  if (hi == 0) li_l[r32] = l_reg; asm volatile("s_waitcnt lgkmcnt(0)" ::: "memory");
  float rli[16];
#pragma unroll
  for (int r = 0; r < 16; ++r) rli[r] = __builtin_amdgcn_rcpf(li_l[crow(r, hi)]);
  __syncthreads();
  float* X2 = (float*)lds + qsub * 4096 + lane;
  if (map == 1) {
#pragma unroll
    for (int r = 0; r < 16; ++r)
#pragma unroll
      for (int d0 = 0; d0 < 4; ++d0) X2[(r * 4 + d0) * 64] = o[d0][r] * rli[r];
  }
  __syncthreads();
  if (map == 0) {
    float g[4];
#pragma unroll
    for (int d0 = 0; d0 < 4; ++d0) g[d0] = gsub[32 * d0 + r32] * (1.f - LAM_INIT);
#pragma unroll
    for (int r = 0; r < 16; ++r) {
      float ss = 0.f;
#pragma unroll
      for (int d0 = 0; d0 < 4; ++d0) { const float v = o[d0][r] * rli[r] - lam * X2[(r * 4 + d0) * 64]; o[d0][r] = v; ss += v * v; }
#pragma unroll
      for (int m = 1; m < 32; m <<= 1) ss += shx(ss, m, lane);
      const float rs = rsqrtf(ss * (1.f / 128.f) + EPS);
      bf16_t* orow = Ob + (size_t)(qsub * 32 + crow(r, hi)) * DM + r32;
#pragma unroll
      for (int d0 = 0; d0 < 4; ++d0) orow[32 * d0] = (bf16_t)f2bf(o[d0][r] * rs * g[d0]);
    }
  }
  __syncthreads();
#undef SLOAD
#undef SWRITE
#undef SWAIT
#undef RESC
}
#undef KSWZ
#undef SBAR
}
__device__ __forceinline__ void ph_attn_fast(CArgs& a, const Ctx& c) {
  const bf16_t* Q = (const bf16_t*)(a.ws + WS_Q); const bf16_t* Kb = (const bf16_t*)(a.ws + WS_K); const bf16_t* Vb = (const bf16_t*)(a.ws + WS_V); bf16_t* ATT = (bf16_t*)(a.ws + WS_ATT);
  const float lam = *(const float*)(a.ws + WS_LAM);
  constexpr int NU = NB * NH * (NSEQ / 128);
  for (int i = 0; ; ++i) {
    const int L = i * c.G + c.blk; if (L >= NU) break;
    const int v = pg8::xcd_remap(L, NU), qb = v & 31, bh = v >> 5, b = bh >> 2, h = bh & 3;
    const size_t row0 = (size_t)b * NSEQ + qb * 128;
    att::unit(Q + row0 * AW + h * 128, Kb + (size_t)b * SKV * AW + h * 128, Vb + (size_t)b * SKV * AW + h * 128, ATT + row0 * DM + h * 128, lam, a.in[I_GSUBLN], (char*)c.lds, c.tid);
  }
}

constexpr int NPHASE = 13;
__device__ __forceinline__ void run_phase(int ph, CArgs& a, const Ctx& c) {
    switch (ph) {
        case 0: ph_adaln(a, c); break;
        case 1: ph_prep(a, c); break;
#if FAST_INPROJ
        case 2: ph_inproj_fast(a, c); break;
        case 3: break;
#else
        case 2: naive_gemm((const bf16_t*)(a.ws + WS_HX), (const bf16_t*)(a.ws + WS_WIN), (bf16_t*)(a.ws + WS_PXB), TT, INW, DM, c); break;
        case 3: ph_rope_scatter(a, c); break;
#endif
#if FAST_ATTN
        case 4: ph_attn_fast(a, c); __syncthreads(); ph_pool_naive(a, c); break;
#else
        case 4: ph_attn_naive(a, c); __syncthreads(); ph_pool_naive(a, c); break;
#endif
#if FAST_OUTPROJ
        case 5: ph_outproj_fast(a, c); break;
#else
        case 5: naive_gemm((const bf16_t*)(a.ws + WS_ATT), (const bf16_t*)(a.ws + WS_WOUT), (bf16_t*)(a.ws + WS_YX), T, DM, DM, c); break;
#endif
        case 6: ph_norm_router(a, c); break;
        case 7: ph_tables(a, c); break;
#if FAST_GATEUP
        case 8: ph_gateup_fast(a, c); break;
#else
        case 8: ph_gateup_naive(a, c); break;
#endif
#if FAST_DOWN
        case 9: ph_down_fast(a, c, 0); break;
        case 11: ph_down_fast(a, c, 1); break;
#else
        case 9: ph_down_naive(a, c, 0); break;
        case 11: ph_down_naive(a, c, 1); break;
#endif
        case 10: ph_combine(a, c, 0); break;
        case 12: ph_combine(a, c, 1); break;
        default: break;
    }
}
__global__ void __launch_bounds__(512, 2) mega(Args a_) {
    extern __shared__ __attribute__((aligned(16))) unsigned char lds[];
    const int lo = a_.ph_lo, hi = a_.ph_hi;
    { volatile LAS unsigned* z = (volatile LAS unsigned*)((LAS unsigned char*)lds + LDSCTL_OFF); for (int u = threadIdx.x; u < (LDS_BYTES - LDSCTL_OFF) / 4; u += 512) z[u] = 0u; }
    __syncthreads();
    volatile LAS unsigned* MISC = (volatile LAS unsigned*)((LAS unsigned char*)lds + MISC_OFF);
    XcdBarrier bar; bar.bar = (unsigned*)(a_.ws + WS_CTL); bar.x = 0; bar.st = nullptr;
    if (hi - lo > 1) bar = xcd_barrier_post((unsigned*)(a_.ws + WS_CTL), MISC + 8);
#define PHASE(k) if (lo <= (k) && (k) < hi) { \
        int t_ = threadIdx.x; asm volatile("" : "+v"(t_)); \
        CArgs* ap_ = (CArgs*)__builtin_amdgcn_kernarg_segment_ptr(); asm volatile("" : "+s"(ap_)); \
        Ctx c; c.tid = t_; c.lane = t_ & 63; c.wave = __builtin_amdgcn_readfirstlane(t_ >> 6); c.blk = blockIdx.x; c.G = gridDim.x; c.lds = lds; \
        run_phase((k), *ap_, c); \
        if ((k) + 1 < hi) xcd_barrier(bar); }
    PHASE(0) PHASE(1) PHASE(2) PHASE(3) PHASE(4) PHASE(5) PHASE(6) PHASE(7) PHASE(8) PHASE(9) PHASE(10) PHASE(11) PHASE(12)
#undef PHASE
}

extern "C" void kernel_launch(void* const* d_in, const int* in_sizes, int n_in, void* d_out, int out_size, void* d_ws, size_t ws_size, hipStream_t stream) {
    static int grid = 0;
    if (grid == 0) {
        if (n_in != 28 || in_sizes[0] != T * DM || out_size != T * DM || ws_size < WS_END) {
            fprintf(stderr, "kernel_launch: unexpected shapes or workspace: n_in %d in0 %d out %d ws %zu (need %zu)\n", n_in, n_in > 0 ? in_sizes[0] : -1, out_size, ws_size, (size_t)WS_END);
            grid = -1; return; }
        int dev = 0, cus = 0;
        if (hipGetDevice(&dev) != hipSuccess || hipDeviceGetAttribute(&cus, hipDeviceAttributeMultiprocessorCount, dev) != hipSuccess) { grid = -1; return; }
        if (hipFuncSetAttribute((const void*)mega, hipFuncAttributeMaxDynamicSharedMemorySize, LDS_BYTES) != hipSuccess) { fprintf(stderr, "kernel_launch: hipFuncSetAttribute failed\n"); grid = -1; return; }
        grid = cus;
    }
    if (grid < 0) return;
    (void)hipMemsetAsync((char*)d_ws + WS_CTL, 0, CTL_ZERO_BYTES, stream);
    Args a{};
    for (int i = 0; i < 28; ++i) a.in[i] = (const float*)d_in[i];
    a.out = (float*)d_out; a.ws = (unsigned char*)d_ws;
#if MK_PER_PHASE_LAUNCH
    for (int p = 0; p < NPHASE; ++p) { a.ph_lo = p; a.ph_hi = p + 1; hipLaunchKernelGGL(mega, dim3(grid), dim3(512), LDS_BYTES, stream, a); }
#else
    a.ph_lo = 0; a.ph_hi = NPHASE; hipLaunchKernelGGL(mega, dim3(grid), dim3(512), LDS_BYTES, stream, a);
#endif
    const hipError_t le = hipPeekAtLastError();
    if (le != hipSuccess) fprintf(stderr, "kernel_launch: launch failed: %s\n", hipGetErrorName(le));
}
```

```cpp
#include <hip/hip_runtime.h>
#include <cstdio>
#include <cstdint>

#ifndef REPEAT_PH
#define REPEAT_PH (-1)
#endif
#ifndef REPEAT_N
#define REPEAT_N 1
#endif
#ifndef MK_PER_PHASE_LAUNCH
#define MK_PER_PHASE_LAUNCH 0
#endif

constexpr int NB = 4, NSEQ = 4096, DM = 1024, T = NB * NSEQ, CTXL = 256, TC = NB * CTXL, TT = T + TC;
constexpr int NH = 4, DQK = 64, DV = 128, AW = 512, INW = 2048, PW = 512;
constexpr int SKV = CTXL + NSEQ;
constexpr int NE = 64, FF = 256, TOPK = 8;
constexpr int NSLOT_R = T * TOPK;
constexpr int NSLOT = NSLOT_R + T;
constexpr float EPS = 1e-6f;
constexpr float LAM_INIT = 0.2f;
constexpr int NVB = 256;

typedef unsigned short bf16_t;
typedef unsigned int u32;

constexpr size_t KiB = 1024, MiB = 1024 * 1024;
constexpr size_t WS_CTL = 0;
constexpr size_t CTL_ZERO_BYTES = 64 * KiB;
constexpr size_t WS_MODS = 64 * KiB;
constexpr size_t WS_LAM = 192 * KiB;
constexpr size_t WS_ROPE = 196 * KiB;
constexpr size_t WS_SEG = 208 * KiB;
constexpr size_t WS_BLKCNT = 256 * KiB;
constexpr size_t WS_TOPE = 512 * KiB;
constexpr size_t WS_TOPW = 1 * MiB;
constexpr size_t WS_TOKSLOT = 1 * MiB + 512 * KiB;
constexpr size_t WS_SLOTTOK = 2 * MiB;
constexpr size_t WS_SLOTW = 2 * MiB + 512 * KiB;
constexpr size_t WS_SLOTE = 3 * MiB;
constexpr size_t WS_WPOOL = 3 * MiB + 512 * KiB;
constexpr size_t WS_WD = 4 * MiB;
constexpr size_t WS_WGU = WS_WD + 33280 * KiB;
constexpr size_t WS_HX = WS_WGU + 65 * MiB;
constexpr size_t WS_WIN = WS_HX + 34 * MiB;
constexpr size_t WS_WOUT = WS_WIN + 4 * MiB;
constexpr size_t WS_Q = WS_WOUT + 2 * MiB;
constexpr size_t WS_K = WS_Q + 16 * MiB;
constexpr size_t WS_V = WS_K + 17 * MiB;
constexpr size_t WS_P = WS_V + 17 * MiB;
constexpr size_t WS_ATT = WS_P + 16 * MiB;
constexpr size_t WS_YX = WS_ATT + 32 * MiB;
constexpr size_t WS_ACT = 227 * MiB + 256 * KiB;
constexpr size_t WS_Y = WS_WGU;
constexpr size_t WS_END = WS_ACT + (size_t)(NSLOT + 256) * FF * 2;
static_assert(WS_YX + 32 * MiB <= WS_END + 64 * MiB, "map");
static_assert(WS_Y + (size_t)(NSLOT + 256) * DM <= WS_ACT, "Y must not reach ACT");

constexpr int LDS_BYTES = 147456;
constexpr int LDS_MAIN = 140 * 1024;
constexpr int LDSCTL_OFF = LDS_MAIN;
constexpr int MISC_OFF = LDSCTL_OFF + 320;

#define GAS __attribute__((address_space(1)))
#define LAS __attribute__((address_space(3)))

__device__ __forceinline__ u32 f2bf(float f) { u32 u = __float_as_uint(f); return (u + 0x7fffu + ((u >> 16) & 1u)) >> 16; }
__device__ __forceinline__ u32 pk2(float lo, float hi) { return f2bf(lo) | (f2bf(hi) << 16); }
__device__ __forceinline__ float bflo(u32 w) { return __uint_as_float(w << 16); }
__device__ __forceinline__ float bfhi(u32 w) { return __uint_as_float(w & 0xffff0000u); }
__device__ __forceinline__ float bf2f(bf16_t b) { return __uint_as_float(((u32)b) << 16); }
__device__ __forceinline__ float shx(float v, int m, int lane) { return __int_as_float(__builtin_amdgcn_ds_bpermute((lane ^ m) << 2, __float_as_int(v))); }
__device__ __forceinline__ float shl(float v, int src) { return __int_as_float(__builtin_amdgcn_ds_bpermute(src << 2, __float_as_int(v))); }
__device__ __forceinline__ float wave_sum(float v, int lane) {
#pragma unroll
    for (int o = 1; o < 64; o <<= 1) v += shx(v, o, lane);
    return v;
}
__device__ __forceinline__ float wave_max(float v, int lane) {
#pragma unroll
    for (int o = 1; o < 64; o <<= 1) v = fmaxf(v, shx(v, o, lane));
    return v;
}
__device__ __forceinline__ float silu_f(float v) { return v / (1.f + __expf(-v)); }
__device__ __forceinline__ float dot8(uint4 a, uint4 b, float acc) {
    acc = fmaf(bflo(a.x), bflo(b.x), acc); acc = fmaf(bfhi(a.x), bfhi(b.x), acc);
    acc = fmaf(bflo(a.y), bflo(b.y), acc); acc = fmaf(bfhi(a.y), bfhi(b.y), acc);
    acc = fmaf(bflo(a.z), bflo(b.z), acc); acc = fmaf(bfhi(a.z), bfhi(b.z), acc);
    acc = fmaf(bflo(a.w), bflo(b.w), acc); acc = fmaf(bfhi(a.w), bfhi(b.w), acc);
    return acc;
}
__device__ __forceinline__ float ndot(const bf16_t* a, const bf16_t* b, int K) {
    float a0 = 0.f, a1 = 0.f;
    for (int k = 0; k < K; k += 16) {
        const uint4 x0 = *(const uint4*)(a + k), y0 = *(const uint4*)(b + k), x1 = *(const uint4*)(a + k + 8), y1 = *(const uint4*)(b + k + 8);
        a0 = dot8(x0, y0, a0); a1 = dot8(x1, y1, a1);
    }
    return a0 + a1;
}

#define XB_TMO      128
#define XB_XCNT(j)  (256  + 64 * (j))
#define XB_XSUB(j)  (1280 + 64 * (j))
#define XB_XGEN(j)  (2304 + 64 * (j))
#define XB_TOP      3328
#define XB_TOPGEN   3392
#define XCD_BAR_WORDS 3456
#define XB_SPIN_CAP (1u << 22)
__device__ __forceinline__ unsigned xb_ld(unsigned* p)              { return __hip_atomic_load(p, __ATOMIC_RELAXED, __HIP_MEMORY_SCOPE_AGENT); }
__device__ __forceinline__ unsigned xb_add(unsigned* p, unsigned v) { return __hip_atomic_fetch_add(p, v, __ATOMIC_RELAXED, __HIP_MEMORY_SCOPE_AGENT); }
__device__ __forceinline__ unsigned xb_xcc_id() { return (unsigned)__builtin_amdgcn_s_getreg((3 << 11) | 20) & 0xFu; }
#define XB_SPIN(cond, bar) do { unsigned _sp = 0; while (cond) { __builtin_amdgcn_s_sleep(1); \
    if ((++_sp & 255u) == 0u) { if (xb_ld(&(bar)[XB_TMO])) break; if (_sp > XB_SPIN_CAP) { atomicAdd(&(bar)[XB_TMO], 1u); break; } } } } while (0)
struct XcdBarrier { unsigned* bar; unsigned x; volatile LAS unsigned* st; };
__device__ __forceinline__ XcdBarrier xcd_barrier_post(unsigned* bar, volatile LAS unsigned* st) {
    XcdBarrier b; b.bar = bar; b.x = xb_xcc_id(); b.st = st;
    if (threadIdx.x == 0) (void)xb_add(&bar[XB_XCNT(b.x)], 1u);
    return b;
}
__device__ __forceinline__ void xcd_barrier_complete(unsigned* bar, unsigned x, unsigned& nloc, unsigned& nx) {
    const unsigned G = gridDim.x * gridDim.y * gridDim.z;
    unsigned sum, cnt, mine, sp = 0u;
    for (;;) {
        sum = 0u; cnt = 0u; mine = 0u;
#pragma unroll
        for (unsigned j = 0; j < 16; ++j) { const unsigned c = xb_ld(&bar[XB_XCNT(j)]); sum += c; cnt += (c > 0u) ? 1u : 0u; mine = (j == x) ? c : mine; }
        if (sum == G) break;
        __builtin_amdgcn_s_sleep(1);
        if ((++sp & 255u) == 0u) { if (xb_ld(&bar[XB_TMO])) break; if (sp > XB_SPIN_CAP) { atomicAdd(&bar[XB_TMO], 1u); break; } }
    }
    nloc = mine > 0u ? mine : 1u; nx = cnt > 0u ? cnt : 1u;
}
__device__ __forceinline__ void xcd_barrier(const XcdBarrier& b) {
    asm volatile("s_waitcnt vmcnt(0)" ::: "memory");
    __syncthreads();
    if (threadIdx.x == 0) {
        unsigned* bar = b.bar;
        __builtin_amdgcn_s_waitcnt(0);
        unsigned nloc = b.st[0], nx = b.st[1];
        if (nloc == 0u) { xcd_barrier_complete(bar, b.x, nloc, nx); b.st[0] = nloc; b.st[1] = nx; }
        const unsigned old = xb_add(&bar[XB_XSUB(b.x)], 1u);
        const unsigned gen = old / nloc;
        if (old + 1u == (gen + 1u) * nloc) {
            __builtin_amdgcn_fence(__ATOMIC_RELEASE, "agent");
            asm volatile("s_waitcnt vmcnt(0)" ::: "memory");
            const unsigned og = xb_add(&bar[XB_TOP], 1u);
            const unsigned tg = og / nx;
            if (og + 1u == (tg + 1u) * nx) xb_add(&bar[XB_TOPGEN], 1u);
            else XB_SPIN(xb_ld(&bar[XB_TOPGEN]) == tg, bar);
            __builtin_amdgcn_fence(__ATOMIC_ACQUIRE, "agent");
            xb_add(&bar[XB_XGEN(b.x)], 1u);
            asm volatile("s_waitcnt vmcnt(0)" ::: "memory");
        } else {
            XB_SPIN(xb_ld(&bar[XB_XGEN(b.x)]) == gen, bar);
            __builtin_amdgcn_fence(__ATOMIC_ACQUIRE, "agent");
            asm volatile("s_waitcnt vmcnt(0)" ::: "memory");
        }
    }
    __syncthreads();
}

struct Args {
    const float* in[28];
    float* out;
    unsigned char* ws;
    int ph_lo, ph_hi;
};
enum { I_X = 0, I_C, I_CTX, I_CCTX, I_WADA, I_BADA, I_GPREMIX, I_GPOSTMIX, I_GPREFFN, I_GPOSTFFN, I_WIN, I_LQ1, I_LK1, I_LQ2, I_LK2,
       I_GSUBLN, I_WPOOL, I_BPOOL, I_PSCALE, I_WOUT, I_WROUTER, I_RBIAS, I_WEG, I_WEU, I_WED, I_WSG, I_WSU, I_WSD };

typedef __attribute__((address_space(4))) const Args CArgs;
struct Ctx {
    int tid, lane, wave, blk, G;
    unsigned char* lds;
};

__device__ __forceinline__ void ph_adaln(CArgs& a, const Ctx& c) {
    float* MODS = (float*)(a.ws + WS_MODS);
    float* red = (float*)c.lds;
    const float* w_ada = a.in[I_WADA];
    const int ksub = c.lane / 6, c4 = c.lane % 6;
    for (int it = c.blk; it < 256; it += c.G) {
        float acc[5][4];
#pragma unroll
        for (int r = 0; r < 5; ++r)
#pragma unroll
            for (int j = 0; j < 4; ++j) acc[r][j] = 0.f;
        if (ksub < 10) {
            for (int i = 0; i < 13; ++i) { const int kk = ksub + 10 * i;
                if (kk < 128) { const int k = c.wave * 128 + kk;
                    const float4 w = *(const float4*)(w_ada + (size_t)k * 6144 + it * 24 + 4 * c4);
#pragma unroll
                    for (int r = 0; r < 5; ++r) { const float sv = silu_f((r < 4) ? a.in[I_C][r * DM + k] : a.in[I_CCTX][k]);
                        acc[r][0] = fmaf(sv, w.x, acc[r][0]); acc[r][1] = fmaf(sv, w.y, acc[r][1]); acc[r][2] = fmaf(sv, w.z, acc[r][2]); acc[r][3] = fmaf(sv, w.w, acc[r][3]); } } }
#pragma unroll
            for (int r = 0; r < 5; ++r)
#pragma unroll
                for (int j = 0; j < 4; ++j) red[((c.wave * 10 + ksub) * 5 + r) * 24 + 4 * c4 + j] = acc[r][j];
        }
        __syncthreads();
        if (c.tid < 120) { const int r = c.tid / 24, col = c.tid % 24; float sum = 0.f;
            for (int q = 0; q < 80; ++q) sum += red[(q * 5 + r) * 24 + col];
            MODS[r * 6144 + it * 24 + col] = sum + a.in[I_BADA][it * 24 + col]; }
        __syncthreads();
    }
    if (c.blk == c.G - 1) {
        float* ROPE = (float*)(a.ws + WS_ROPE);
        for (int i = c.tid; i < 1024; i += 512) {
            const int pos = i >> 4, fi = i & 15;
            const float freq = powf(10000.f, -(float)fi / 16.f);
            const float ang = (float)pos * freq;
            ROPE[i * 2] = cosf(ang); ROPE[i * 2 + 1] = sinf(ang);
        }
        if (c.wave == 0) {
            const float s1 = wave_sum(a.in[I_LQ1][c.lane] * a.in[I_LK1][c.lane], c.lane);
            const float s2 = wave_sum(a.in[I_LQ2][c.lane] * a.in[I_LK2][c.lane], c.lane);
            if (c.lane == 0) *(float*)(a.ws + WS_LAM) = expf(s1) - expf(s2) + LAM_INIT;
        }
    }
    __syncthreads();
}

__device__ __forceinline__ void transpose_item(const float* W, int K, int N, bf16_t* WT, int k0, int n0, int drow0, float* scr, int lane) {
#pragma unroll 8
    for (int i = 0; i < 32; ++i) { const int kk = 2 * i + (lane >> 5); scr[kk * 33 + (lane & 31)] = W[(size_t)(k0 + kk) * N + n0 + (lane & 31)]; }
    asm volatile("s_waitcnt lgkmcnt(0)" ::: "memory");
    const int cc = lane & 7;
#pragma unroll
    for (int j = 0; j < 4; ++j) { const int n = (lane >> 3) + 8 * j; const float* s = scr + (8 * cc) * 33 + n;
        uint4 o; o.x = pk2(s[0 * 33], s[1 * 33]); o.y = pk2(s[2 * 33], s[3 * 33]); o.z = pk2(s[4 * 33], s[5 * 33]); o.w = pk2(s[6 * 33], s[7 * 33]);
        *(uint4*)(WT + (size_t)(drow0 + n) * K + k0 + 8 * cc) = o; }
    asm volatile("s_waitcnt lgkmcnt(0)" ::: "memory");
}
__device__ __forceinline__ void ph_transposes(CArgs& a, const Ctx& c) {
    float* scr = (float*)(c.lds + c.wave * 16384);
    const int gw = c.blk * 8 + c.wave, NGW = c.G * 8;
    constexpr int I_IN = 16 * 64, I_OUT = 16 * 32, I_G = 16 * 8, I_D = 4 * 32;
    constexpr int I_P = 4 * 2 * 4;
    constexpr int NIT = I_IN + I_OUT + 65 * (2 * I_G + I_D) + I_P;
    bf16_t* WIN = (bf16_t*)(a.ws + WS_WIN); bf16_t* WOUT = (bf16_t*)(a.ws + WS_WOUT); bf16_t* WGU = (bf16_t*)(a.ws + WS_WGU); bf16_t* WD = (bf16_t*)(a.ws + WS_WD);
    for (int it = gw; it < NIT; it += NGW) {
        int r = it;
        if (r < I_IN) { const int kb = r / 64, nb = r % 64; transpose_item(a.in[I_WIN], DM, INW, WIN, kb * 64, nb * 32, nb * 32, scr, c.lane); continue; } r -= I_IN;
        if (r < I_OUT) { const int kb = r / 32, nb = r % 32; transpose_item(a.in[I_WOUT], DM, DM, WOUT, kb * 64, nb * 32, nb * 32, scr, c.lane); continue; } r -= I_OUT;
        if (r >= 65 * (2 * I_G + I_D)) { r -= 65 * (2 * I_G + I_D); const int g = r >> 3, kb = (r >> 2) & 1, nb = r & 3;
            transpose_item(a.in[I_WPOOL] + (size_t)g * 128 * 128, 128, 128, (bf16_t*)(a.ws + WS_WPOOL) + (size_t)g * 128 * 128, kb * 64, nb * 32, nb * 32, scr, c.lane); continue; }
        const int e = r / (2 * I_G + I_D); r -= e * (2 * I_G + I_D);
        if (r < 2 * I_G) {
            const int up = r / I_G; r -= up * I_G; const int kb = r / 8, nb = r % 8, n0 = nb * 32;
            const float* src = (e < 64) ? a.in[up ? I_WEU : I_WEG] + (size_t)e * DM * FF : a.in[up ? I_WSU : I_WSG];
            transpose_item(src, DM, FF, WGU + (size_t)e * 512 * DM, kb * 64, n0, 256 * (n0 >> 7) + (n0 & 127) + (up ? 128 : 0), scr, c.lane);
        } else {
            r -= 2 * I_G; const int kb = r / 32, nb = r % 32;
            const float* src = (e < 64) ? a.in[I_WED] + (size_t)e * FF * DM : a.in[I_WSD];
            transpose_item(src, FF, DM, WD + (size_t)e * DM * FF, kb * 64, nb * 32, nb * 32, scr, c.lane);
        }
    }
}
__device__ __forceinline__ void ph_hxrows(CArgs& a, const Ctx& c) {
    const int gw = c.blk * 8 + c.wave, NGW = c.G * 8;
    const float* MODS = (const float*)(a.ws + WS_MODS); bf16_t* HX = (bf16_t*)(a.ws + WS_HX);
    for (int m = gw; m < TT; m += NGW) {
        const float* xr = (m < T) ? a.in[I_X] + (size_t)m * DM : a.in[I_CTX] + (size_t)(m - T) * DM;
        const float* md = MODS + (size_t)((m < T) ? (m / NSEQ) : 4) * 6144;
        float4 v[4]; float ss = 0.f;
#pragma unroll
        for (int j = 0; j < 4; ++j) { v[j] = *(const float4*)(xr + 4 * c.lane + 256 * j); ss += v[j].x * v[j].x + v[j].y * v[j].y + v[j].z * v[j].z + v[j].w * v[j].w; }
        const float rs = rsqrtf(wave_sum(ss, c.lane) * (1.f / DM) + EPS);
#pragma unroll
        for (int j = 0; j < 4; ++j) {
            const int col = 4 * c.lane + 256 * j;
            const float4 g = *(const float4*)(a.in[I_GPREMIX] + col), sh = *(const float4*)(md + col), sc = *(const float4*)(md + 1024 + col);
            const float o0 = v[j].x * rs * g.x * (1.f + sc.x) + sh.x, o1 = v[j].y * rs * g.y * (1.f + sc.y) + sh.y;
            const float o2 = v[j].z * rs * g.z * (1.f + sc.z) + sh.z, o3 = v[j].w * rs * g.w * (1.f + sc.w) + sh.w;
            uint2 w; w.x = pk2(o0, o1); w.y = pk2(o2, o3);
            *(uint2*)(HX + (size_t)m * DM + col) = w;
        }
    }
}

template <class StoreF>
__device__ __forceinline__ void norm_token(CArgs& a, const Ctx& c, const int t, StoreF store) {
    const bf16_t* YX = (const bf16_t*)(a.ws + WS_YX); bf16_t* HX2 = (bf16_t*)(a.ws + WS_HX);
    const float* md = (const float*)(a.ws + WS_MODS) + (size_t)(t / NSEQ) * 6144;
    float v[16]; float ss = 0.f;
#pragma unroll
    for (int j = 0; j < 4; ++j) { const uint2 w = *(const uint2*)(YX + (size_t)t * DM + 4 * c.lane + 256 * j);
        v[4 * j] = bflo(w.x); v[4 * j + 1] = bfhi(w.x); v[4 * j + 2] = bflo(w.y); v[4 * j + 3] = bfhi(w.y); }
#pragma unroll
    for (int j = 0; j < 16; ++j) ss += v[j] * v[j];
    const float r1 = rsqrtf(wave_sum(ss, c.lane) * (1.f / DM) + EPS);
    float ss2 = 0.f;
#pragma unroll
    for (int j = 0; j < 4; ++j) {
        const int col = 4 * c.lane + 256 * j;
        const float4 xv = *(const float4*)(a.in[I_X] + (size_t)t * DM + col), gp = *(const float4*)(a.in[I_GPOSTMIX] + col), ga = *(const float4*)(md + 2048 + col);
        float4 x1; x1.x = xv.x + ga.x * (v[4 * j] * r1 * gp.x); x1.y = xv.y + ga.y * (v[4 * j + 1] * r1 * gp.y);
        x1.z = xv.z + ga.z * (v[4 * j + 2] * r1 * gp.z); x1.w = xv.w + ga.w * (v[4 * j + 3] * r1 * gp.w);
        *(float4*)(a.out + (size_t)t * DM + col) = x1;
        v[4 * j] = x1.x; v[4 * j + 1] = x1.y; v[4 * j + 2] = x1.z; v[4 * j + 3] = x1.w;
        ss2 += x1.x * x1.x + x1.y * x1.y + x1.z * x1.z + x1.w * x1.w;
    }
    const float r2 = rsqrtf(wave_sum(ss2, c.lane) * (1.f / DM) + EPS);
#pragma unroll
    for (int j = 0; j < 4; ++j) {
        const int col = 4 * c.lane + 256 * j;
        const float4 g = *(const float4*)(a.in[I_GPREFFN] + col), sh = *(const float4*)(md + 3072 + col), sc = *(const float4*)(md + 4096 + col);
        float4 hv; hv.x = v[4 * j] * r2 * g.x * (1.f + sc.x) + sh.x; hv.y = v[4 * j + 1] * r2 * g.y * (1.f + sc.y) + sh.y;
        hv.z = v[4 * j + 2] * r2 * g.z * (1.f + sc.z) + sh.z; hv.w = v[4 * j + 3] * r2 * g.w * (1.f + sc.w) + sh.w;
        uint2 w; w.x = pk2(hv.x, hv.y); w.y = pk2(hv.z, hv.w);
        *(uint2*)(HX2 + (size_t)t * DM + col) = w;
        store(col, hv);
    }
}
__device__ __forceinline__ void route_token(CArgs& a, const Ctx& c, const int t, const float logit, int* hist) {
    int* TOPE = (int*)(a.ws + WS_TOPE); float* TOPW = (float*)(a.ws + WS_TOPW);
    const float score = 1.f / (1.f + expf(-logit));
    const float biased = score + a.in[I_RBIAS][c.lane];
    int grank = 0;
#pragma unroll
    for (int j = 0; j < 8; ++j) { const float vj = shl(biased, (c.lane & ~7) + j); grank += (vj > biased || (vj == biased && j < (c.lane & 7))) ? 1 : 0; }
    float gs = (grank < 2) ? biased : 0.f;
    gs += shx(gs, 1, c.lane); gs += shx(gs, 2, c.lane); gs += shx(gs, 4, c.lane);
    int gr = 0; const int myg = c.lane >> 3;
#pragma unroll
    for (int g = 0; g < 8; ++g) { const float sg = __int_as_float(__builtin_amdgcn_readlane(__float_as_int(gs), g * 8)); gr += (sg > gs || (sg == gs && g < myg)) ? 1 : 0; }
    const float masked = (gr < 4) ? biased : -INFINITY;
    int cnt = 0;
#pragma unroll
    for (int j = 0; j < 64; ++j) { const float vj = __int_as_float(__builtin_amdgcn_readlane(__float_as_int(masked), j)); cnt += (vj > masked || (vj == masked && j < c.lane)) ? 1 : 0; }
    const bool sel = cnt < TOPK;
    const float ssum = wave_sum(sel ? score : 0.f, c.lane);
    if (sel) {
        const int lr = atomicAdd(&hist[c.lane], 1);
        TOPE[t * 8 + cnt] = c.lane | (lr << 8);
        TOPW[t * 8 + cnt] = score / ssum * 2.5f;
    }
}
__device__ __forceinline__ void ph_norm_router_fast(CArgs& a, const Ctx& c) {
    typedef float f32x16 __attribute__((ext_vector_type(16)));
    constexpr int HSS = 1025;
    float* HS = (float*)c.lds;
    int* hist = (int*)(c.lds + 131328);
    int* BLKCNT = (int*)(a.ws + WS_BLKCNT);
    const float* wr = a.in[I_WROUTER];
    const int kq = c.wave >> 1, jt = c.wave & 1, r32 = c.lane & 31, hi = c.lane >> 5;
    for (int vb = c.blk; vb < NVB; vb += c.G) {
        if (c.tid < 64) hist[c.tid] = 0;
        __syncthreads();
        for (int pass = 0; pass < 2; ++pass) {
            const int t0 = vb * 64 + pass * 32;
            for (int i = 0; i < 4; ++i) { const int ti = c.wave * 4 + i; float* row = HS + ti * HSS;
                norm_token(a, c, t0 + ti, [&](int col, float4 hv) { row[col] = hv.x; row[col + 1] = hv.y; row[col + 2] = hv.z; row[col + 3] = hv.w; }); }
            __syncthreads();
            f32x16 acc = {};
            { const float* ap = HS + r32 * HSS + kq * 256 + hi; const float* bp = wr + (size_t)(kq * 256 + hi) * NE + jt * 32 + r32;
#pragma unroll 8
              for (int ks = 0; ks < 128; ++ks) acc = __builtin_amdgcn_mfma_f32_32x32x2f32(ap[2 * ks], bp[(size_t)2 * ks * NE], acc, 0, 0, 0); }
            __syncthreads();
#pragma unroll
            for (int r = 0; r < 16; ++r) HS[(kq * 32 + ((r & 3) + 8 * (r >> 2) + 4 * hi)) * 64 + jt * 32 + r32] = acc[r];
            __syncthreads();
            for (int i = 0; i < 4; ++i) { const int ti = c.wave * 4 + i;
                const float lg = ((HS[(0 * 32 + ti) * 64 + c.lane] + HS[(1 * 32 + ti) * 64 + c.lane]) + HS[(2 * 32 + ti) * 64 + c.lane]) + HS[(3 * 32 + ti) * 64 + c.lane];
                route_token(a, c, t0 + ti, lg, hist); }
            __syncthreads();
        }
        if (c.tid < 64) BLKCNT[vb * 64 + c.tid] = hist[c.tid];
        __syncthreads();
    }
}

__device__ __forceinline__ void ph_pool_fast(CArgs& a, const Ctx& c) {
    typedef short bf16x8 __attribute__((ext_vector_type(8)));
    typedef float f32x16 __attribute__((ext_vector_type(16)));
    const bf16_t* P = (const bf16_t*)(a.ws + WS_P); bf16_t* ATT = (bf16_t*)(a.ws + WS_ATT); const bf16_t* WPT = (const bf16_t*)(a.ws + WS_WPOOL);
    constexpr int DSTR = 1040;
    char* Dl = (char*)c.lds;
    for (int u = c.blk; u < T / 64; u += c.G) {
        const int row0 = u * 64, n0 = row0 % NSEQ;
        __syncthreads();
        {
            const int cc = c.tid & 63, rr = c.tid >> 6, g = cc >> 4, w = 2 << g, hw = w >> 1;
            const bf16_t* pc = P + (size_t)(row0 - n0) * PW + cc * 8;
            float s[8];
#pragma unroll
            for (int j = 0; j < 8; ++j) s[j] = 0.f;
            const int nfirst = n0 + rr * 8;
            int lo = nfirst - hw; if (lo < 0) lo = 0; int hiw = nfirst + hw; if (hiw > NSEQ) hiw = NSEQ;
            for (int n = lo; n < hiw; ++n) { const uint4 q = *(const uint4*)(pc + (size_t)n * PW);
                s[0] += bflo(q.x); s[1] += bfhi(q.x); s[2] += bflo(q.y); s[3] += bfhi(q.y); s[4] += bflo(q.z); s[5] += bfhi(q.z); s[6] += bflo(q.w); s[7] += bfhi(q.w); }
            for (int i = 0; i < 8; ++i) {
                const int n = nfirst + i;
                if (i > 0) {
                    const int nadd = n + hw - 1, nsub = n - hw - 1;
                    if (nadd < NSEQ) { const uint4 q = *(const uint4*)(pc + (size_t)nadd * PW);
                        s[0] += bflo(q.x); s[1] += bfhi(q.x); s[2] += bflo(q.y); s[3] += bfhi(q.y); s[4] += bflo(q.z); s[5] += bfhi(q.z); s[6] += bflo(q.w); s[7] += bfhi(q.w); }
                    if (nsub >= 0) { const uint4 q = *(const uint4*)(pc + (size_t)nsub * PW);
                        s[0] -= bflo(q.x); s[1] -= bfhi(q.x); s[2] -= bflo(q.y); s[3] -= bfhi(q.y); s[4] -= bflo(q.z); s[5] -= bfhi(q.z); s[6] -= bflo(q.w); s[7] -= bfhi(q.w); }
                }
                int l2 = n - hw; if (l2 < 0) l2 = 0; int h2 = n + hw; if (h2 > NSEQ) h2 = NSEQ;
                const float inv = 1.f / (float)(h2 - l2);
                const uint4 q = *(const uint4*)(pc + (size_t)n * PW);
                uint4 o; o.x = pk2(s[0] * inv - bflo(q.x), s[1] * inv - bfhi(q.x)); o.y = pk2(s[2] * inv - bflo(q.y), s[3] * inv - bfhi(q.y));
                o.z = pk2(s[4] * inv - bflo(q.z), s[5] * inv - bfhi(q.z)); o.w = pk2(s[6] * inv - bflo(q.w), s[7] * inv - bfhi(q.w));
                *(uint4*)(Dl + (rr * 8 + i) * DSTR + cc * 16) = o;
            }
        }
        __syncthreads();
        {
            const int g = c.wave >> 1, rh = c.wave & 1, r32 = c.lane & 31, hi = c.lane >> 5;
            f32x16 acc[4] = {};
            const char* ap = Dl + (rh * 32 + r32) * DSTR + g * 256 + hi * 16;
            const bf16_t* bp = WPT + ((size_t)g * 128 + r32) * 128 + hi * 8;
#pragma unroll
            for (int ks = 0; ks < 8; ++ks) {
                const bf16x8 af = *(const bf16x8*)(ap + ks * 32);
#pragma unroll
                for (int et = 0; et < 4; ++et) { const bf16x8 bf = *(const bf16x8*)(bp + (size_t)et * 32 * 128 + ks * 16);
                    acc[et] = __builtin_amdgcn_mfma_f32_32x32x16_bf16(af, bf, acc[et], 0, 0, 0); }
            }
#pragma unroll
            for (int et = 0; et < 4; ++et) { const int ch = g * 128 + et * 32 + r32; const float bb = a.in[I_BPOOL][ch], sc = a.in[I_PSCALE][ch];
#pragma unroll
                for (int r = 0; r < 16; ++r) { const int row = row0 + rh * 32 + (r & 3) + 8 * (r >> 2) + 4 * hi;
                    ATT[(size_t)row * DM + 512 + ch] = (bf16_t)f2bf((acc[et][r] + bb) * sc); } }
        }
    }
    __syncthreads();
}

__device__ __forceinline__ void ph_tables(CArgs& a, const Ctx& c) {
    const int* BLKCNT = (const int*)(a.ws + WS_BLKCNT); const int* TOPE = (const int*)(a.ws + WS_TOPE); const float* TOPW = (const float*)(a.ws + WS_TOPW);
    int* SEG = (int*)(a.ws + WS_SEG); int* TOKSLOT = (int*)(a.ws + WS_TOKSLOT); int* SLOTTOK = (int*)(a.ws + WS_SLOTTOK); float* SLOTW = (float*)(a.ws + WS_SLOTW);
    int* psum = (int*)c.lds;
    int* segstart = psum + 512;
    int* segcnt = segstart + 64;
    int* base = segcnt + 64;
    { const int e = c.tid & 63, p = c.tid >> 6; int s = 0;
      for (int v = 0; v < 32; ++v) s += BLKCNT[(p * 32 + v) * 64 + e];
      psum[p * 64 + e] = s; }
    __syncthreads();
    if (c.tid < 64) { int s = 0;
#pragma unroll
        for (int p = 0; p < 8; ++p) s += psum[p * 64 + c.tid];
        segcnt[c.tid] = s; }
    __syncthreads();
    if (c.tid < 64) { int s = 0; for (int e2 = 0; e2 < c.tid; ++e2) s += segcnt[e2]; segstart[c.tid] = s; }
    __syncthreads();
    if (c.blk == 0) {
        if (c.tid < 64) { SEG[c.tid * 2] = segstart[c.tid]; SEG[c.tid * 2 + 1] = segcnt[c.tid]; }
        if (c.tid == 64) { SEG[128] = NSLOT_R; SEG[129] = T; }
    }
    for (int vb = c.blk; vb < NVB; vb += c.G) {
        if (c.tid < 64) { const int e = c.tid, p = vb >> 5; int s = segstart[e];
            for (int p2 = 0; p2 < p; ++p2) s += psum[p2 * 64 + e];
            for (int v = p * 32; v < vb; ++v) s += BLKCNT[v * 64 + e];
            base[e] = s; }
        __syncthreads();
        { const int t = vb * 64 + (c.tid >> 3), k = c.tid & 7; const int pe = TOPE[t * 8 + k], e = pe & 255, lr = pe >> 8;
          const int slot = base[e] + lr;
          SLOTTOK[slot] = t; SLOTW[slot] = TOPW[t * 8 + k]; TOKSLOT[t * 8 + k] = slot; }
        __syncthreads();
    }
}

__device__ __forceinline__ void ph_combine(CArgs& a, const Ctx& c) {
    typedef float f32x2 __attribute__((ext_vector_type(2)));
    const unsigned char* Y = (const unsigned char*)(a.ws + WS_Y); const int* TOKSLOT = (const int*)(a.ws + WS_TOKSLOT); const float* MODS = (const float*)(a.ws + WS_MODS);
    const int gw = c.blk * 8 + c.wave, NGW = c.G * 8;
    for (int t = gw; t < T; t += NGW) {
        const int b = t / NSEQ;
        float v[16];
#pragma unroll
        for (int j = 0; j < 16; ++j) v[j] = 0.f;
#pragma unroll
        for (int k = 0; k < 9; ++k) {
            const int r = (k < 8) ? TOKSLOT[t * 8 + k] : (NSLOT_R + t);
#pragma unroll
            for (int j = 0; j < 4; ++j) { const int w = *(const int*)(Y + (size_t)r * DM + 4 * c.lane + 256 * j);
                const f32x2 lo = __builtin_amdgcn_cvt_pk_f32_fp8(w, false), hi = __builtin_amdgcn_cvt_pk_f32_fp8(w, true);
                v[4 * j] += lo[0]; v[4 * j + 1] += lo[1]; v[4 * j + 2] += hi[0]; v[4 * j + 3] += hi[1]; }
        }
        float ss = 0.f;
#pragma unroll
        for (int j = 0; j < 16; ++j) ss += v[j] * v[j];
        const float rs = rsqrtf(wave_sum(ss, c.lane) * (1.f / DM) + EPS);
        const float* md = MODS + (size_t)b * 6144 + 5120;
#pragma unroll
        for (int j = 0; j < 4; ++j) {
            const int col = 4 * c.lane + 256 * j;
            float4 x1 = *(const float4*)(a.out + (size_t)t * DM + col); const float4 g = *(const float4*)(a.in[I_GPOSTFFN] + col), gf = *(const float4*)(md + col);
            x1.x += gf.x * (v[4 * j] * rs * g.x); x1.y += gf.y * (v[4 * j + 1] * rs * g.y); x1.z += gf.z * (v[4 * j + 2] * rs * g.z); x1.w += gf.w * (v[4 * j + 3] * rs * g.w);
            *(float4*)(a.out + (size_t)t * DM + col) = x1;
        }
    }
}

constexpr int LDS_TAB = 128 * 1024;
constexpr int LDS_OAN = 132 * 1024;
namespace pg8 {
typedef short bf16x8 __attribute__((ext_vector_type(8)));
typedef float f32x4 __attribute__((ext_vector_type(4)));
typedef unsigned u32x4 __attribute__((ext_vector_type(4)));
typedef unsigned u32x2 __attribute__((ext_vector_type(2)));
constexpr int BM = 256, BK = 64, HALF = 128, HTB = HALF * BK * 2, STAGE_BYTES = 8 * HTB;
__device__ __forceinline__ int lds_byte(int r, int c) { const int st = (r >> 4) * 2 + (c >> 5), rr = r & 15, cc = c & 31, ob = rr * 64 + cc * 2; return st * 1024 + (ob ^ (((ob >> 9) & 1) << 5)); }
__device__ __forceinline__ void stage_rc(int b, int& R, int& C) { const int st = b / 1024, sb = b % 1024, swz = sb ^ (((sb >> 9) & 1) << 5); R = (st >> 1) * 16 + swz / 64; C = (st & 1) * 32 + (swz % 64) / 2; }
__device__ __forceinline__ int perm32(int rho) { const int n = rho >> 4, i = rho & 15; return 8 * (i >> 2) + 4 * n + (i & 3); }
__device__ __forceinline__ int xcd_remap(int L, int nwg) { const int q = nwg / 8, r = nwg % 8, xcd = L % 8, off = L / 8; return (xcd < r ? xcd * (q + 1) : r * (q + 1) + (xcd - r) * q) + off; }
__device__ __forceinline__ unsigned cvt_pk_bf16(float lo, float hi) { unsigned r; asm volatile("v_cvt_pk_bf16_f32 %0, %1, %2" : "=v"(r) : "v"(lo), "v"(hi)); return r; }

struct Unit { int row0, nvalid, pn, aux; };

template <class Epi, class Sched, bool ALIGN_EPI, int K>
__device__ __forceinline__ void gemm_phase(LAS unsigned char* lds, const Sched& S, const Epi& E, const int tid) {
    const int wid = __builtin_amdgcn_readfirstlane(tid >> 6), lane = tid & 63, wr = wid >> 2, wc = wid & 3, fr = lane & 15, fq = lane >> 4;
    constexpr int nt = K / BK;
    unsigned voffB[2];
#pragma unroll
    for (int i = 0; i < 2; ++i) { int R, C; stage_rc(tid * 16 + i * 8192, R, C); const int Rb = Epi::PERM ? ((R & ~31) + perm32(R & 31)) : R;
        voffB[i] = (unsigned)(Rb * K + C) * 2u; }
    LAS u32x4* const oAnL = (LAS u32x4*)(lds + LDS_OAN) + tid;
    const size_t kstep = (size_t)(BK * 2);
    const size_t hstepB = (size_t)HALF * K * 2;
    const unsigned ldsw = (unsigned)wid * 1024u;
    const int aoff = lds_byte(wr * 64 + fr, fq * 8), boff = lds_byte(wc * 32 + fr, fq * 8);
#define PG8_SA(b, h) (((b) * 2 + (h)) * HTB)
#define PG8_SB(b, h) ((4 + (b) * 2 + (h)) * HTB)
#define PG8_STAGE(bufoff, gbase, voff) do { _Pragma("unroll") for (int _i = 0; _i < 2; ++_i) \
        __builtin_amdgcn_global_load_lds((const unsigned*)((const char*)(gbase) + (voff)[_i]), (LAS unsigned*)(lds + (bufoff) + ldsw + _i * 8192), 16, 0, 0); } while (0)
#define PG8_LDA(dst, b, h) do { _Pragma("unroll") for (int m = 0; m < 4; ++m) _Pragma("unroll") for (int k = 0; k < 2; ++k) dst[m][k] = *(const LAS bf16x8*)(lds + PG8_SA(b, h) + aoff + m * 2048 + k * 1024); } while (0)
#define PG8_LDB(dst, b, h) do { _Pragma("unroll") for (int n = 0; n < 2; ++n) _Pragma("unroll") for (int k = 0; k < 2; ++k) dst[n][k] = *(const LAS bf16x8*)(lds + PG8_SB(b, h) + boff + n * 2048 + k * 1024); } while (0)
#define PG8_MMA(ai, bj, At, Bt) do { __builtin_amdgcn_s_setprio(1); _Pragma("unroll") for (int m = 0; m < 4; ++m) _Pragma("unroll") for (int n = 0; n < 2; ++n) _Pragma("unroll") for (int k = 0; k < 2; ++k) \
        acc[ai][bj][m][n] = __builtin_amdgcn_mfma_f32_16x16x32_bf16(Bt[n][k], At[m][k], acc[ai][bj][m][n], 0, 0, 0); __builtin_amdgcn_s_setprio(0); } while (0)
#define PG8_WAIT_V(n) asm volatile("s_waitcnt vmcnt(" #n ")" ::: "memory")
#define PG8_WAIT_L(n) asm volatile("s_waitcnt lgkmcnt(" #n ")" ::: "memory")
#define PG8_BAR __builtin_amdgcn_s_barrier()
#define PG8_SCHED __builtin_amdgcn_sched_barrier(0)
    Unit cur, nxt; int ui = 0;
    if (!S.next(0, cur)) return;
    f32x4 acc[2][2][4][2];
#pragma unroll
    for (int a = 0; a < 2; ++a)
#pragma unroll
        for (int b = 0; b < 2; ++b)
#pragma unroll
            for (int m = 0; m < 4; ++m)
#pragma unroll
                for (int n = 0; n < 2; ++n) acc[a][b][m][n] = (f32x4){0.f, 0.f, 0.f, 0.f};
    bf16x8 At[4][2], B0[2][2], B1[2][2];
    unsigned oAc[2][2];
    S.a_off(cur, tid, oAc);
    const char* const Ab = S.a_base();
    const char* cB = S.b_base(cur);
    PG8_STAGE(PG8_SB(0, 0), cB, voffB); PG8_STAGE(PG8_SB(0, 1), cB + hstepB, voffB); PG8_STAGE(PG8_SA(0, 0), Ab, oAc[0]); PG8_STAGE(PG8_SA(0, 1), Ab, oAc[1]);
    if (wr == 1) PG8_BAR;
    PG8_WAIT_V(2); PG8_BAR;
    PG8_STAGE(PG8_SB(1, 0), cB + kstep, voffB); PG8_STAGE(PG8_SA(1, 0), Ab + kstep, oAc[0]); PG8_STAGE(PG8_SB(1, 1), cB + hstepB + kstep, voffB);
    PG8_WAIT_V(6); PG8_BAR;
    for (;;) {
        const bool has_next = S.next(ui + 1, nxt);
        if (has_next) { unsigned t_[2][2]; S.a_off(nxt, tid, t_); *oAnL = (u32x4){t_[0][0], t_[0][1], t_[1][0], t_[1][1]}; }
        const char* nB = has_next ? S.b_base(nxt) : cB;
#pragma unroll 1
        for (int t = 0; t < nt; t += 2) {
            const bool last = (t == nt - 2);
            const char* a1 = Ab + (size_t)(t + 1) * kstep;
            const char* a2 = last ? Ab : Ab + (size_t)(t + 2) * kstep; const char* b2 = last ? nB : cB + (size_t)(t + 2) * kstep;
            const char* a3 = a2 + kstep; const char* b3 = b2 + kstep;
            PG8_LDB(B0, 0, 0); PG8_LDB(B1, 0, 1); PG8_SCHED; PG8_LDA(At, 0, 0); PG8_STAGE(PG8_SA(1, 1), a1, oAc[1]);
            if (last && has_next) { const u32x4 q = *oAnL; oAc[0][0] = q.x; oAc[0][1] = q.y; oAc[1][0] = q.z; oAc[1][1] = q.w; }
            PG8_WAIT_V(8); PG8_WAIT_L(0); PG8_BAR; PG8_MMA(0, 0, At, B0); PG8_MMA(0, 1, At, B1); PG8_BAR; PG8_SCHED;
            PG8_LDA(At, 0, 1); PG8_STAGE(PG8_SB(0, 0), b2, voffB); PG8_STAGE(PG8_SB(0, 1), b2 + hstepB, voffB); PG8_STAGE(PG8_SA(0, 0), a2, oAc[0]);
            PG8_WAIT_V(8); PG8_WAIT_L(0); PG8_BAR; PG8_MMA(1, 0, At, B0); PG8_MMA(1, 1, At, B1); PG8_BAR; PG8_SCHED;
            PG8_LDB(B0, 1, 0); PG8_LDB(B1, 1, 1); PG8_SCHED; PG8_LDA(At, 1, 0); PG8_STAGE(PG8_SA(0, 1), a2, oAc[1]);
            PG8_WAIT_V(8); PG8_WAIT_L(0); PG8_BAR; PG8_MMA(0, 0, At, B0); PG8_MMA(0, 1, At, B1); PG8_BAR; PG8_SCHED;
            PG8_LDA(At, 1, 1); PG8_STAGE(PG8_SB(1, 0), b3, voffB); PG8_STAGE(PG8_SB(1, 1), b3 + hstepB, voffB); PG8_STAGE(PG8_SA(1, 0), a3, oAc[0]);
            PG8_WAIT_V(8); PG8_WAIT_L(0); PG8_BAR; PG8_MMA(1, 0, At, B0); PG8_MMA(1, 1, At, B1); PG8_BAR; PG8_SCHED;
        }
        if constexpr (ALIGN_EPI) { if (wr == 0) PG8_BAR; }
        E(acc, cur, wr, wc, fr, fq);
        if (!has_next) break;
#pragma unroll
        for (int a = 0; a < 2; ++a)
#pragma unroll
            for (int b = 0; b < 2; ++b)
#pragma unroll
                for (int m = 0; m < 4; ++m)
#pragma unroll
                    for (int n = 0; n < 2; ++n) acc[a][b][m][n] = (f32x4){0.f, 0.f, 0.f, 0.f};
        cur = nxt; cB = nB; ++ui;
        if constexpr (ALIGN_EPI) { if (wr == 1) PG8_BAR; }
    }
    PG8_WAIT_V(0);
    if constexpr (!ALIGN_EPI) { if (wr == 0) PG8_BAR; }
    PG8_BAR;
#undef PG8_SA
#undef PG8_SB
#undef PG8_STAGE
#undef PG8_LDA
#undef PG8_LDB
#undef PG8_MMA
#undef PG8_WAIT_V
#undef PG8_WAIT_L
#undef PG8_BAR
#undef PG8_SCHED
}

struct DenseSched {
    const char* A; const char* Bt; int nN, nwg, G, c, nmain;
    __device__ __forceinline__ bool next(int i, Unit& u) const {
        const int L = i * G + c; if (L >= nwg) return false;
        const int wgid = xcd_remap(L, nwg);
        if (wgid < nmain) { const int nig = 8 * nN, gid = wgid / nig, w = wgid % nig; u.row0 = 256 * (gid * 8 + (w % 8)); u.pn = w / 8; }
        else { const int j = wgid - nmain; u.row0 = T + 256 * (j >> 2); u.pn = 2 + (j & 3); }
        u.nvalid = 256; u.aux = 0; return true;
    }
    __device__ __forceinline__ const char* a_base() const { return A; }
    __device__ __forceinline__ const char* b_base(const Unit& u) const { return Bt + (size_t)u.pn * 256 * DM * 2; }
    __device__ __forceinline__ void a_off(const Unit& u, int tid, unsigned (&o)[2][2]) const {
#pragma unroll
        for (int i = 0; i < 2; ++i) { int R, C; stage_rc(tid * 16 + i * 8192, R, C);
#pragma unroll
            for (int h = 0; h < 2; ++h) o[h][i] = (unsigned)((u.row0 + 128 * h + R) * DM + C) * 2u; }
    }
};
constexpr int GT_MAXSEG = 132;
struct GroupedSched {
    const char* A; const char* Bt; const int* slottok; const LAS int* tab; int nseg, npn, nwg, G, c, K, brows;
    __device__ __forceinline__ bool next(int i, Unit& u) const {
        const int L = i * G + c; if (L >= nwg) return false;
        const int wgid = xcd_remap(L, nwg), tl = wgid / npn; u.pn = wgid % npn;
        int s = 0; while (tab[s + 1] <= tl) ++s;
        const int off = 256 * (tl - tab[s]);
        u.row0 = tab[GT_MAXSEG + s] + off; const int rem = tab[2 * GT_MAXSEG + s] - off; u.nvalid = rem < 256 ? rem : 256; u.aux = tab[3 * GT_MAXSEG + s];
        return true;
    }
    __device__ __forceinline__ const char* a_base() const { return A; }
    __device__ __forceinline__ const char* b_base(const Unit& u) const { return Bt + ((size_t)u.aux * brows + (size_t)u.pn * 256) * K * 2; }
    __device__ __forceinline__ void a_off(const Unit& u, int tid, unsigned (&o)[2][2]) const {
#pragma unroll
        for (int i = 0; i < 2; ++i) { int R, C; stage_rc(tid * 16 + i * 8192, R, C);
#pragma unroll
            for (int h = 0; h < 2; ++h) {
                int r = 128 * h + R;
                if (slottok) { if (r >= u.nvalid) r = u.nvalid - 1; const int slot = u.row0 + r; const int tok = (u.aux < 64) ? slottok[slot] : slot - NSLOT_R; o[h][i] = (unsigned)(tok * K + C) * 2u; }
                else o[h][i] = (unsigned)((u.row0 + r) * K + C) * 2u;
            } }
    }
};
__device__ __forceinline__ int grouped_table(LAS int* tab, const int* SEG, const int tid) {
    constexpr int nseg = 65;
    if (tid < nseg) { const int e = tid; const int st = SEG[e * 2], cn = SEG[e * 2 + 1];
        tab[GT_MAXSEG + tid] = st; tab[2 * GT_MAXSEG + tid] = cn; tab[3 * GT_MAXSEG + tid] = e; tab[4 * GT_MAXSEG + tid] = (cn + 255) >> 8; }
    __syncthreads();
    if (tid <= nseg) { int s = 0; for (int j = 0; j < tid; ++j) s += tab[4 * GT_MAXSEG + j]; tab[tid] = s; }
    __syncthreads();
    return tab[nseg];
}

struct EpiStore {
    static constexpr bool PERM = true;
    bf16_t* C; int ldc; int rowsub, rowsub_sh;
    __device__ __forceinline__ void operator()(const f32x4 (&acc)[2][2][4][2], const Unit& u, int wr, int wc, int fr, int fq) const {
        const int col0 = u.pn * 256 + wc * 32 + 8 * fq, crow0 = u.row0 - (u.aux < 64 ? rowsub : rowsub_sh);
        int rb = wr * 64 + fr; asm volatile("" : "+v"(rb));
#pragma unroll
        for (int ai = 0; ai < 2; ++ai)
#pragma unroll
            for (int m = 0; m < 4; ++m) { const int r = ai * 128 + m * 16 + rb;
                if (r < u.nvalid) { bf16_t* rowp = C + (size_t)(crow0 + r) * ldc + col0;
#pragma unroll
                    for (int bj = 0; bj < 2; ++bj) { const f32x4 v0 = acc[ai][bj][m][0], v1 = acc[ai][bj][m][1];
                        u32x4 w; w.x = cvt_pk_bf16(v0[0], v0[1]); w.y = cvt_pk_bf16(v0[2], v0[3]); w.z = cvt_pk_bf16(v1[0], v1[1]); w.w = cvt_pk_bf16(v1[2], v1[3]);
                        *(u32x4*)(rowp + bj * 128) = w; } } }
    }
};
struct EpiStoreFp8 {
    static constexpr bool PERM = true;
    unsigned char* C;
    __device__ __forceinline__ void operator()(const f32x4 (&acc)[2][2][4][2], const Unit& u, int wr, int wc, int fr, int fq) const {
        const int col0 = u.pn * 256 + wc * 32 + 8 * fq;
        int rb = wr * 64 + fr; asm volatile("" : "+v"(rb));
#pragma unroll
        for (int ai = 0; ai < 2; ++ai)
#pragma unroll
            for (int m = 0; m < 4; ++m) { const int r = ai * 128 + m * 16 + rb;
                if (r < u.nvalid) { unsigned char* rowp = C + (size_t)(u.row0 + r) * DM + col0;
#pragma unroll
                    for (int bj = 0; bj < 2; ++bj) { const f32x4 v0 = acc[ai][bj][m][0], v1 = acc[ai][bj][m][1];
                        int w0 = __builtin_amdgcn_cvt_pk_fp8_f32(v0[0], v0[1], 0, false); w0 = __builtin_amdgcn_cvt_pk_fp8_f32(v0[2], v0[3], w0, true);
                        int w1 = __builtin_amdgcn_cvt_pk_fp8_f32(v1[0], v1[1], 0, false); w1 = __builtin_amdgcn_cvt_pk_fp8_f32(v1[2], v1[3], w1, true);
                        u32x2 w; w.x = (unsigned)w0; w.y = (unsigned)w1;
                        *(u32x2*)(rowp + bj * 128) = w; } } }
    }
};
struct EpiGateUp {
    static constexpr bool PERM = true;
    bf16_t* ACT; const float* slotw;
    __device__ __forceinline__ void operator()(const f32x4 (&acc)[2][2][4][2], const Unit& u, int wr, int wc, int fr, int fq) const {
        const int col0 = u.pn * 128 + wc * 32 + 8 * fq;
        int rb = wr * 64 + fr; asm volatile("" : "+v"(rb));
#pragma unroll
        for (int ai = 0; ai < 2; ++ai)
#pragma unroll
            for (int m = 0; m < 4; ++m) { const int r = ai * 128 + m * 16 + rb;
                if (r < u.nvalid) { const int slot = u.row0 + r; const float w = (u.aux < 64) ? slotw[slot] : 1.f;
                    float o[8];
#pragma unroll
                    for (int n = 0; n < 2; ++n)
#pragma unroll
                        for (int i = 0; i < 4; ++i) { const float g = acc[ai][0][m][n][i], up = acc[ai][1][m][n][i]; o[4 * n + i] = g / (1.f + __expf(-g)) * up * w; }
                    u32x4 pk; pk.x = cvt_pk_bf16(o[0], o[1]); pk.y = cvt_pk_bf16(o[2], o[3]); pk.z = cvt_pk_bf16(o[4], o[5]); pk.w = cvt_pk_bf16(o[6], o[7]);
                    *(u32x4*)(ACT + (size_t)slot * FF + col0) = pk; } }
    }
};
struct EpiInProj {
    static constexpr bool PERM = false;
    bf16_t *Q, *Kb, *Vb, *P; const float* rope;
    __device__ __forceinline__ void operator()(const f32x4 (&acc)[2][2][4][2], const Unit& u, int wr, int wc, int fr, int fq) const {
        const bool latent = u.row0 < T; const int sec = u.pn >> 1;
        const bool dorope = latent && sec < 2;
        bf16_t* dstU; int n0 = 0;
        if (latent) { const int b = u.row0 / NSEQ; n0 = u.row0 % NSEQ; const size_t kvrow = (size_t)b * SKV + CTXL + n0;
            dstU = sec == 0 ? Q + (size_t)u.row0 * AW : sec == 1 ? Kb + kvrow * AW : sec == 2 ? Vb + kvrow * AW : P + (size_t)u.row0 * PW; }
        else { const int b = (u.row0 - T) / CTXL; dstU = (sec == 1 ? Kb : Vb) + (size_t)b * SKV * AW; }
        dstU += (u.pn & 1) * 256;
        int rb = wr * 64 + fr; asm volatile("" : "+v"(rb));
        const int lcol = wc * 32 + 4 * fq;
#pragma unroll
        for (int ai = 0; ai < 2; ++ai)
#pragma unroll
            for (int m = 0; m < 4; ++m) {
                const int r = ai * 128 + m * 16 + rb;
                f32x4 c4 = (f32x4){1.f, 1.f, 1.f, 1.f}, s4 = (f32x4){0.f, 0.f, 0.f, 0.f};
                if (dorope) { const int pos = (wc & 1) ? (r & 63) : ((n0 >> 6) + (r >> 6)); const float* rp = rope + (pos * 16 + 4 * fq) * 2;
                    const f32x4 cs0 = *(const f32x4*)rp, cs1 = *(const f32x4*)(rp + 4); c4 = (f32x4){cs0[0], cs0[2], cs1[0], cs1[2]}; s4 = (f32x4){cs0[1], cs0[3], cs1[1], cs1[3]}; }
                bf16_t* dst = dstU + r * 512 + lcol;
#pragma unroll
                for (int bj = 0; bj < 2; ++bj) {
                    const f32x4 x1 = acc[ai][bj][m][0], x2 = acc[ai][bj][m][1];
                    const f32x4 o1 = x1 * c4 - x2 * s4, o2 = x2 * c4 + x1 * s4;
                    u32x2 w1, w2; w1.x = cvt_pk_bf16(o1[0], o1[1]); w1.y = cvt_pk_bf16(o1[2], o1[3]); w2.x = cvt_pk_bf16(o2[0], o2[1]); w2.y = cvt_pk_bf16(o2[2], o2[3]);
                    *(u32x2*)(dst + bj * 128) = w1; *(u32x2*)(dst + bj * 128 + 16) = w2;
                }
            }
    }
};
}

__device__ __forceinline__ void ph_inproj_fast(CArgs& a, const Ctx& c) {
    pg8::DenseSched S{(const char*)(a.ws + WS_HX), (const char*)(a.ws + WS_WIN), 8, 528, c.G, c.blk, 512};
    pg8::EpiInProj E{(bf16_t*)(a.ws + WS_Q), (bf16_t*)(a.ws + WS_K), (bf16_t*)(a.ws + WS_V), (bf16_t*)(a.ws + WS_P), (const float*)(a.ws + WS_ROPE)};
    pg8::gemm_phase<pg8::EpiInProj, pg8::DenseSched, true, DM>((LAS unsigned char*)c.lds, S, E, c.tid);
}
__device__ __forceinline__ void ph_outproj_fast(CArgs& a, const Ctx& c) {
    pg8::DenseSched S{(const char*)(a.ws + WS_ATT), (const char*)(a.ws + WS_WOUT), 4, 256, c.G, c.blk, 256};
    pg8::EpiStore E{(bf16_t*)(a.ws + WS_YX), DM, 0, 0};
    pg8::gemm_phase<pg8::EpiStore, pg8::DenseSched, true, DM>((LAS unsigned char*)c.lds, S, E, c.tid);
}
__device__ __forceinline__ void ph_gateup_fast(CArgs& a, const Ctx& c) {
    LAS int* tab = (LAS int*)((LAS unsigned char*)c.lds + LDS_TAB);
    const int ntile = pg8::grouped_table(tab, (const int*)(a.ws + WS_SEG), c.tid);
    pg8::GroupedSched S{(const char*)(a.ws + WS_HX), (const char*)(a.ws + WS_WGU), (const int*)(a.ws + WS_SLOTTOK), tab, 65, 2, ntile * 2, c.G, c.blk, DM, 512};
    pg8::EpiGateUp E{(bf16_t*)(a.ws + WS_ACT), (const float*)(a.ws + WS_SLOTW)};
    pg8::gemm_phase<pg8::EpiGateUp, pg8::GroupedSched, true, DM>((LAS unsigned char*)c.lds, S, E, c.tid);
}
__device__ __forceinline__ void ph_down_fast(CArgs& a, const Ctx& c) {
    LAS int* tab = (LAS int*)((LAS unsigned char*)c.lds + LDS_TAB);
    const int ntile = pg8::grouped_table(tab, (const int*)(a.ws + WS_SEG), c.tid);
    pg8::GroupedSched S{(const char*)(a.ws + WS_ACT), (const char*)(a.ws + WS_WD), nullptr, tab, 65, 4, ntile * 4, c.G, c.blk, FF, DM};
    pg8::EpiStoreFp8 E{(unsigned char*)(a.ws + WS_Y)};
    pg8::gemm_phase<pg8::EpiStoreFp8, pg8::GroupedSched, true, FF>((LAS unsigned char*)c.lds, S, E, c.tid);
}

namespace att {
using bf16x8 = __attribute__((ext_vector_type(8))) short;
using s16x4  = __attribute__((ext_vector_type(4))) short;
using f32x16 = __attribute__((ext_vector_type(16))) float;
using u32x4  = __attribute__((ext_vector_type(4))) unsigned;
constexpr int KVBLK = 64, LDK = 512;
constexpr float SCALE = 0.125f, THR = 8.f;
constexpr int SHM_V = KVBLK * 128 * 2, SHM_K = KVBLK * 128 * 2, OFF_WS = 2 * SHM_V + 2 * SHM_K;
#define KSWZ(row, colB) ((row) * 256 + ((colB) ^ (((row) & 7) << 4)))
#define SBAR() __builtin_amdgcn_sched_barrier(0)
__device__ __forceinline__ int crow(int r, int hi) { return (r & 3) + 8 * (r >> 2) + 4 * hi; }
__device__ __forceinline__ unsigned cvtpk(float lo, float hi) { unsigned r; asm volatile("v_cvt_pk_bf16_f32 %0, %1, %2" : "=v"(r) : "v"(lo), "v"(hi)); return r; }
__device__ __forceinline__ void partialSM(f32x16& p0, f32x16& p1, float& m_reg, float& mn, float& alpha) {
  constexpr float C = SCALE * 1.4426950408889634f;
  float pmax = p0[0];
#pragma unroll
  for (int r = 1; r < 16; ++r) pmax = fmaxf(pmax, p0[r]);
#pragma unroll
  for (int r = 0; r < 16; ++r) pmax = fmaxf(pmax, p1[r]);
  { auto rr = __builtin_amdgcn_permlane32_swap(__float_as_uint(pmax), __float_as_uint(pmax), false, false);
    pmax = fmaxf(__uint_as_float(rr[0]), __uint_as_float(rr[1])); }
  if (__builtin_expect(__all(pmax - m_reg <= THR / SCALE), 1)) { mn = m_reg; alpha = 1.f; }
  else { mn = fmaxf(m_reg, pmax); alpha = __builtin_amdgcn_exp2f((m_reg - mn) * C); m_reg = mn; }
  const float mnC = -mn * C;
#pragma unroll
  for (int r = 0; r < 16; ++r) p0[r] = fmaf(p0[r], C, mnC);
#pragma unroll
  for (int r = 0; r < 16; ++r) p1[r] = fmaf(p1[r], C, mnC);
#pragma unroll
  for (int r = 0; r < 16; ++r) p0[r] = __builtin_amdgcn_exp2f(p0[r]);
}
__device__ __forceinline__ void finishSM(f32x16& p0, f32x16& p1, float alpha, float& l_reg, bf16x8& pa0, bf16x8& pa1, bf16x8& pa2, bf16x8& pa3) {
#pragma unroll
  for (int r = 0; r < 16; ++r) p1[r] = __builtin_amdgcn_exp2f(p1[r]);
  float ps = 0;
#pragma unroll
  for (int r = 0; r < 16; ++r) ps += p0[r];
#pragma unroll
  for (int r = 0; r < 16; ++r) ps += p1[r];
  { auto rr = __builtin_amdgcn_permlane32_swap(__float_as_uint(ps), __float_as_uint(ps), false, false);
    ps = __uint_as_float(rr[0]) + __uint_as_float(rr[1]); }
  l_reg = l_reg * alpha + ps;
#define PK4(P, BASE, OUT) do { unsigned a0 = cvtpk(P[BASE + 0], P[BASE + 1]), a1 = cvtpk(P[BASE + 2], P[BASE + 3]);   \
    unsigned b0 = cvtpk(P[BASE + 4], P[BASE + 5]), b1 = cvtpk(P[BASE + 6], P[BASE + 7]);                              \
    auto r0 = __builtin_amdgcn_permlane32_swap(a0, b0, false, false); auto r1 = __builtin_amdgcn_permlane32_swap(a1, b1, false, false); \
    u32x4 w = {r0[0], r1[0], r0[1], r1[1]}; OUT = *reinterpret_cast<bf16x8*>(&w); } while (0)
  PK4(p0, 0, pa0); PK4(p0, 8, pa1); PK4(p1, 0, pa2); PK4(p1, 8, pa3);
#undef PK4
}
__device__ __forceinline__ void qkt(f32x16& p0, f32x16& p1, const char* Ks, const bf16x8* qr, int r32, int hi, int mcol) {
  p0 = f32x16{}; p1 = f32x16{};
#pragma unroll
  for (int d0 = 0; d0 < 4; ++d0) { const int cb = (mcol + d0 * 16 + hi * 8) * 2;
    const bf16x8 b0 = *reinterpret_cast<const bf16x8*>(Ks + KSWZ(r32, cb));
    const bf16x8 b1 = *reinterpret_cast<const bf16x8*>(Ks + KSWZ(32 + r32, cb));
    p0 = __builtin_amdgcn_mfma_f32_32x32x16_bf16(b0, qr[d0], p0, 0, 0, 0);
    p1 = __builtin_amdgcn_mfma_f32_32x32x16_bf16(b1, qr[d0], p1, 0, 0, 0); }
}
__device__ __forceinline__ int v_st(int k, int c) { const int kk = (k & ~0xC) | ((k & 4) << 1) | ((k & 8) >> 1); return ((kk >> 3) * 4 + (c >> 5)) * 512 + ((kk & 7) * 32 + (c & 31)) * 2; }
__device__ __forceinline__ int v_rd_base(int lane) { return ((lane & 3) << 3) | (((lane >> 2) & 3) << 6) | (((lane >> 4) & 1) << 5) | (((lane >> 5) & 1) << 8); }
constexpr int v_rd_off(int d0, int ks, int half) { return d0 * 512 + ks * 4096 + half * 2048; }
template <int OFF> __device__ __forceinline__ s16x4 tr_read(int vb) {
  s16x4 r; asm volatile("ds_read_b64_tr_b16 %0, %1 offset:%2" : "=&v"(r) : "v"(vb), "i"(OFF) : "memory"); return r;
}
template <int D0> __device__ __forceinline__ void pv_one(f32x16& od, int vb, bf16x8 pa0, bf16x8 pa1, bf16x8 pa2, bf16x8 pa3) {
  const s16x4 l0 = tr_read<v_rd_off(D0, 0, 0)>(vb), h0 = tr_read<v_rd_off(D0, 0, 1)>(vb), l1 = tr_read<v_rd_off(D0, 1, 0)>(vb), h1 = tr_read<v_rd_off(D0, 1, 1)>(vb);
  const s16x4 l2 = tr_read<v_rd_off(D0, 2, 0)>(vb), h2 = tr_read<v_rd_off(D0, 2, 1)>(vb), l3 = tr_read<v_rd_off(D0, 3, 0)>(vb), h3 = tr_read<v_rd_off(D0, 3, 1)>(vb);
  asm volatile("s_waitcnt lgkmcnt(0)" ::: "memory"); SBAR();
#define PK(L, H) (bf16x8){L[0], L[1], L[2], L[3], H[0], H[1], H[2], H[3]}
  od = __builtin_amdgcn_mfma_f32_32x32x16_bf16(pa0, PK(l0, h0), od, 0, 0, 0);
  od = __builtin_amdgcn_mfma_f32_32x32x16_bf16(pa1, PK(l1, h1), od, 0, 0, 0);
  od = __builtin_amdgcn_mfma_f32_32x32x16_bf16(pa2, PK(l2, h2), od, 0, 0, 0);
  od = __builtin_amdgcn_mfma_f32_32x32x16_bf16(pa3, PK(l3, h3), od, 0, 0, 0);
#undef PK
}
__device__ __forceinline__ void pv_d0(f32x16* o, int vb, bf16x8 pa0, bf16x8 pa1, bf16x8 pa2, bf16x8 pa3) {
  pv_one<0>(o[0], vb, pa0, pa1, pa2, pa3); pv_one<1>(o[1], vb, pa0, pa1, pa2, pa3); pv_one<2>(o[2], vb, pa0, pa1, pa2, pa3); pv_one<3>(o[3], vb, pa0, pa1, pa2, pa3);
}
__device__ __forceinline__ void unit(const bf16_t* __restrict__ Qb, const bf16_t* __restrict__ Kh, const bf16_t* __restrict__ Vh, bf16_t* __restrict__ Ob,
                                     const float lam, const float* __restrict__ gsub, char* lds, const int tid) {
  const int wid = __builtin_amdgcn_readfirstlane(tid >> 6), lane = tid & 63, r32 = lane & 31, hi = lane >> 5, qsub = wid & 3, map = wid >> 2, mcol = map * 64;
  char* V_lds = lds; char* K_lds = lds + 2 * SHM_V;
  float* ws = (float*)(lds + OFF_WS) + wid * 64; float* li_l = ws; float* al_l = ws + 32;
  float m_reg = -1e30f, l_reg = 0; f32x16 o[4] = {}; bf16x8 qr[4];
  const bf16_t* Qw = Qb + (size_t)(qsub * 32 + r32) * AW + mcol + hi * 8;
#pragma unroll
  for (int d0 = 0; d0 < 4; ++d0) qr[d0] = *reinterpret_cast<const bf16x8*>(Qw + d0 * 16);
  const int sr = tid >> 4, sc = (tid & 15) * 8, vst0 = v_st(sr, sc), vst1 = v_st(32 + sr, sc);
  const int vb0 = (int)(uintptr_t)V_lds + v_rd_base(lane);
  struct { bf16x8 vs0, vs1, ks0, ks1; } sr_[2];
#define SLOAD(i, k0) do { sr_[i].vs0 = *reinterpret_cast<const bf16x8*>(&Vh[(size_t)((k0) + sr) * LDK + sc]); sr_[i].vs1 = *reinterpret_cast<const bf16x8*>(&Vh[(size_t)((k0) + 32 + sr) * LDK + sc]); \
    sr_[i].ks0 = *reinterpret_cast<const bf16x8*>(&Kh[(size_t)((k0) + sr) * LDK + sc]); sr_[i].ks1 = *reinterpret_cast<const bf16x8*>(&Kh[(size_t)((k0) + 32 + sr) * LDK + sc]); } while (0)
#define SWRITE(b, i) do { *(bf16x8*)(V_lds + (b) * SHM_V + vst0) = sr_[i].vs0; *(bf16x8*)(V_lds + (b) * SHM_V + vst1) = sr_[i].vs1; const int kc = sc * 2; \
    *(bf16x8*)(K_lds + (b) * SHM_K + KSWZ(sr, kc)) = sr_[i].ks0; *(bf16x8*)(K_lds + (b) * SHM_K + KSWZ(32 + sr, kc)) = sr_[i].ks1; } while (0)
#define SWAIT() asm volatile("s_waitcnt vmcnt(4)" ::: "memory")
#define RESC(a) do { if (__any((a) < 1.f)) { if (hi == 0) al_l[r32] = (a); asm volatile("s_waitcnt lgkmcnt(0)" ::: "memory"); \
    _Pragma("unroll") for (int d = 0; d < 4; ++d) _Pragma("unroll") for (int r = 0; r < 16; ++r) o[d][r] *= al_l[crow(r, hi)]; } } while (0)
  f32x16 pA0, pA1, pB0, pB1; float mnA, mnB, alA, alB; bf16x8 pa0, pa1, pa2, pa3; constexpr int NT = SKV / KVBLK;
  SLOAD(0, 0); asm volatile("s_waitcnt vmcnt(0)" ::: "memory"); SWRITE(0, 0); __syncthreads();
  qkt(pA0, pA1, K_lds, qr, r32, hi, mcol); partialSM(pA0, pA1, m_reg, mnA, alA);
  SLOAD(1, KVBLK); SLOAD(0, 2 * KVBLK);
  SWAIT(); SWRITE(1, 1); __syncthreads();
  for (int j = 1; j + 1 < NT; j += 2) {
    SBAR(); qkt(pB0, pB1, K_lds + SHM_K, qr, r32, hi, mcol);
    finishSM(pA0, pA1, alA, l_reg, pa0, pa1, pa2, pa3); SBAR();
    SLOAD(1, (j + 2) * KVBLK); SBAR();
    pv_d0(o, vb0, pa0, pa1, pa2, pa3); partialSM(pB0, pB1, m_reg, mnB, alB);
    __syncthreads(); SWAIT(); SWRITE(0, 0);
    RESC(alB); __syncthreads();
    SBAR(); qkt(pA0, pA1, K_lds, qr, r32, hi, mcol);
    finishSM(pB0, pB1, alB, l_reg, pa0, pa1, pa2, pa3); SBAR();
    if (j + 3 < NT) SLOAD(0, (j + 3) * KVBLK); SBAR();
    pv_d0(o, vb0 + SHM_V, pa0, pa1, pa2, pa3); partialSM(pA0, pA1, m_reg, mnA, alA);
    __syncthreads(); SWAIT(); SWRITE(1, 1);
    RESC(alA); __syncthreads();
  }
  SBAR(); qkt(pB0, pB1, K_lds + SHM_K, qr, r32, hi, mcol);
  finishSM(pA0, pA1, alA, l_reg, pa0, pa1, pa2, pa3); SBAR();
  pv_d0(o, vb0, pa0, pa1, pa2, pa3); partialSM(pB0, pB1, m_reg, mnB, alB);
  __syncthreads(); RESC(alB);
  finishSM(pB0, pB1, alB, l_reg, pa0, pa1, pa2, pa3); SBAR();
  pv_d0(o, vb0 + SHM_V, pa0, pa1, pa2, pa3);
  if (hi == 0) li_l[r32] = l_reg; asm volatile("s_waitcnt lgkmcnt(0)" ::: "memory");
  float rli[16];
#pragma unroll
  for (int r = 0; r < 16; ++r) rli[r] = __builtin_amdgcn_rcpf(li_l[crow(r, hi)]);
  __syncthreads();
  float* X2 = (float*)lds + qsub * 4096 + lane;
  if (map == 1) {
#pragma unroll
    for (int r = 0; r < 16; ++r)
#pragma unroll
      for (int d0 = 0; d0 < 4; ++d0) X2[(r * 4 + d0) * 64] = o[d0][r] * rli[r];
  }
  __syncthreads();
  if (map == 0) {
    float g[4];
#pragma unroll
    for (int d0 = 0; d0 < 4; ++d0) g[d0] = gsub[32 * d0 + r32] * (1.f - LAM_INIT);
#pragma unroll
    for (int r = 0; r < 16; ++r) {
      float ss = 0.f;
#pragma unroll
      for (int d0 = 0; d0 < 4; ++d0) { const float v = o[d0][r] * rli[r] - lam * X2[(r * 4 + d0) * 64]; o[d0][r] = v; ss += v * v; }
#pragma unroll
      for (int m = 1; m < 32; m <<= 1) ss += shx(ss, m, lane);
      const float rs = rsqrtf(ss * (1.f / 128.f) + EPS);
      bf16_t* orow = Ob + (size_t)(qsub * 32 + crow(r, hi)) * DM + r32;
#pragma unroll
      for (int d0 = 0; d0 < 4; ++d0) orow[32 * d0] = (bf16_t)f2bf(o[d0][r] * rs * g[d0]);
    }
  }
  __syncthreads();
#undef SLOAD
#undef SWRITE
#undef SWAIT
#undef RESC
}
#undef KSWZ
#undef SBAR
}
__device__ __forceinline__ void ph_attn_fast(CArgs& a, const Ctx& c) {
  const bf16_t* Q = (const bf16_t*)(a.ws + WS_Q); const bf16_t* Kb = (const bf16_t*)(a.ws + WS_K); const bf16_t* Vb = (const bf16_t*)(a.ws + WS_V); bf16_t* ATT = (bf16_t*)(a.ws + WS_ATT);
  const float lam = *(const float*)(a.ws + WS_LAM);
  constexpr int NU = NB * NH * (NSEQ / 128);
  for (int i = 0; ; ++i) {
    const int L = i * c.G + c.blk; if (L >= NU) break;
    const int v = pg8::xcd_remap(L, NU), qb = v & 31, bh = v >> 5, b = bh >> 2, h = bh & 3;
    const size_t row0 = (size_t)b * NSEQ + qb * 128;
    att::unit(Q + row0 * AW + h * 128, Kb + (size_t)b * SKV * AW + h * 128, Vb + (size_t)b * SKV * AW + h * 128, ATT + row0 * DM + h * 128, lam, a.in[I_GSUBLN], (char*)c.lds, c.tid);
  }
}

constexpr int NPHASE = 10;
__device__ __forceinline__ void run_phase(int ph, CArgs& a, const Ctx& c) {
    switch (ph) {
        case 0: ph_adaln(a, c); ph_transposes(a, c); break;
        case 1: ph_hxrows(a, c); break;
        case 2: ph_inproj_fast(a, c); break;
        case 3: ph_attn_fast(a, c); __syncthreads(); ph_pool_fast(a, c); break;
        case 4: ph_outproj_fast(a, c); break;
        case 5: ph_norm_router_fast(a, c); break;
        case 6: ph_tables(a, c); break;
        case 7: ph_gateup_fast(a, c); break;
        case 8: ph_down_fast(a, c); break;
        case 9: ph_combine(a, c); break;
        default: break;
    }
}
__global__ void __launch_bounds__(512, 2) mega(Args a_) {
    extern __shared__ __attribute__((aligned(16))) unsigned char lds[];
    const int lo = a_.ph_lo, hi = a_.ph_hi;
    { volatile LAS unsigned* z = (volatile LAS unsigned*)((LAS unsigned char*)lds + LDSCTL_OFF); for (int u = threadIdx.x; u < (LDS_BYTES - LDSCTL_OFF) / 4; u += 512) z[u] = 0u; }
    __syncthreads();
    volatile LAS unsigned* MISC = (volatile LAS unsigned*)((LAS unsigned char*)lds + MISC_OFF);
    XcdBarrier bar; bar.bar = (unsigned*)(a_.ws + WS_CTL); bar.x = 0; bar.st = nullptr;
    if (hi - lo > 1) bar = xcd_barrier_post((unsigned*)(a_.ws + WS_CTL), MISC + 8);
#define PHASE(k) if (lo <= (k) && (k) < hi) { \
        int t_ = threadIdx.x; asm volatile("" : "+v"(t_)); \
        CArgs* ap_ = (CArgs*)__builtin_amdgcn_kernarg_segment_ptr(); asm volatile("" : "+s"(ap_)); \
        Ctx c; c.tid = t_; c.lane = t_ & 63; c.wave = __builtin_amdgcn_readfirstlane(t_ >> 6); c.blk = blockIdx.x; c.G = gridDim.x; c.lds = lds; \
        run_phase((k), *ap_, c); \
        if ((k) == REPEAT_PH) { for (int rep_ = 0; rep_ < REPEAT_N; ++rep_) { xcd_barrier(bar); run_phase((k), *ap_, c); } } \
        if ((k) + 1 < hi) xcd_barrier(bar); }
    PHASE(0) PHASE(1) PHASE(2) PHASE(3) PHASE(4) PHASE(5) PHASE(6) PHASE(7) PHASE(8) PHASE(9)
#undef PHASE
}

extern "C" void kernel_launch(void* const* d_in, const int* in_sizes, int n_in, void* d_out, int out_size, void* d_ws, size_t ws_size, hipStream_t stream) {
    static int grid = 0;
    if (grid == 0) {
        if (n_in != 28 || in_sizes[0] != T * DM || out_size != T * DM || ws_size < WS_END) {
            fprintf(stderr, "kernel_launch: unexpected shapes or workspace: n_in %d in0 %d out %d ws %zu (need %zu)\n", n_in, n_in > 0 ? in_sizes[0] : -1, out_size, ws_size, (size_t)WS_END);
            grid = -1; return; }
        int dev = 0, cus = 0;
        if (hipGetDevice(&dev) != hipSuccess || hipDeviceGetAttribute(&cus, hipDeviceAttributeMultiprocessorCount, dev) != hipSuccess) { grid = -1; return; }
        if (hipFuncSetAttribute((const void*)mega, hipFuncAttributeMaxDynamicSharedMemorySize, LDS_BYTES) != hipSuccess) { fprintf(stderr, "kernel_launch: hipFuncSetAttribute failed\n"); grid = -1; return; }
        grid = cus;
    }
    if (grid < 0) return;
    (void)hipMemsetAsync((char*)d_ws + WS_CTL, 0, CTL_ZERO_BYTES, stream);
    Args a{};
    for (int i = 0; i < 28; ++i) a.in[i] = (const float*)d_in[i];
    a.out = (float*)d_out; a.ws = (unsigned char*)d_ws;
#if MK_PER_PHASE_LAUNCH
    for (int p = 0; p < NPHASE; ++p) { a.ph_lo = p; a.ph_hi = p + 1; hipLaunchKernelGGL(mega, dim3(grid), dim3(512), LDS_BYTES, stream, a); }
#else
    a.ph_lo = 0; a.ph_hi = NPHASE; hipLaunchKernelGGL(mega, dim3(grid), dim3(512), LDS_BYTES, stream, a);
#endif
    const hipError_t le = hipPeekAtLastError();
    if (le != hipSuccess) fprintf(stderr, "kernel_launch: launch failed: %s\n", hipGetErrorName(le));
}
```

```cpp
#include <hip/hip_runtime.h>
#include <cstdio>
#include <cstdint>

#ifndef REPK_DOWN
#define REPK_DOWN 1
#endif
#ifndef REPK_GU
#define REPK_GU 1
#endif
#ifndef REPEAT_PH
#define REPEAT_PH (-1)
#endif
#ifndef REPEAT_N
#define REPEAT_N 1
#endif
#ifndef MK_PER_PHASE_LAUNCH
#define MK_PER_PHASE_LAUNCH 0
#endif

constexpr int NB = 4, NSEQ = 4096, DM = 1024, T = NB * NSEQ, CTXL = 256, TC = NB * CTXL, TT = T + TC;
constexpr int NH = 4, DQK = 64, DV = 128, AW = 512, INW = 2048, PW = 512;
constexpr int SKV = CTXL + NSEQ;
constexpr int NE = 64, FF = 256, TOPK = 8;
constexpr int NSLOT_R = T * TOPK;
constexpr int NSLOT = NSLOT_R + T;
constexpr float EPS = 1e-6f;
constexpr float LAM_INIT = 0.2f;
constexpr int NVB = 256;

typedef unsigned short bf16_t;
typedef unsigned int u32;

constexpr size_t KiB = 1024, MiB = 1024 * 1024;
constexpr size_t WS_CTL = 0;
constexpr size_t CTL_ZERO_BYTES = 64 * KiB;
constexpr size_t WS_MODS = 64 * KiB;
constexpr size_t WS_LAM = 192 * KiB;
constexpr size_t WS_ROPE = 196 * KiB;
constexpr size_t WS_SEG = 208 * KiB;
constexpr size_t WS_BLKCNT = 256 * KiB;
constexpr size_t WS_TOPE = 512 * KiB;
constexpr size_t WS_TOPW = 1 * MiB;
constexpr size_t WS_TOKSLOT = 1 * MiB + 512 * KiB;
constexpr size_t WS_SLOTTOK = 2 * MiB;
constexpr size_t WS_SLOTW = 2 * MiB + 512 * KiB;
constexpr size_t WS_SLOTE = 3 * MiB;
constexpr size_t WS_WPOOL = 3 * MiB + 512 * KiB;
constexpr size_t WS_WD = 4 * MiB;
constexpr size_t WS_WGU = WS_WD + 33280 * KiB;
constexpr size_t WS_HX = WS_WGU + 65 * MiB;
constexpr size_t WS_WIN = WS_HX + 34 * MiB;
constexpr size_t WS_WOUT = WS_WIN + 4 * MiB;
constexpr size_t WS_Q = WS_WOUT + 2 * MiB;
constexpr size_t WS_K = WS_Q + 16 * MiB;
constexpr size_t WS_V = WS_K + 17 * MiB;
constexpr size_t WS_P = WS_V + 17 * MiB;
constexpr size_t WS_ATT = WS_P + 16 * MiB;
constexpr size_t WS_YX = WS_ATT + 32 * MiB;
constexpr size_t WS_ACT = 227 * MiB + 256 * KiB;
constexpr size_t WS_Y = WS_WGU;
constexpr size_t WS_END = WS_ACT + (size_t)(NSLOT + 256) * FF * 2;
static_assert(WS_YX + 32 * MiB <= WS_END + 64 * MiB, "map");
static_assert(WS_Y + (size_t)(NSLOT + 256) * DM <= WS_ACT, "Y must not reach ACT");

constexpr int LDS_BYTES = 163840;
constexpr int LDS_MAIN = 140 * 1024;
constexpr int LDS_TOKL = 140 * 1024;
constexpr int LDS_ROPE = 148 * 1024;
constexpr int LDSCTL_OFF = 156 * 1024;
constexpr int MISC_OFF = LDSCTL_OFF + 320;

#define GAS __attribute__((address_space(1)))
#define LAS __attribute__((address_space(3)))

__device__ __forceinline__ u32 f2bf(float f) { u32 u = __float_as_uint(f); return (u + 0x7fffu + ((u >> 16) & 1u)) >> 16; }
__device__ __forceinline__ u32 pk2(float lo, float hi) { return f2bf(lo) | (f2bf(hi) << 16); }
__device__ __forceinline__ float bflo(u32 w) { return __uint_as_float(w << 16); }
__device__ __forceinline__ float bfhi(u32 w) { return __uint_as_float(w & 0xffff0000u); }
__device__ __forceinline__ float bf2f(bf16_t b) { return __uint_as_float(((u32)b) << 16); }
__device__ __forceinline__ float shx(float v, int m, int lane) { return __int_as_float(__builtin_amdgcn_ds_bpermute((lane ^ m) << 2, __float_as_int(v))); }
__device__ __forceinline__ float shl(float v, int src) { return __int_as_float(__builtin_amdgcn_ds_bpermute(src << 2, __float_as_int(v))); }
__device__ __forceinline__ float wave_sum(float v, int lane) {
#pragma unroll
    for (int o = 1; o < 64; o <<= 1) v += shx(v, o, lane);
    return v;
}
__device__ __forceinline__ float wave_max(float v, int lane) {
#pragma unroll
    for (int o = 1; o < 64; o <<= 1) v = fmaxf(v, shx(v, o, lane));
    return v;
}
__device__ __forceinline__ float silu_f(float v) { return v / (1.f + __expf(-v)); }
__device__ __forceinline__ float dot8(uint4 a, uint4 b, float acc) {
    acc = fmaf(bflo(a.x), bflo(b.x), acc); acc = fmaf(bfhi(a.x), bfhi(b.x), acc);
    acc = fmaf(bflo(a.y), bflo(b.y), acc); acc = fmaf(bfhi(a.y), bfhi(b.y), acc);
    acc = fmaf(bflo(a.z), bflo(b.z), acc); acc = fmaf(bfhi(a.z), bfhi(b.z), acc);
    acc = fmaf(bflo(a.w), bflo(b.w), acc); acc = fmaf(bfhi(a.w), bfhi(b.w), acc);
    return acc;
}
__device__ __forceinline__ float ndot(const bf16_t* a, const bf16_t* b, int K) {
    float a0 = 0.f, a1 = 0.f;
    for (int k = 0; k < K; k += 16) {
        const uint4 x0 = *(const uint4*)(a + k), y0 = *(const uint4*)(b + k), x1 = *(const uint4*)(a + k + 8), y1 = *(const uint4*)(b + k + 8);
        a0 = dot8(x0, y0, a0); a1 = dot8(x1, y1, a1);
    }
    return a0 + a1;
}

#define XB_TMO      128
#define XB_XCNT(j)  (256  + 64 * (j))
#define XB_XSUB(j)  (1280 + 64 * (j))
#define XB_XGEN(j)  (2304 + 64 * (j))
#define XB_TOP      3328
#define XB_TOPGEN   3392
#define XCD_BAR_WORDS 3456
#define XB_SPIN_CAP (1u << 22)
__device__ __forceinline__ unsigned xb_ld(unsigned* p)              { return __hip_atomic_load(p, __ATOMIC_RELAXED, __HIP_MEMORY_SCOPE_AGENT); }
__device__ __forceinline__ unsigned xb_add(unsigned* p, unsigned v) { return __hip_atomic_fetch_add(p, v, __ATOMIC_RELAXED, __HIP_MEMORY_SCOPE_AGENT); }
__device__ __forceinline__ unsigned xb_xcc_id() { return (unsigned)__builtin_amdgcn_s_getreg((3 << 11) | 20) & 0xFu; }
#define XB_SPIN(cond, bar) do { unsigned _sp = 0; while (cond) { __builtin_amdgcn_s_sleep(1); \
    if ((++_sp & 255u) == 0u) { if (xb_ld(&(bar)[XB_TMO])) break; if (_sp > XB_SPIN_CAP) { atomicAdd(&(bar)[XB_TMO], 1u); break; } } } } while (0)
struct XcdBarrier { unsigned* bar; unsigned x; volatile LAS unsigned* st; };
__device__ __forceinline__ XcdBarrier xcd_barrier_post(unsigned* bar, volatile LAS unsigned* st) {
    XcdBarrier b; b.bar = bar; b.x = xb_xcc_id(); b.st = st;
    if (threadIdx.x == 0) (void)xb_add(&bar[XB_XCNT(b.x)], 1u);
    return b;
}
__device__ __forceinline__ void xcd_barrier_complete(unsigned* bar, unsigned x, unsigned& nloc, unsigned& nx) {
    const unsigned G = gridDim.x * gridDim.y * gridDim.z;
    unsigned sum, cnt, mine, sp = 0u;
    for (;;) {
        sum = 0u; cnt = 0u; mine = 0u;
#pragma unroll
        for (unsigned j = 0; j < 16; ++j) { const unsigned c = xb_ld(&bar[XB_XCNT(j)]); sum += c; cnt += (c > 0u) ? 1u : 0u; mine = (j == x) ? c : mine; }
        if (sum == G) break;
        __builtin_amdgcn_s_sleep(1);
        if ((++sp & 255u) == 0u) { if (xb_ld(&bar[XB_TMO])) break; if (sp > XB_SPIN_CAP) { atomicAdd(&bar[XB_TMO], 1u); break; } }
    }
    nloc = mine > 0u ? mine : 1u; nx = cnt > 0u ? cnt : 1u;
}
__device__ __forceinline__ void xcd_barrier(const XcdBarrier& b) {
    asm volatile("s_waitcnt vmcnt(0)" ::: "memory");
    __syncthreads();
    if (threadIdx.x == 0) {
        unsigned* bar = b.bar;
        __builtin_amdgcn_s_waitcnt(0);
        unsigned nloc = b.st[0], nx = b.st[1];
        if (nloc == 0u) { xcd_barrier_complete(bar, b.x, nloc, nx); b.st[0] = nloc; b.st[1] = nx; }
        const unsigned old = xb_add(&bar[XB_XSUB(b.x)], 1u);
        const unsigned gen = old / nloc;
        if (old + 1u == (gen + 1u) * nloc) {
            __builtin_amdgcn_fence(__ATOMIC_RELEASE, "agent");
            asm volatile("s_waitcnt vmcnt(0)" ::: "memory");
            const unsigned og = xb_add(&bar[XB_TOP], 1u);
            const unsigned tg = og / nx;
            if (og + 1u == (tg + 1u) * nx) xb_add(&bar[XB_TOPGEN], 1u);
            else XB_SPIN(xb_ld(&bar[XB_TOPGEN]) == tg, bar);
            __builtin_amdgcn_fence(__ATOMIC_ACQUIRE, "agent");
            xb_add(&bar[XB_XGEN(b.x)], 1u);
            asm volatile("s_waitcnt vmcnt(0)" ::: "memory");
        } else {
            XB_SPIN(xb_ld(&bar[XB_XGEN(b.x)]) == gen, bar);
            __builtin_amdgcn_fence(__ATOMIC_ACQUIRE, "agent");
            asm volatile("s_waitcnt vmcnt(0)" ::: "memory");
        }
    }
    __syncthreads();
}


constexpr int CW_ADALN = 4096;
__device__ __forceinline__ void flag_arrive(unsigned* cnt, int tid) {
    asm volatile("s_waitcnt vmcnt(0)" ::: "memory");
    __syncthreads();
    if (tid == 0) { __builtin_amdgcn_fence(__ATOMIC_RELEASE, "agent"); asm volatile("s_waitcnt vmcnt(0)" ::: "memory"); (void)xb_add(cnt, 1u); }
}
__device__ __forceinline__ void flag_wait(unsigned* cnt, unsigned target, int tid) {
    if (tid == 0) { unsigned sp = 0; while (xb_ld(cnt) < target) { __builtin_amdgcn_s_sleep(2); if (++sp > (1u << 24)) break; }
        __builtin_amdgcn_fence(__ATOMIC_ACQUIRE, "agent"); asm volatile("s_waitcnt vmcnt(0)" ::: "memory"); }
    __syncthreads();
}

struct Args {
    const float* in[28];
    float* out;
    unsigned char* ws;
    int ph_lo, ph_hi;
};
enum { I_X = 0, I_C, I_CTX, I_CCTX, I_WADA, I_BADA, I_GPREMIX, I_GPOSTMIX, I_GPREFFN, I_GPOSTFFN, I_WIN, I_LQ1, I_LK1, I_LQ2, I_LK2,
       I_GSUBLN, I_WPOOL, I_BPOOL, I_PSCALE, I_WOUT, I_WROUTER, I_RBIAS, I_WEG, I_WEU, I_WED, I_WSG, I_WSU, I_WSD };

typedef __attribute__((address_space(4))) const Args CArgs;
struct Ctx {
    int tid, lane, wave, blk, G;
    unsigned char* lds;
};

__device__ __forceinline__ void ph_adaln(CArgs& a, const Ctx& c) {
    float* MODS = (float*)(a.ws + WS_MODS);
    float* red = (float*)c.lds;
    const float* w_ada = a.in[I_WADA];
    const int ksub = c.lane / 6, c4 = c.lane % 6;
    for (int it = c.blk; it < 256; it += c.G) {
        float acc[5][4];
#pragma unroll
        for (int r = 0; r < 5; ++r)
#pragma unroll
            for (int j = 0; j < 4; ++j) acc[r][j] = 0.f;
        if (ksub < 10) {
            for (int i = 0; i < 13; ++i) { const int kk = ksub + 10 * i;
                if (kk < 128) { const int k = c.wave * 128 + kk;
                    const float4 w = *(const float4*)(w_ada + (size_t)k * 6144 + it * 24 + 4 * c4);
#pragma unroll
                    for (int r = 0; r < 5; ++r) { const float sv = silu_f((r < 4) ? a.in[I_C][r * DM + k] : a.in[I_CCTX][k]);
                        acc[r][0] = fmaf(sv, w.x, acc[r][0]); acc[r][1] = fmaf(sv, w.y, acc[r][1]); acc[r][2] = fmaf(sv, w.z, acc[r][2]); acc[r][3] = fmaf(sv, w.w, acc[r][3]); } } }
#pragma unroll
            for (int r = 0; r < 5; ++r)
#pragma unroll
                for (int j = 0; j < 4; ++j) red[((c.wave * 10 + ksub) * 5 + r) * 24 + 4 * c4 + j] = acc[r][j];
        }
        __syncthreads();
        if (c.tid < 120) { const int r = c.tid / 24, col = c.tid % 24; float sum = 0.f;
            for (int q = 0; q < 80; ++q) sum += red[(q * 5 + r) * 24 + col];
            MODS[r * 6144 + it * 24 + col] = sum + a.in[I_BADA][it * 24 + col]; }
        __syncthreads();
    }
    if (c.blk == c.G - 1) {
        float* ROPE = (float*)(a.ws + WS_ROPE);
        for (int i = c.tid; i < 1024; i += 512) {
            const int pos = i >> 4, fi = i & 15;
            const float freq = powf(10000.f, -(float)fi / 16.f);
            const float ang = (float)pos * freq;
            ROPE[i * 2] = cosf(ang); ROPE[i * 2 + 1] = sinf(ang);
        }
        if (c.wave == 0) {
            const float s1 = wave_sum(a.in[I_LQ1][c.lane] * a.in[I_LK1][c.lane], c.lane);
            const float s2 = wave_sum(a.in[I_LQ2][c.lane] * a.in[I_LK2][c.lane], c.lane);
            if (c.lane == 0) *(float*)(a.ws + WS_LAM) = expf(s1) - expf(s2) + LAM_INIT;
        }
    }
    __syncthreads();
}

__device__ __forceinline__ void transpose_item(const float* W, int K, int N, bf16_t* WT, int k0, int n0, int drow0, float* scr, int lane) {
    float v[32];
#pragma unroll
    for (int i = 0; i < 32; ++i) v[i] = W[(size_t)(k0 + 2 * i + (lane >> 5)) * N + n0 + (lane & 31)];
#pragma unroll
    for (int i = 0; i < 32; ++i) scr[(2 * i + (lane >> 5)) * 33 + (lane & 31)] = v[i];
    asm volatile("s_waitcnt lgkmcnt(0)" ::: "memory");
    const int cc = lane & 7;
#pragma unroll
    for (int j = 0; j < 4; ++j) { const int n = (lane >> 3) + 8 * j; const float* s = scr + (8 * cc) * 33 + n;
        uint4 o; o.x = pk2(s[0 * 33], s[1 * 33]); o.y = pk2(s[2 * 33], s[3 * 33]); o.z = pk2(s[4 * 33], s[5 * 33]); o.w = pk2(s[6 * 33], s[7 * 33]);
        *(uint4*)(WT + (size_t)(drow0 + n) * K + k0 + 8 * cc) = o; }
    asm volatile("s_waitcnt lgkmcnt(0)" ::: "memory");
}
__device__ __forceinline__ void ph_transposes(CArgs& a, const Ctx& c) {
    float* scr = (float*)(c.lds + c.wave * 16384);
    const int gw = c.blk * 8 + c.wave, NGW = c.G * 8;
    constexpr int I_IN = 16 * 64, I_OUT = 16 * 32, I_G = 16 * 8, I_D = 4 * 32;
    constexpr int I_P = 4 * 2 * 4;
    constexpr int NIT = I_IN + I_OUT + 65 * (2 * I_G + I_D) + I_P;
    bf16_t* WIN = (bf16_t*)(a.ws + WS_WIN); bf16_t* WOUT = (bf16_t*)(a.ws + WS_WOUT); bf16_t* WGU = (bf16_t*)(a.ws + WS_WGU); bf16_t* WD = (bf16_t*)(a.ws + WS_WD);
    for (int it = gw; it < NIT; it += NGW) {
        int r = it;
        if (r < I_IN) { const int kb = r / 64, nb = r % 64; transpose_item(a.in[I_WIN], DM, INW, WIN, kb * 64, nb * 32, nb * 32, scr, c.lane); continue; } r -= I_IN;
        if (r < I_OUT) { const int kb = r / 32, nb = r % 32; transpose_item(a.in[I_WOUT], DM, DM, WOUT, kb * 64, nb * 32, nb * 32, scr, c.lane); continue; } r -= I_OUT;
        if (r >= 65 * (2 * I_G + I_D)) { r -= 65 * (2 * I_G + I_D); const int g = r >> 3, kb = (r >> 2) & 1, nb = r & 3;
            transpose_item(a.in[I_WPOOL] + (size_t)g * 128 * 128, 128, 128, (bf16_t*)(a.ws + WS_WPOOL) + (size_t)g * 128 * 128, kb * 64, nb * 32, nb * 32, scr, c.lane); continue; }
        const int e = r / (2 * I_G + I_D); r -= e * (2 * I_G + I_D);
        if (r < 2 * I_G) {
            const int up = r / I_G; r -= up * I_G; const int kb = r / 8, nb = r % 8, n0 = nb * 32;
            const float* src = (e < 64) ? a.in[up ? I_WEU : I_WEG] + (size_t)e * DM * FF : a.in[up ? I_WSU : I_WSG];
            transpose_item(src, DM, FF, WGU + (size_t)e * 512 * DM, kb * 64, n0, 256 * (n0 >> 7) + (n0 & 127) + (up ? 128 : 0), scr, c.lane);
        } else {
            r -= 2 * I_G; const int kb = r / 32, nb = r % 32;
            const float* src = (e < 64) ? a.in[I_WED] + (size_t)e * FF * DM : a.in[I_WSD];
            transpose_item(src, FF, DM, WD + (size_t)e * DM * FF, kb * 64, nb * 32, nb * 32, scr, c.lane);
        }
    }
}
__device__ __forceinline__ void ph_hxrows(CArgs& a, const Ctx& c) {
    const int gw = c.blk * 8 + c.wave, NGW = c.G * 8;
    const float* MODS = (const float*)(a.ws + WS_MODS); bf16_t* HX = (bf16_t*)(a.ws + WS_HX);
    for (int m = gw; m < TT; m += NGW) {
        const float* xr = (m < T) ? a.in[I_X] + (size_t)m * DM : a.in[I_CTX] + (size_t)(m - T) * DM;
        const float* md = MODS + (size_t)((m < T) ? (m / NSEQ) : 4) * 6144;
        float4 v[4]; float ss = 0.f;
#pragma unroll
        for (int j = 0; j < 4; ++j) { v[j] = *(const float4*)(xr + 4 * c.lane + 256 * j); ss += v[j].x * v[j].x + v[j].y * v[j].y + v[j].z * v[j].z + v[j].w * v[j].w; }
        const float rs = rsqrtf(wave_sum(ss, c.lane) * (1.f / DM) + EPS);
#pragma unroll
        for (int j = 0; j < 4; ++j) {
            const int col = 4 * c.lane + 256 * j;
            const float4 g = *(const float4*)(a.in[I_GPREMIX] + col), sh = *(const float4*)(md + col), sc = *(const float4*)(md + 1024 + col);
            const float o0 = v[j].x * rs * g.x * (1.f + sc.x) + sh.x, o1 = v[j].y * rs * g.y * (1.f + sc.y) + sh.y;
            const float o2 = v[j].z * rs * g.z * (1.f + sc.z) + sh.z, o3 = v[j].w * rs * g.w * (1.f + sc.w) + sh.w;
            uint2 w; w.x = pk2(o0, o1); w.y = pk2(o2, o3);
            *(uint2*)(HX + (size_t)m * DM + col) = w;
        }
    }
}

__device__ __forceinline__ void route_token(CArgs& a, const Ctx& c, const int t, const float logit, int* hist) {
    int* TOPE = (int*)(a.ws + WS_TOPE); float* TOPW = (float*)(a.ws + WS_TOPW);
    const float score = 1.f / (1.f + expf(-logit));
    const float biased = score + a.in[I_RBIAS][c.lane];
    int grank = 0;
#pragma unroll
    for (int j = 0; j < 8; ++j) { const float vj = shl(biased, (c.lane & ~7) + j); grank += (vj > biased || (vj == biased && j < (c.lane & 7))) ? 1 : 0; }
    float gs = (grank < 2) ? biased : 0.f;
    gs += shx(gs, 1, c.lane); gs += shx(gs, 2, c.lane); gs += shx(gs, 4, c.lane);
    int gr = 0; const int myg = c.lane >> 3;
#pragma unroll
    for (int g = 0; g < 8; ++g) { const float sg = __int_as_float(__builtin_amdgcn_readlane(__float_as_int(gs), g * 8)); gr += (sg > gs || (sg == gs && g < myg)) ? 1 : 0; }
    const float masked = (gr < 4) ? biased : -INFINITY;
    int cnt = 0;
#pragma unroll
    for (int j = 0; j < 64; ++j) { const float vj = __int_as_float(__builtin_amdgcn_readlane(__float_as_int(masked), j)); cnt += (vj > masked || (vj == masked && j < c.lane)) ? 1 : 0; }
    const bool sel = cnt < TOPK;
    const float ssum = wave_sum(sel ? score : 0.f, c.lane);
    if (sel) {
        const int lr = atomicAdd(&hist[c.lane], 1);
        TOPE[t * 8 + cnt] = c.lane | (lr << 8);
        TOPW[t * 8 + cnt] = score / ssum * 2.5f;
    }
}
__device__ __forceinline__ void ph_norm_router_fast(CArgs& a, const Ctx& c) {
    typedef float f32x16 __attribute__((ext_vector_type(16)));
    constexpr int HSS = 1025;
    float* HS = (float*)c.lds;
    int* hist = (int*)(c.lds + 131328);
    int* BLKCNT = (int*)(a.ws + WS_BLKCNT);
    const float* wr = a.in[I_WROUTER];
    const int kq = c.wave >> 1, jt = c.wave & 1;
    const bf16_t* YX = (const bf16_t*)(a.ws + WS_YX); bf16_t* HX2 = (bf16_t*)(a.ws + WS_HX);
    for (int vb = c.blk; vb < NVB; vb += c.G) {
        if (c.tid < 64) hist[c.tid] = 0;
        __syncthreads();
        for (int pass = 0; pass < 2; ++pass) {
            const int t0 = vb * 64 + pass * 32;
            {
            float A1[16], G2[16], SH[16];
            { const float* md = (const float*)(a.ws + WS_MODS) + (size_t)((vb * 64) / NSEQ) * 6144;
#pragma unroll
              for (int j = 0; j < 4; ++j) { const int col = 4 * c.lane + 256 * j;
                  const float4 gp = *(const float4*)(a.in[I_GPOSTMIX] + col), ga = *(const float4*)(md + 2048 + col), g = *(const float4*)(a.in[I_GPREFFN] + col), sh = *(const float4*)(md + 3072 + col), sc = *(const float4*)(md + 4096 + col);
                  A1[4 * j] = ga.x * gp.x; A1[4 * j + 1] = ga.y * gp.y; A1[4 * j + 2] = ga.z * gp.z; A1[4 * j + 3] = ga.w * gp.w;
                  G2[4 * j] = g.x * (1.f + sc.x); G2[4 * j + 1] = g.y * (1.f + sc.y); G2[4 * j + 2] = g.z * (1.f + sc.z); G2[4 * j + 3] = g.w * (1.f + sc.w);
                  SH[4 * j] = sh.x; SH[4 * j + 1] = sh.y; SH[4 * j + 2] = sh.z; SH[4 * j + 3] = sh.w; } }
            {
#pragma unroll 1
              for (int ip = 0; ip < 4; ++ip) {
                uint2 yv[1][4]; float4 xv[1][4];
#pragma unroll
                for (int i = 0; i < 1; ++i) { const size_t t = (size_t)(t0 + c.wave * 4 + ip + i);
#pragma unroll
                    for (int j = 0; j < 4; ++j) { yv[i][j] = *(const uint2*)(YX + t * DM + 4 * c.lane + 256 * j); xv[i][j] = *(const float4*)(a.in[I_X] + t * DM + 4 * c.lane + 256 * j); } }
#pragma unroll
                for (int i = 0; i < 1; ++i) { const int ti = c.wave * 4 + ip + i; const size_t t = (size_t)(t0 + ti); float* row = HS + ti * HSS;
                    float v[16]; float ss = 0.f;
#pragma unroll
                    for (int j = 0; j < 4; ++j) { v[4 * j] = bflo(yv[i][j].x); v[4 * j + 1] = bfhi(yv[i][j].x); v[4 * j + 2] = bflo(yv[i][j].y); v[4 * j + 3] = bfhi(yv[i][j].y); }
#pragma unroll
                    for (int j = 0; j < 16; ++j) ss += v[j] * v[j];
                    const float r1 = rsqrtf(wave_sum(ss, c.lane) * (1.f / DM) + EPS);
                    float ss2 = 0.f;
#pragma unroll
                    for (int j = 0; j < 4; ++j) { float4 x1;
                        x1.x = fmaf(A1[4 * j], v[4 * j] * r1, xv[i][j].x); x1.y = fmaf(A1[4 * j + 1], v[4 * j + 1] * r1, xv[i][j].y);
                        x1.z = fmaf(A1[4 * j + 2], v[4 * j + 2] * r1, xv[i][j].z); x1.w = fmaf(A1[4 * j + 3], v[4 * j + 3] * r1, xv[i][j].w);
                        *(float4*)(a.out + t * DM + 4 * c.lane + 256 * j) = x1;
                        v[4 * j] = x1.x; v[4 * j + 1] = x1.y; v[4 * j + 2] = x1.z; v[4 * j + 3] = x1.w;
                        ss2 += x1.x * x1.x + x1.y * x1.y + x1.z * x1.z + x1.w * x1.w; }
                    const float r2 = rsqrtf(wave_sum(ss2, c.lane) * (1.f / DM) + EPS);
#pragma unroll
                    for (int j = 0; j < 4; ++j) { const int col = 4 * c.lane + 256 * j;
                        const float h0 = fmaf(v[4 * j] * r2, G2[4 * j], SH[4 * j]), h1 = fmaf(v[4 * j + 1] * r2, G2[4 * j + 1], SH[4 * j + 1]);
                        const float h2 = fmaf(v[4 * j + 2] * r2, G2[4 * j + 2], SH[4 * j + 2]), h3 = fmaf(v[4 * j + 3] * r2, G2[4 * j + 3], SH[4 * j + 3]);
                        uint2 w; w.x = pk2(h0, h1); w.y = pk2(h2, h3);
                        *(uint2*)(HX2 + t * DM + col) = w;
                        row[col] = h0; row[col + 1] = h1; row[col + 2] = h2; row[col + 3] = h3; } }
              }
            }
            }
            __syncthreads();
            f32x16 acc = {};
            { int ln_ = c.lane; asm volatile("" : "+v"(ln_)); const int r32 = ln_ & 31, hi = ln_ >> 5;
              const float* ap = HS + r32 * HSS + kq * 256 + hi; const float* bp = wr + (size_t)(kq * 256 + hi) * NE + jt * 32 + r32;
              float b0[32], b1[32]; const float* bpl = bp; asm volatile("" : "+v"(bpl));
#define RT_LOADB(dst, bt) do { _Pragma("unroll") for (int g_ = 0; g_ < 4; ++g_) { const float* pg_ = bpl + (size_t)2 * ((bt) * 32 + g_ * 8) * NE; \
                  _Pragma("unroll") for (int q_ = 0; q_ < 8; ++q_) dst[g_ * 8 + q_] = pg_[2 * q_ * NE]; } } while (0)
              RT_LOADB(b0, 0);
              RT_LOADB(b1, 1);
#pragma unroll
              for (int q = 0; q < 32; ++q) acc = __builtin_amdgcn_mfma_f32_32x32x2f32(ap[2 * q], b0[q], acc, 0, 0, 0);
              RT_LOADB(b0, 2);
#pragma unroll
              for (int q = 0; q < 32; ++q) acc = __builtin_amdgcn_mfma_f32_32x32x2f32(ap[2 * (32 + q)], b1[q], acc, 0, 0, 0);
              RT_LOADB(b1, 3);
#pragma unroll
              for (int q = 0; q < 32; ++q) acc = __builtin_amdgcn_mfma_f32_32x32x2f32(ap[2 * (64 + q)], b0[q], acc, 0, 0, 0);
#pragma unroll
              for (int q = 0; q < 32; ++q) acc = __builtin_amdgcn_mfma_f32_32x32x2f32(ap[2 * (96 + q)], b1[q], acc, 0, 0, 0);
#undef RT_LOADB
            }
            __syncthreads();
#pragma unroll
            for (int r = 0; r < 16; ++r) HS[(kq * 32 + ((r & 3) + 8 * (r >> 2) + 4 * (c.lane >> 5))) * 64 + jt * 32 + (c.lane & 31)] = acc[r];
            __syncthreads();
            for (int i = 0; i < 4; ++i) { const int ti = c.wave * 4 + i;
                const float lg = ((HS[(0 * 32 + ti) * 64 + c.lane] + HS[(1 * 32 + ti) * 64 + c.lane]) + HS[(2 * 32 + ti) * 64 + c.lane]) + HS[(3 * 32 + ti) * 64 + c.lane];
                route_token(a, c, t0 + ti, lg, hist); }
            __syncthreads();
        }
        if (c.tid < 64) BLKCNT[vb * 64 + c.tid] = hist[c.tid];
        __syncthreads();
    }
}

__device__ __forceinline__ void ph_pool_fast(CArgs& a, const Ctx& c) {
    typedef short bf16x8 __attribute__((ext_vector_type(8)));
    typedef float f32x16 __attribute__((ext_vector_type(16)));
    const bf16_t* P = (const bf16_t*)(a.ws + WS_P); bf16_t* ATT = (bf16_t*)(a.ws + WS_ATT); const bf16_t* WPT = (const bf16_t*)(a.ws + WS_WPOOL);
    constexpr int DSTR = 1040;
    char* Dl = (char*)c.lds;
    for (int u = c.blk; u < T / 64; u += c.G) {
        const int row0 = u * 64, n0 = row0 % NSEQ;
        __syncthreads();
        {
            const int cc = c.tid & 63, rr = c.tid >> 6, g = cc >> 4, w = 2 << g, hw = w >> 1;
            const bf16_t* pc = P + (size_t)(row0 - n0) * PW + cc * 8;
            float s[8];
#pragma unroll
            for (int j = 0; j < 8; ++j) s[j] = 0.f;
            const int nfirst = n0 + rr * 8;
            int lo = nfirst - hw; if (lo < 0) lo = 0; int hiw = nfirst + hw; if (hiw > NSEQ) hiw = NSEQ;
            for (int n = lo; n < hiw; ++n) { const uint4 q = *(const uint4*)(pc + (size_t)n * PW);
                s[0] += bflo(q.x); s[1] += bfhi(q.x); s[2] += bflo(q.y); s[3] += bfhi(q.y); s[4] += bflo(q.z); s[5] += bfhi(q.z); s[6] += bflo(q.w); s[7] += bfhi(q.w); }
            for (int i = 0; i < 8; ++i) {
                const int n = nfirst + i;
                if (i > 0) {
                    const int nadd = n + hw - 1, nsub = n - hw - 1;
                    if (nadd < NSEQ) { const uint4 q = *(const uint4*)(pc + (size_t)nadd * PW);
                        s[0] += bflo(q.x); s[1] += bfhi(q.x); s[2] += bflo(q.y); s[3] += bfhi(q.y); s[4] += bflo(q.z); s[5] += bfhi(q.z); s[6] += bflo(q.w); s[7] += bfhi(q.w); }
                    if (nsub >= 0) { const uint4 q = *(const uint4*)(pc + (size_t)nsub * PW);
                        s[0] -= bflo(q.x); s[1] -= bfhi(q.x); s[2] -= bflo(q.y); s[3] -= bfhi(q.y); s[4] -= bflo(q.z); s[5] -= bfhi(q.z); s[6] -= bflo(q.w); s[7] -= bfhi(q.w); }
                }
                int l2 = n - hw; if (l2 < 0) l2 = 0; int h2 = n + hw; if (h2 > NSEQ) h2 = NSEQ;
                const float inv = 1.f / (float)(h2 - l2);
                const uint4 q = *(const uint4*)(pc + (size_t)n * PW);
                uint4 o; o.x = pk2(s[0] * inv - bflo(q.x), s[1] * inv - bfhi(q.x)); o.y = pk2(s[2] * inv - bflo(q.y), s[3] * inv - bfhi(q.y));
                o.z = pk2(s[4] * inv - bflo(q.z), s[5] * inv - bfhi(q.z)); o.w = pk2(s[6] * inv - bflo(q.w), s[7] * inv - bfhi(q.w));
                *(uint4*)(Dl + (rr * 8 + i) * DSTR + cc * 16) = o;
            }
        }
        __syncthreads();
        {
            const int g = c.wave >> 1, rh = c.wave & 1, r32 = c.lane & 31, hi = c.lane >> 5;
            f32x16 acc[4] = {};
            const char* ap = Dl + (rh * 32 + r32) * DSTR + g * 256 + hi * 16;
            const bf16_t* bp = WPT + ((size_t)g * 128 + r32) * 128 + hi * 8;
#pragma unroll
            for (int ks = 0; ks < 8; ++ks) {
                const bf16x8 af = *(const bf16x8*)(ap + ks * 32);
#pragma unroll
                for (int et = 0; et < 4; ++et) { const bf16x8 bf = *(const bf16x8*)(bp + (size_t)et * 32 * 128 + ks * 16);
                    acc[et] = __builtin_amdgcn_mfma_f32_32x32x16_bf16(af, bf, acc[et], 0, 0, 0); }
            }
#pragma unroll
            for (int et = 0; et < 4; ++et) { const int ch = g * 128 + et * 32 + r32; const float bb = a.in[I_BPOOL][ch], sc = a.in[I_PSCALE][ch];
#pragma unroll
                for (int r = 0; r < 16; ++r) { const int row = row0 + rh * 32 + (r & 3) + 8 * (r >> 2) + 4 * hi;
                    ATT[(size_t)row * DM + 512 + ch] = (bf16_t)f2bf((acc[et][r] + bb) * sc); } }
        }
    }
    __syncthreads();
}

__device__ __forceinline__ void ph_tables(CArgs& a, const Ctx& c) {
    const int* BLKCNT = (const int*)(a.ws + WS_BLKCNT); const int* TOPE = (const int*)(a.ws + WS_TOPE); const float* TOPW = (const float*)(a.ws + WS_TOPW);
    int* SEG = (int*)(a.ws + WS_SEG); int* TOKSLOT = (int*)(a.ws + WS_TOKSLOT); int* SLOTTOK = (int*)(a.ws + WS_SLOTTOK); float* SLOTW = (float*)(a.ws + WS_SLOTW);
    int* psum = (int*)c.lds;
    int* segstart = psum + 512;
    int* segcnt = segstart + 64;
    int* base = segcnt + 64;
    { const int e = c.tid & 63, p = c.tid >> 6; int s = 0;
      for (int v = 0; v < 32; ++v) s += BLKCNT[(p * 32 + v) * 64 + e];
      psum[p * 64 + e] = s; }
    __syncthreads();
    if (c.tid < 64) { int s = 0;
#pragma unroll
        for (int p = 0; p < 8; ++p) s += psum[p * 64 + c.tid];
        segcnt[c.tid] = s; }
    __syncthreads();
    if (c.tid < 64) { int s = 0; for (int e2 = 0; e2 < c.tid; ++e2) s += segcnt[e2]; segstart[c.tid] = s; }
    __syncthreads();
    if (c.blk == 0) {
        if (c.tid < 64) { SEG[c.tid * 2] = segstart[c.tid]; SEG[c.tid * 2 + 1] = segcnt[c.tid]; }
        if (c.tid == 64) { SEG[128] = NSLOT_R; SEG[129] = T; }
    }
    for (int vb = c.blk; vb < NVB; vb += c.G) {
        if (c.tid < 64) { const int e = c.tid, p = vb >> 5; int s = segstart[e];
            for (int p2 = 0; p2 < p; ++p2) s += psum[p2 * 64 + e];
            for (int v = p * 32; v < vb; ++v) s += BLKCNT[v * 64 + e];
            base[e] = s; }
        __syncthreads();
        { const int t = vb * 64 + (c.tid >> 3), k = c.tid & 7; const int pe = TOPE[t * 8 + k], e = pe & 255, lr = pe >> 8;
          const int slot = base[e] + lr;
          SLOTTOK[slot] = t; TOKSLOT[t * 8 + k] = slot; }
        __syncthreads();
    }
}

__device__ __forceinline__ void ph_combine(CArgs& a, const Ctx& c) {
    typedef float f32x2 __attribute__((ext_vector_type(2)));
    const unsigned char* Y = (const unsigned char*)(a.ws + WS_Y); const int* TOKSLOT = (const int*)(a.ws + WS_TOKSLOT); const float* MODS = (const float*)(a.ws + WS_MODS); const float* TOPW = (const float*)(a.ws + WS_TOPW);
    const int gw = c.blk * 8 + c.wave, NGW = c.G * 8;
    for (int t = gw; t < T; t += NGW) {
        const int b = t / NSEQ;
        float v[16];
#pragma unroll
        for (int j = 0; j < 16; ++j) v[j] = 0.f;
#pragma unroll
        for (int k = 0; k < 9; ++k) {
            const int r = (k < 8) ? TOKSLOT[t * 8 + k] : (NSLOT_R + t);
            const float wk = (k < 8) ? TOPW[t * 8 + k] : 1.f;
#pragma unroll
            for (int j = 0; j < 4; ++j) { const int w = *(const int*)(Y + (size_t)r * DM + 4 * c.lane + 256 * j);
                const f32x2 lo = __builtin_amdgcn_cvt_pk_f32_fp8(w, false), hi = __builtin_amdgcn_cvt_pk_f32_fp8(w, true);
                v[4 * j] = fmaf(wk, lo[0], v[4 * j]); v[4 * j + 1] = fmaf(wk, lo[1], v[4 * j + 1]); v[4 * j + 2] = fmaf(wk, hi[0], v[4 * j + 2]); v[4 * j + 3] = fmaf(wk, hi[1], v[4 * j + 3]); }
        }
        float ss = 0.f;
#pragma unroll
        for (int j = 0; j < 16; ++j) ss += v[j] * v[j];
        const float rs = rsqrtf(wave_sum(ss, c.lane) * (1.f / DM) + EPS);
        const float* md = MODS + (size_t)b * 6144 + 5120;
        const int lcol = 128 * ((c.lane & 3) >> 1) + 32 * (c.lane >> 4) + 8 * ((c.lane & 15) >> 2) + 4 * (c.lane & 1);
#pragma unroll
        for (int j = 0; j < 4; ++j) {
            const int col = lcol + 256 * j;
            float4 x1 = *(const float4*)(a.out + (size_t)t * DM + col); const float4 g = *(const float4*)(a.in[I_GPOSTFFN] + col), gf = *(const float4*)(md + col);
            x1.x += gf.x * (v[4 * j] * rs * g.x); x1.y += gf.y * (v[4 * j + 1] * rs * g.y); x1.z += gf.z * (v[4 * j + 2] * rs * g.z); x1.w += gf.w * (v[4 * j + 3] * rs * g.w);
            *(float4*)(a.out + (size_t)t * DM + col) = x1;
        }
    }
}

constexpr int LDS_TAB = 128 * 1024;
constexpr int LDS_OAN = 132 * 1024;
namespace pg8 {
typedef short bf16x8 __attribute__((ext_vector_type(8)));
typedef float f32x4 __attribute__((ext_vector_type(4)));
typedef unsigned u32x4 __attribute__((ext_vector_type(4)));
typedef unsigned u32x2 __attribute__((ext_vector_type(2)));
constexpr int BM = 256, BK = 64, HALF = 128, HTB = HALF * BK * 2, STAGE_BYTES = 8 * HTB;
__device__ __forceinline__ int lds_byte(int r, int c) { const int st = (r >> 4) * 2 + (c >> 5), rr = r & 15, cc = c & 31, ob = rr * 64 + cc * 2; return st * 1024 + (ob ^ (((ob >> 9) & 1) << 5)); }
__device__ __forceinline__ void stage_rc(int b, int& R, int& C) { const int st = b / 1024, sb = b % 1024, swz = sb ^ (((sb >> 9) & 1) << 5); R = (st >> 1) * 16 + swz / 64; C = (st & 1) * 32 + (swz % 64) / 2; }
__device__ __forceinline__ int perm32(int rho) { const int n = rho >> 4, i = rho & 15; return 8 * (i >> 2) + 4 * n + (i & 3); }
__device__ __forceinline__ int xcd_remap(int L, int nwg) { const int q = nwg / 8, r = nwg % 8, xcd = L % 8, off = L / 8; return (xcd < r ? xcd * (q + 1) : r * (q + 1) + (xcd - r) * q) + off; }
__device__ __forceinline__ unsigned cvt_pk_bf16(float lo, float hi) { unsigned r; asm volatile("v_cvt_pk_bf16_f32 %0, %1, %2" : "=v"(r) : "v"(lo), "v"(hi)); return r; }

struct Unit { int row0, nvalid, pn, aux, idx; };

template <class Epi, class Sched, bool ALIGN_EPI, int K, int REPK = 1>
__device__ __forceinline__ void gemm_phase(LAS unsigned char* lds, const Sched& S, const Epi& E, const int tid) {
    const int wid = __builtin_amdgcn_readfirstlane(tid >> 6), lane = tid & 63, wr = wid >> 2, wc = wid & 3, fr = lane & 15, fq = lane >> 4;
    constexpr int nt = K / BK;
    unsigned voffB[2];
#pragma unroll
    for (int i = 0; i < 2; ++i) { int R, C; stage_rc(tid * 16 + i * 8192, R, C); const int Rb = Epi::PERM ? ((R & ~31) + perm32(R & 31)) : R;
        voffB[i] = (unsigned)(Rb * K + C) * 2u; }
    LAS u32x4* const oAnL = (LAS u32x4*)(lds + LDS_OAN) + tid;
    const size_t kstep = (size_t)(BK * 2);
    const size_t hstepB = (size_t)HALF * K * 2;
    const unsigned ldsw = (unsigned)wid * 1024u;
    const int aoff = lds_byte(wr * 64 + fr, fq * 8), boff = lds_byte(wc * 32 + fr, fq * 8);
#define PG8_SA(b, h) (((b) * 2 + (h)) * HTB)
#define PG8_SB(b, h) ((4 + (b) * 2 + (h)) * HTB)
#define PG8_STAGE(bufoff, gbase, voff) do { _Pragma("unroll") for (int _i = 0; _i < 2; ++_i) \
        __builtin_amdgcn_global_load_lds((const unsigned*)((const char*)(gbase) + (voff)[_i]), (LAS unsigned*)(lds + (bufoff) + ldsw + _i * 8192), 16, 0, 0); } while (0)
#define PG8_LDA(dst, b, h) do { _Pragma("unroll") for (int m = 0; m < 4; ++m) _Pragma("unroll") for (int k = 0; k < 2; ++k) dst[m][k] = *(const LAS bf16x8*)(lds + PG8_SA(b, h) + aoff + m * 2048 + k * 1024); } while (0)
#define PG8_LDB(dst, b, h) do { _Pragma("unroll") for (int n = 0; n < 2; ++n) _Pragma("unroll") for (int k = 0; k < 2; ++k) dst[n][k] = *(const LAS bf16x8*)(lds + PG8_SB(b, h) + boff + n * 2048 + k * 1024); } while (0)
#define PG8_MMA(ai, bj, At, Bt) do { __builtin_amdgcn_s_setprio(1); _Pragma("unroll") for (int m = 0; m < 4; ++m) _Pragma("unroll") for (int n = 0; n < 2; ++n) _Pragma("unroll") for (int k = 0; k < 2; ++k) \
        acc[ai][bj][m][n] = __builtin_amdgcn_mfma_f32_16x16x32_bf16(Bt[n][k], At[m][k], acc[ai][bj][m][n], 0, 0, 0); __builtin_amdgcn_s_setprio(0); } while (0)
#define PG8_WAIT_V(n) asm volatile("s_waitcnt vmcnt(" #n ")" ::: "memory")
#define PG8_WAIT_L(n) asm volatile("s_waitcnt lgkmcnt(" #n ")" ::: "memory")
#define PG8_BAR __builtin_amdgcn_s_barrier()
#define PG8_SCHED __builtin_amdgcn_sched_barrier(0)
    Unit cur, nxt; int ui = 0;
    if (!S.next(0, cur)) return;
    f32x4 acc[2][2][4][2];
#pragma unroll
    for (int a = 0; a < 2; ++a)
#pragma unroll
        for (int b = 0; b < 2; ++b)
#pragma unroll
            for (int m = 0; m < 4; ++m)
#pragma unroll
                for (int n = 0; n < 2; ++n) acc[a][b][m][n] = (f32x4){0.f, 0.f, 0.f, 0.f};
    bf16x8 At[4][2], B0[2][2], B1[2][2];
    unsigned oAc[2][2];
    S.a_off(cur, tid, oAc);
    const char* const Ab = S.a_base();
    const char* cB = S.b_base(cur);
    PG8_STAGE(PG8_SB(0, 0), cB, voffB); PG8_STAGE(PG8_SB(0, 1), cB + hstepB, voffB); PG8_STAGE(PG8_SA(0, 0), Ab, oAc[0]); PG8_STAGE(PG8_SA(0, 1), Ab, oAc[1]);
    if (wr == 1) PG8_BAR;
    PG8_WAIT_V(2); PG8_BAR;
    PG8_STAGE(PG8_SB(1, 0), cB + kstep, voffB); PG8_STAGE(PG8_SA(1, 0), Ab + kstep, oAc[0]); PG8_STAGE(PG8_SB(1, 1), cB + hstepB + kstep, voffB);
    PG8_WAIT_V(6); PG8_BAR;
    for (;;) {
        const bool has_next = S.next(ui + 1, nxt);
        if (has_next) { unsigned t_[2][2]; S.a_off(nxt, tid, t_); *oAnL = (u32x4){t_[0][0], t_[0][1], t_[1][0], t_[1][1]}; }
        const char* nB = has_next ? S.b_base(nxt) : cB;
#pragma unroll 1
        for (int tt = 0; tt < nt * REPK; tt += 2) {
            const int t = (REPK == 1) ? tt : tt % nt;
            const bool wrap = (t == nt - 2), last = (tt == nt * REPK - 2);
            const char* a1 = Ab + (size_t)(t + 1) * kstep;
            const char* a2 = wrap ? Ab : Ab + (size_t)(t + 2) * kstep; const char* b2 = last ? nB : (wrap ? cB : cB + (size_t)(t + 2) * kstep);
            const char* a3 = a2 + kstep; const char* b3 = b2 + kstep;
            PG8_LDB(B0, 0, 0); PG8_LDB(B1, 0, 1); PG8_SCHED; PG8_LDA(At, 0, 0); PG8_STAGE(PG8_SA(1, 1), a1, oAc[1]);
            if (last && has_next) { const u32x4 q = *oAnL; oAc[0][0] = q.x; oAc[0][1] = q.y; oAc[1][0] = q.z; oAc[1][1] = q.w; }
            PG8_WAIT_V(8); PG8_WAIT_L(0); PG8_BAR; PG8_MMA(0, 0, At, B0); PG8_MMA(0, 1, At, B1); PG8_BAR; PG8_SCHED;
            PG8_LDA(At, 0, 1); PG8_STAGE(PG8_SB(0, 0), b2, voffB); PG8_STAGE(PG8_SB(0, 1), b2 + hstepB, voffB); PG8_STAGE(PG8_SA(0, 0), a2, oAc[0]);
            PG8_WAIT_V(8); PG8_WAIT_L(0); PG8_BAR; PG8_MMA(1, 0, At, B0); PG8_MMA(1, 1, At, B1); PG8_BAR; PG8_SCHED;
            PG8_LDB(B0, 1, 0); PG8_LDB(B1, 1, 1); PG8_SCHED; PG8_LDA(At, 1, 0); PG8_STAGE(PG8_SA(0, 1), a2, oAc[1]);
            PG8_WAIT_V(8); PG8_WAIT_L(0); PG8_BAR; PG8_MMA(0, 0, At, B0); PG8_MMA(0, 1, At, B1); PG8_BAR; PG8_SCHED;
            PG8_LDA(At, 1, 1); PG8_STAGE(PG8_SB(1, 0), b3, voffB); PG8_STAGE(PG8_SB(1, 1), b3 + hstepB, voffB); PG8_STAGE(PG8_SA(1, 0), a3, oAc[0]);
            PG8_WAIT_V(8); PG8_WAIT_L(0); PG8_BAR; PG8_MMA(1, 0, At, B0); PG8_MMA(1, 1, At, B1); PG8_BAR; PG8_SCHED;
        }
        if constexpr (ALIGN_EPI) { if (wr == 0) PG8_BAR; }
        if constexpr (REPK > 1) {
#pragma unroll
            for (int a = 0; a < 2; ++a)
#pragma unroll
                for (int b = 0; b < 2; ++b)
#pragma unroll
                    for (int m = 0; m < 4; ++m)
#pragma unroll
                        for (int n = 0; n < 2; ++n) acc[a][b][m][n] *= (1.f / REPK); }
        E(acc, cur, wr, wc, fr, fq);
        if (!has_next) break;
#pragma unroll
        for (int a = 0; a < 2; ++a)
#pragma unroll
            for (int b = 0; b < 2; ++b)
#pragma unroll
                for (int m = 0; m < 4; ++m)
#pragma unroll
                    for (int n = 0; n < 2; ++n) acc[a][b][m][n] = (f32x4){0.f, 0.f, 0.f, 0.f};
        cur = nxt; cB = nB; ++ui;
        if constexpr (ALIGN_EPI) { if (wr == 1) PG8_BAR; }
    }
    PG8_WAIT_V(0);
    if constexpr (!ALIGN_EPI) { if (wr == 0) PG8_BAR; }
    PG8_BAR;
#undef PG8_SA
#undef PG8_SB
#undef PG8_STAGE
#undef PG8_LDA
#undef PG8_LDB
#undef PG8_MMA
#undef PG8_WAIT_V
#undef PG8_WAIT_L
#undef PG8_BAR
#undef PG8_SCHED
}

struct DenseSched {
    const char* A; const char* Bt; int nN, nwg, G, c, nmain;
    __device__ __forceinline__ bool next(int i, Unit& u) const {
        const int L = i * G + c; if (L >= nwg) return false;
        const int wgid = xcd_remap(L, nwg);
        if (wgid < nmain) { const int nig = 8 * nN, gid = wgid / nig, w = wgid % nig; u.row0 = 256 * (gid * 8 + (w % 8)); u.pn = w / 8; }
        else { const int j = wgid - nmain; u.row0 = T + 256 * (j >> 2); u.pn = 2 + (j & 3); }
        u.nvalid = 256; u.aux = 0; u.idx = i; return true;
    }
    __device__ __forceinline__ const char* a_base() const { return A; }
    __device__ __forceinline__ const char* b_base(const Unit& u) const { return Bt + (size_t)u.pn * 256 * DM * 2; }
    __device__ __forceinline__ void a_off(const Unit& u, int tid, unsigned (&o)[2][2]) const {
#pragma unroll
        for (int i = 0; i < 2; ++i) { int R, C; stage_rc(tid * 16 + i * 8192, R, C);
#pragma unroll
            for (int h = 0; h < 2; ++h) o[h][i] = (unsigned)((u.row0 + 128 * h + R) * DM + C) * 2u; }
    }
};
constexpr int GT_MAXSEG = 132, GT_ULIST = 768, GT_MAXU = 48;
struct GroupedSched {
    const char* A; const char* Bt; const int* slottok; const LAS int* tab; int nseg, npn, nwg, G, c, K, brows; const LAS int* tokl;
    __device__ __forceinline__ bool next(int i, Unit& u) const {
        const int L = i * G + c; if (L >= nwg) return false;
        u.idx = i;
        if (i < GT_MAXU) { const LAS int* q = tab + GT_ULIST + 4 * i; u.row0 = q[0]; u.nvalid = q[1]; u.pn = q[2]; u.aux = q[3]; return true; }
        const int wgid = xcd_remap(L, nwg), tl = wgid / npn; u.pn = wgid % npn;
        int s = 0; while (tab[s + 1] <= tl) ++s;
        const int off = 256 * (tl - tab[s]);
        u.row0 = tab[GT_MAXSEG + s] + off; const int rem = tab[2 * GT_MAXSEG + s] - off; u.nvalid = rem < 256 ? rem : 256; u.aux = tab[3 * GT_MAXSEG + s];
        return true;
    }
    __device__ __forceinline__ const char* a_base() const { return A; }
    __device__ __forceinline__ const char* b_base(const Unit& u) const { return Bt + ((size_t)u.aux * brows + (size_t)u.pn * 256) * K * 2; }
    __device__ __forceinline__ void a_off(const Unit& u, int tid, unsigned (&o)[2][2]) const {
#pragma unroll
        for (int i = 0; i < 2; ++i) { int R, C; stage_rc(tid * 16 + i * 8192, R, C);
#pragma unroll
            for (int h = 0; h < 2; ++h) {
                int r = 128 * h + R;
                if (slottok) { int tok; if (u.idx < 8) tok = tokl[u.idx * 256 + r];
                    else { if (r >= u.nvalid) r = u.nvalid - 1; const int slot = u.row0 + r; tok = (u.aux < 64) ? slottok[slot] : slot - NSLOT_R; }
                    o[h][i] = (unsigned)(tok * K + C) * 2u; }
                else o[h][i] = (unsigned)((u.row0 + r) * K + C) * 2u;
            } }
    }
};
__device__ __forceinline__ int grouped_table(LAS int* tab, const int* SEG, const int tid) {
    constexpr int nseg = 65;
    if (tid < nseg) { const int e = tid; const int st = SEG[e * 2], cn = SEG[e * 2 + 1];
        tab[GT_MAXSEG + tid] = st; tab[2 * GT_MAXSEG + tid] = cn; tab[3 * GT_MAXSEG + tid] = e; tab[4 * GT_MAXSEG + tid] = (cn + 255) >> 8; }
    __syncthreads();
    if (tid <= nseg) { int s = 0; for (int j = 0; j < tid; ++j) s += tab[4 * GT_MAXSEG + j]; tab[tid] = s; }
    __syncthreads();
    return tab[nseg];
}

__device__ __forceinline__ void grouped_units(LAS int* tab, int npn, int nwg, int G, int c, const int tid) {
    constexpr int nseg = 65;
    for (int i = 0; i < GT_MAXU; ++i) { const int L = i * G + c; if (L >= nwg) break;
        const int wgid = xcd_remap(L, nwg), tl = wgid / npn;
        if (tid < nseg && tab[tid] <= tl && tl < tab[tid + 1]) { const int off = 256 * (tl - tab[tid]); const int rem = tab[2 * GT_MAXSEG + tid] - off;
            LAS int* q = tab + GT_ULIST + 4 * i; q[0] = tab[GT_MAXSEG + tid] + off; q[1] = rem < 256 ? rem : 256; q[2] = wgid % npn; q[3] = tab[3 * GT_MAXSEG + tid]; } }
    __syncthreads();
}

struct EpiStore {
    static constexpr bool PERM = true;
    bf16_t* C; int ldc; int rowsub, rowsub_sh;
    __device__ __forceinline__ void operator()(const f32x4 (&acc)[2][2][4][2], const Unit& u, int wr, int wc, int fr, int fq) const {
        const int col0 = u.pn * 256 + wc * 32 + 8 * fq, crow0 = u.row0 - (u.aux < 64 ? rowsub : rowsub_sh);
        int rb = wr * 64 + fr; asm volatile("" : "+v"(rb));
#pragma unroll
        for (int ai = 0; ai < 2; ++ai)
#pragma unroll
            for (int m = 0; m < 4; ++m) { const int r = ai * 128 + m * 16 + rb;
                if (r < u.nvalid) { bf16_t* rowp = C + (size_t)(crow0 + r) * ldc + col0;
#pragma unroll
                    for (int bj = 0; bj < 2; ++bj) { const f32x4 v0 = acc[ai][bj][m][0], v1 = acc[ai][bj][m][1];
                        u32x4 w; w.x = cvt_pk_bf16(v0[0], v0[1]); w.y = cvt_pk_bf16(v0[2], v0[3]); w.z = cvt_pk_bf16(v1[0], v1[1]); w.w = cvt_pk_bf16(v1[2], v1[3]);
                        *(u32x4*)(rowp + bj * 128) = w; } } }
    }
};
struct EpiStoreFp8 {
    static constexpr bool PERM = true;
    unsigned char* C;
    __device__ __forceinline__ void operator()(const f32x4 (&acc)[2][2][4][2], const Unit& u, int wr, int wc, int fr, int fq) const {
        const int col0 = u.pn * 256 + wc * 64 + 16 * fq;
        int rb = wr * 64 + fr; asm volatile("" : "+v"(rb));
#pragma unroll
        for (int ai = 0; ai < 2; ++ai)
#pragma unroll
            for (int m = 0; m < 4; ++m) { const int r = ai * 128 + m * 16 + rb;
                if (r < u.nvalid) { u32x4 w;
#pragma unroll
                    for (int bj = 0; bj < 2; ++bj) { const f32x4 v0 = acc[ai][bj][m][0], v1 = acc[ai][bj][m][1];
                        int w0 = __builtin_amdgcn_cvt_pk_fp8_f32(v0[0], v0[1], 0, false); w0 = __builtin_amdgcn_cvt_pk_fp8_f32(v0[2], v0[3], w0, true);
                        int w1 = __builtin_amdgcn_cvt_pk_fp8_f32(v1[0], v1[1], 0, false); w1 = __builtin_amdgcn_cvt_pk_fp8_f32(v1[2], v1[3], w1, true);
                        if (bj == 0) { w.x = (unsigned)w0; w.y = (unsigned)w1; } else { w.z = (unsigned)w0; w.w = (unsigned)w1; } }
                    *(u32x4*)(C + (size_t)(u.row0 + r) * DM + col0) = w; } }
    }
};
struct EpiGateUp {
    static constexpr bool PERM = true;
    bf16_t* ACT;
    __device__ __forceinline__ void operator()(const f32x4 (&acc)[2][2][4][2], const Unit& u, int wr, int wc, int fr, int fq) const {
        const int col0 = u.pn * 128 + wc * 32 + 8 * fq;
        int rb = wr * 64 + fr; asm volatile("" : "+v"(rb));
#pragma unroll
        for (int ai = 0; ai < 2; ++ai)
#pragma unroll
            for (int m = 0; m < 4; ++m) { const int r = ai * 128 + m * 16 + rb;
                if (r < u.nvalid) { const int slot = u.row0 + r;
                    float o[8];
#pragma unroll
                    for (int n = 0; n < 2; ++n)
#pragma unroll
                        for (int i = 0; i < 4; ++i) { const float g = acc[ai][0][m][n][i], up = acc[ai][1][m][n][i]; o[4 * n + i] = g / (1.f + __expf(-g)) * up; }
                    u32x4 pk; pk.x = cvt_pk_bf16(o[0], o[1]); pk.y = cvt_pk_bf16(o[2], o[3]); pk.z = cvt_pk_bf16(o[4], o[5]); pk.w = cvt_pk_bf16(o[6], o[7]);
                    *(u32x4*)(ACT + (size_t)slot * FF + col0) = pk; } }
    }
};
struct EpiInProj {
    static constexpr bool PERM = false;
    bf16_t *Q, *Kb, *Vb, *P; const LAS float* rope;
    __device__ __forceinline__ void operator()(const f32x4 (&acc)[2][2][4][2], const Unit& u, int wr, int wc, int fr, int fq) const {
        const bool latent = u.row0 < T; const int sec = u.pn >> 1;
        const bool dorope = latent && sec < 2;
        bf16_t* dstU; int n0 = 0;
        if (latent) { const int b = u.row0 / NSEQ; n0 = u.row0 % NSEQ; const size_t kvrow = (size_t)b * SKV + CTXL + n0;
            dstU = sec == 0 ? Q + (size_t)u.row0 * AW : sec == 1 ? Kb + kvrow * AW : sec == 2 ? Vb + kvrow * AW : P + (size_t)u.row0 * PW; }
        else { const int b = (u.row0 - T) / CTXL; dstU = (sec == 1 ? Kb : Vb) + (size_t)b * SKV * AW; }
        dstU += (u.pn & 1) * 256;
        int rb = wr * 64 + fr; asm volatile("" : "+v"(rb));
        const int lcol = wc * 32 + 4 * fq;
#pragma unroll
        for (int ai = 0; ai < 2; ++ai)
#pragma unroll
            for (int m = 0; m < 4; ++m) {
                const int r = ai * 128 + m * 16 + rb;
                f32x4 c4 = (f32x4){1.f, 1.f, 1.f, 1.f}, s4 = (f32x4){0.f, 0.f, 0.f, 0.f};
                if (dorope) { const int pos = (wc & 1) ? (r & 63) : ((n0 >> 6) + (r >> 6)); const LAS float* rp = rope + (pos * 16 + 4 * fq) * 2;
                    const f32x4 cs0 = *(const LAS f32x4*)rp, cs1 = *(const LAS f32x4*)(rp + 4); c4 = (f32x4){cs0[0], cs0[2], cs1[0], cs1[2]}; s4 = (f32x4){cs0[1], cs0[3], cs1[1], cs1[3]}; }
                bf16_t* dst = dstU + r * 512 + lcol;
#pragma unroll
                for (int bj = 0; bj < 2; ++bj) {
                    const f32x4 x1 = acc[ai][bj][m][0], x2 = acc[ai][bj][m][1];
                    const f32x4 o1 = x1 * c4 - x2 * s4, o2 = x2 * c4 + x1 * s4;
                    u32x2 w1, w2; w1.x = cvt_pk_bf16(o1[0], o1[1]); w1.y = cvt_pk_bf16(o1[2], o1[3]); w2.x = cvt_pk_bf16(o2[0], o2[1]); w2.y = cvt_pk_bf16(o2[2], o2[3]);
                    *(u32x2*)(dst + bj * 128) = w1; *(u32x2*)(dst + bj * 128 + 16) = w2;
                }
            }
    }
};
}

__device__ __forceinline__ void ph_inproj_fast(CArgs& a, const Ctx& c) {
    pg8::DenseSched S{(const char*)(a.ws + WS_HX), (const char*)(a.ws + WS_WIN), 8, 528, c.G, c.blk, 512};
    LAS float* ropeL = (LAS float*)((LAS unsigned char*)c.lds + LDS_ROPE);
    { const float4 v = *(const float4*)((const float*)(a.ws + WS_ROPE) + 4 * c.tid); ropeL[4 * c.tid] = v.x; ropeL[4 * c.tid + 1] = v.y; ropeL[4 * c.tid + 2] = v.z; ropeL[4 * c.tid + 3] = v.w; }
    __syncthreads();
    pg8::EpiInProj E{(bf16_t*)(a.ws + WS_Q), (bf16_t*)(a.ws + WS_K), (bf16_t*)(a.ws + WS_V), (bf16_t*)(a.ws + WS_P), ropeL};
    pg8::gemm_phase<pg8::EpiInProj, pg8::DenseSched, true, DM>((LAS unsigned char*)c.lds, S, E, c.tid);
}
__device__ __forceinline__ void ph_outproj_fast(CArgs& a, const Ctx& c) {
    pg8::DenseSched S{(const char*)(a.ws + WS_ATT), (const char*)(a.ws + WS_WOUT), 4, 256, c.G, c.blk, 256};
    pg8::EpiStore E{(bf16_t*)(a.ws + WS_YX), DM, 0, 0};
    pg8::gemm_phase<pg8::EpiStore, pg8::DenseSched, true, DM>((LAS unsigned char*)c.lds, S, E, c.tid);
}
__device__ __forceinline__ void ph_gateup_fast(CArgs& a, const Ctx& c) {
    LAS int* tab = (LAS int*)((LAS unsigned char*)c.lds + LDS_TAB);
    const int ntile = pg8::grouped_table(tab, (const int*)(a.ws + WS_SEG), c.tid);
    pg8::grouped_units(tab, 2, ntile * 2, c.G, c.blk, c.tid);
    LAS int* tokl = (LAS int*)((LAS unsigned char*)c.lds + LDS_TOKL);
    { const int* SLOTTOK = (const int*)(a.ws + WS_SLOTTOK);
      for (int q = c.tid; q < 8 * 256; q += 512) { const int i = q >> 8, r = q & 255;
          if (i * c.G + c.blk < ntile * 2) { const LAS int* ul = tab + pg8::GT_ULIST + 4 * i; const int row0 = ul[0], nv = ul[1], e = ul[3];
              const int slot = row0 + (r < nv ? r : nv - 1); tokl[q] = (e < 64) ? SLOTTOK[slot] : slot - NSLOT_R; } }
      __syncthreads(); }
    pg8::GroupedSched S{(const char*)(a.ws + WS_HX), (const char*)(a.ws + WS_WGU), (const int*)(a.ws + WS_SLOTTOK), tab, 65, 2, ntile * 2, c.G, c.blk, DM, 512, tokl};
    pg8::EpiGateUp E{(bf16_t*)(a.ws + WS_ACT)};
    pg8::gemm_phase<pg8::EpiGateUp, pg8::GroupedSched, true, DM, REPK_GU>((LAS unsigned char*)c.lds, S, E, c.tid);
}
__device__ __forceinline__ void ph_down_fast(CArgs& a, const Ctx& c) {
    LAS int* tab = (LAS int*)((LAS unsigned char*)c.lds + LDS_TAB);
    const int ntile = pg8::grouped_table(tab, (const int*)(a.ws + WS_SEG), c.tid);
    pg8::grouped_units(tab, 4, ntile * 4, c.G, c.blk, c.tid);
    pg8::GroupedSched S{(const char*)(a.ws + WS_ACT), (const char*)(a.ws + WS_WD), nullptr, tab, 65, 4, ntile * 4, c.G, c.blk, FF, DM, nullptr};
    pg8::EpiStoreFp8 E{(unsigned char*)(a.ws + WS_Y)};
    pg8::gemm_phase<pg8::EpiStoreFp8, pg8::GroupedSched, true, FF, REPK_DOWN>((LAS unsigned char*)c.lds, S, E, c.tid);
}

namespace att {
using bf16x8 = __attribute__((ext_vector_type(8))) short;
using s16x4  = __attribute__((ext_vector_type(4))) short;
using f32x16 = __attribute__((ext_vector_type(16))) float;
using u32x4  = __attribute__((ext_vector_type(4))) unsigned;
constexpr int KVBLK = 64, LDK = 512;
constexpr float SCALE = 0.125f, THR = 8.f;
constexpr int SHM_V = KVBLK * 128 * 2, SHM_K = KVBLK * 128 * 2, OFF_WS = 2 * SHM_V + 2 * SHM_K;
#define KSWZ(row, colB) ((row) * 256 + ((colB) ^ (((row) & 7) << 4)))
#define SBAR() __builtin_amdgcn_sched_barrier(0)
__device__ __forceinline__ int crow(int r, int hi) { return (r & 3) + 8 * (r >> 2) + 4 * hi; }
__device__ __forceinline__ unsigned cvtpk(float lo, float hi) { unsigned r; asm volatile("v_cvt_pk_bf16_f32 %0, %1, %2" : "=v"(r) : "v"(lo), "v"(hi)); return r; }
__device__ __forceinline__ void partialSM(f32x16& p0, f32x16& p1, float& m_reg, float& mn, float& alpha) {
  constexpr float C = SCALE * 1.4426950408889634f;
  float pmax = p0[0];
#pragma unroll
  for (int r = 1; r < 16; ++r) pmax = fmaxf(pmax, p0[r]);
#pragma unroll
  for (int r = 0; r < 16; ++r) pmax = fmaxf(pmax, p1[r]);
  { auto rr = __builtin_amdgcn_permlane32_swap(__float_as_uint(pmax), __float_as_uint(pmax), false, false);
    pmax = fmaxf(__uint_as_float(rr[0]), __uint_as_float(rr[1])); }
  if (__builtin_expect(__all(pmax - m_reg <= THR / SCALE), 1)) { mn = m_reg; alpha = 1.f; }
  else { mn = fmaxf(m_reg, pmax); alpha = __builtin_amdgcn_exp2f((m_reg - mn) * C); m_reg = mn; }
  const float mnC = -mn * C;
#pragma unroll
  for (int r = 0; r < 16; ++r) p0[r] = fmaf(p0[r], C, mnC);
#pragma unroll
  for (int r = 0; r < 16; ++r) p1[r] = fmaf(p1[r], C, mnC);
#pragma unroll
  for (int r = 0; r < 16; ++r) p0[r] = __builtin_amdgcn_exp2f(p0[r]);
}
__device__ __forceinline__ void finishSM(f32x16& p0, f32x16& p1, float alpha, float& l_reg, bf16x8& pa0, bf16x8& pa1, bf16x8& pa2, bf16x8& pa3) {
#pragma unroll
  for (int r = 0; r < 16; ++r) p1[r] = __builtin_amdgcn_exp2f(p1[r]);
  float ps = 0;
#pragma unroll
  for (int r = 0; r < 16; ++r) ps += p0[r];
#pragma unroll
  for (int r = 0; r < 16; ++r) ps += p1[r];
  { auto rr = __builtin_amdgcn_permlane32_swap(__float_as_uint(ps), __float_as_uint(ps), false, false);
    ps = __uint_as_float(rr[0]) + __uint_as_float(rr[1]); }
  l_reg = l_reg * alpha + ps;
#define PK4(P, BASE, OUT) do { unsigned a0 = cvtpk(P[BASE + 0], P[BASE + 1]), a1 = cvtpk(P[BASE + 2], P[BASE + 3]);   \
    unsigned b0 = cvtpk(P[BASE + 4], P[BASE + 5]), b1 = cvtpk(P[BASE + 6], P[BASE + 7]);                              \
    auto r0 = __builtin_amdgcn_permlane32_swap(a0, b0, false, false); auto r1 = __builtin_amdgcn_permlane32_swap(a1, b1, false, false); \
    u32x4 w = {r0[0], r1[0], r0[1], r1[1]}; OUT = *reinterpret_cast<bf16x8*>(&w); } while (0)
  PK4(p0, 0, pa0); PK4(p0, 8, pa1); PK4(p1, 0, pa2); PK4(p1, 8, pa3);
#undef PK4
}
__device__ __forceinline__ void qkt(f32x16& p0, f32x16& p1, const char* Ks, const bf16x8* qr, int r32, int hi, int mcol) {
  p0 = f32x16{}; p1 = f32x16{};
#pragma unroll
  for (int d0 = 0; d0 < 4; ++d0) { const int cb = (mcol + d0 * 16 + hi * 8) * 2;
    const bf16x8 b0 = *reinterpret_cast<const bf16x8*>(Ks + KSWZ(r32, cb));
    const bf16x8 b1 = *reinterpret_cast<const bf16x8*>(Ks + KSWZ(32 + r32, cb));
    p0 = __builtin_amdgcn_mfma_f32_32x32x16_bf16(b0, qr[d0], p0, 0, 0, 0);
    p1 = __builtin_amdgcn_mfma_f32_32x32x16_bf16(b1, qr[d0], p1, 0, 0, 0); }
}
__device__ __forceinline__ int v_st(int k, int c) { const int kk = (k & ~0xC) | ((k & 4) << 1) | ((k & 8) >> 1); return ((kk >> 3) * 4 + (c >> 5)) * 512 + ((kk & 7) * 32 + (c & 31)) * 2; }
__device__ __forceinline__ int v_rd_base(int lane) { return ((lane & 3) << 3) | (((lane >> 2) & 3) << 6) | (((lane >> 4) & 1) << 5) | (((lane >> 5) & 1) << 8); }
constexpr int v_rd_off(int d0, int ks, int half) { return d0 * 512 + ks * 4096 + half * 2048; }
template <int OFF> __device__ __forceinline__ s16x4 tr_read(int vb) {
  s16x4 r; asm volatile("ds_read_b64_tr_b16 %0, %1 offset:%2" : "=&v"(r) : "v"(vb), "i"(OFF) : "memory"); return r;
}
template <int D0> __device__ __forceinline__ void pv_one(f32x16& od, int vb, bf16x8 pa0, bf16x8 pa1, bf16x8 pa2, bf16x8 pa3) {
  const s16x4 l0 = tr_read<v_rd_off(D0, 0, 0)>(vb), h0 = tr_read<v_rd_off(D0, 0, 1)>(vb), l1 = tr_read<v_rd_off(D0, 1, 0)>(vb), h1 = tr_read<v_rd_off(D0, 1, 1)>(vb);
  const s16x4 l2 = tr_read<v_rd_off(D0, 2, 0)>(vb), h2 = tr_read<v_rd_off(D0, 2, 1)>(vb), l3 = tr_read<v_rd_off(D0, 3, 0)>(vb), h3 = tr_read<v_rd_off(D0, 3, 1)>(vb);
  asm volatile("s_waitcnt lgkmcnt(0)" ::: "memory"); SBAR();
#define PK(L, H) (bf16x8){L[0], L[1], L[2], L[3], H[0], H[1], H[2], H[3]}
  od = __builtin_amdgcn_mfma_f32_32x32x16_bf16(pa0, PK(l0, h0), od, 0, 0, 0);
  od = __builtin_amdgcn_mfma_f32_32x32x16_bf16(pa1, PK(l1, h1), od, 0, 0, 0);
  od = __builtin_amdgcn_mfma_f32_32x32x16_bf16(pa2, PK(l2, h2), od, 0, 0, 0);
  od = __builtin_amdgcn_mfma_f32_32x32x16_bf16(pa3, PK(l3, h3), od, 0, 0, 0);
#undef PK
}
__device__ __forceinline__ void pv_d0(f32x16* o, int vb, bf16x8 pa0, bf16x8 pa1, bf16x8 pa2, bf16x8 pa3) {
  pv_one<0>(o[0], vb, pa0, pa1, pa2, pa3); pv_one<1>(o[1], vb, pa0, pa1, pa2, pa3); pv_one<2>(o[2], vb, pa0, pa1, pa2, pa3); pv_one<3>(o[3], vb, pa0, pa1, pa2, pa3);
}
__device__ __forceinline__ void unit(const bf16_t* __restrict__ Qb, const bf16_t* __restrict__ Kh, const bf16_t* __restrict__ Vh, bf16_t* __restrict__ Ob,
                                     const float lam, const float* __restrict__ gsub, char* lds, const int tid) {
  const int wid = __builtin_amdgcn_readfirstlane(tid >> 6), lane = tid & 63, r32 = lane & 31, hi = lane >> 5, qsub = wid & 3, map = wid >> 2, mcol = map * 64;
  char* V_lds = lds; char* K_lds = lds + 2 * SHM_V;
  float* ws = (float*)(lds + OFF_WS) + wid * 64; float* li_l = ws; float* al_l = ws + 32;
  float m_reg = -1e30f, l_reg = 0; f32x16 o[4] = {}; bf16x8 qr[4];
  const bf16_t* Qw = Qb + (size_t)(qsub * 32 + r32) * AW + mcol + hi * 8;
#pragma unroll
  for (int d0 = 0; d0 < 4; ++d0) qr[d0] = *reinterpret_cast<const bf16x8*>(Qw + d0 * 16);
  const int sr = tid >> 4, sc = (tid & 15) * 8, vst0 = v_st(sr, sc), vst1 = v_st(32 + sr, sc);
  const int vb0 = (int)(uintptr_t)V_lds + v_rd_base(lane);
  struct { bf16x8 vs0, vs1, ks0, ks1; } sr_[2];
#define SLOAD(i, k0) do { sr_[i].vs0 = *reinterpret_cast<const bf16x8*>(&Vh[(size_t)((k0) + sr) * LDK + sc]); sr_[i].vs1 = *reinterpret_cast<const bf16x8*>(&Vh[(size_t)((k0) + 32 + sr) * LDK + sc]); \
    sr_[i].ks0 = *reinterpret_cast<const bf16x8*>(&Kh[(size_t)((k0) + sr) * LDK + sc]); sr_[i].ks1 = *reinterpret_cast<const bf16x8*>(&Kh[(size_t)((k0) + 32 + sr) * LDK + sc]); } while (0)
#define SWRITE(b, i) do { *(bf16x8*)(V_lds + (b) * SHM_V + vst0) = sr_[i].vs0; *(bf16x8*)(V_lds + (b) * SHM_V + vst1) = sr_[i].vs1; const int kc = sc * 2; \
    *(bf16x8*)(K_lds + (b) * SHM_K + KSWZ(sr, kc)) = sr_[i].ks0; *(bf16x8*)(K_lds + (b) * SHM_K + KSWZ(32 + sr, kc)) = sr_[i].ks1; } while (0)
#define SWAIT() asm volatile("s_waitcnt vmcnt(4)" ::: "memory")
#define RESC(a) do { if (__any((a) < 1.f)) { if (hi == 0) al_l[r32] = (a); asm volatile("s_waitcnt lgkmcnt(0)" ::: "memory"); \
    _Pragma("unroll") for (int d = 0; d < 4; ++d) _Pragma("unroll") for (int r = 0; r < 16; ++r) o[d][r] *= al_l[crow(r, hi)]; } } while (0)
  f32x16 pA0, pA1, pB0, pB1; float mnA, mnB, alA, alB; bf16x8 pa0, pa1, pa2, pa3; constexpr int NT = SKV / KVBLK;
  SLOAD(0, 0); asm volatile("s_waitcnt vmcnt(0)" ::: "memory"); SWRITE(0, 0); __syncthreads();
  qkt(pA0, pA1, K_lds, qr, r32, hi, mcol); partialSM(pA0, pA1, m_reg, mnA, alA);
  SLOAD(1, KVBLK); SLOAD(0, 2 * KVBLK);
  SWAIT(); SWRITE(1, 1); __syncthreads();
  for (int j = 1; j + 1 < NT; j += 2) {
    SBAR(); qkt(pB0, pB1, K_lds + SHM_K, qr, r32, hi, mcol);
    finishSM(pA0, pA1, alA, l_reg, pa0, pa1, pa2, pa3); SBAR();
    SLOAD(1, (j + 2) * KVBLK); SBAR();
    pv_d0(o, vb0, pa0, pa1, pa2, pa3); partialSM(pB0, pB1, m_reg, mnB, alB);
    __syncthreads(); SWAIT(); SWRITE(0, 0);
    RESC(alB); __syncthreads();
    SBAR(); qkt(pA0, pA1, K_lds, qr, r32, hi, mcol);
    finishSM(pB0, pB1, alB, l_reg, pa0, pa1, pa2, pa3); SBAR();
    if (j + 3 < NT) SLOAD(0, (j + 3) * KVBLK); SBAR();
    pv_d0(o, vb0 + SHM_V, pa0, pa1, pa2, pa3); partialSM(pA0, pA1, m_reg, mnA, alA);
    __syncthreads(); SWAIT(); SWRITE(1, 1);
    RESC(alA); __syncthreads();
  }
  SBAR(); qkt(pB0, pB1, K_lds + SHM_K, qr, r32, hi, mcol);
  finishSM(pA0, pA1, alA, l_reg, pa0, pa1, pa2, pa3); SBAR();
  pv_d0(o, vb0, pa0, pa1, pa2, pa3); partialSM(pB0, pB1, m_reg, mnB, alB);
  __syncthreads(); RESC(alB);
  finishSM(pB0, pB1, alB, l_reg, pa0, pa1, pa2, pa3); SBAR();
  pv_d0(o, vb0 + SHM_V, pa0, pa1, pa2, pa3);
  if (hi == 0) li_l[r32] = l_reg; asm volatile("s_waitcnt lgkmcnt(0)" ::: "memory");
  float rli[16];
#pragma unroll
  for (int r = 0; r < 16; ++r) rli[r] = __builtin_amdgcn_rcpf(li_l[crow(r, hi)]);
  __syncthreads();
  float* X2 = (float*)lds + qsub * 4096 + lane;
  if (map == 1) {
#pragma unroll
    for (int r = 0; r < 16; ++r)
#pragma unroll
      for (int d0 = 0; d0 < 4; ++d0) X2[(r * 4 + d0) * 64] = o[d0][r] * rli[r];
  }
  __syncthreads();
  if (map == 0) {
    float g[4];
#pragma unroll
    for (int d0 = 0; d0 < 4; ++d0) g[d0] = gsub[32 * d0 + r32] * (1.f - LAM_INIT);
#pragma unroll
    for (int r = 0; r < 16; ++r) {
      float ss = 0.f;
#pragma unroll
      for (int d0 = 0; d0 < 4; ++d0) { const float v = o[d0][r] * rli[r] - lam * X2[(r * 4 + d0) * 64]; o[d0][r] = v; ss += v * v; }
#pragma unroll
      for (int m = 1; m < 32; m <<= 1) ss += shx(ss, m, lane);
      const float rs = rsqrtf(ss * (1.f / 128.f) + EPS);
      bf16_t* orow = Ob + (size_t)(qsub * 32 + crow(r, hi)) * DM + r32;
#pragma unroll
      for (int d0 = 0; d0 < 4; ++d0) orow[32 * d0] = (bf16_t)f2bf(o[d0][r] * rs * g[d0]);
    }
  }
  __syncthreads();
#undef SLOAD
#undef SWRITE
#undef SWAIT
#undef RESC
}
#undef KSWZ
#undef SBAR
}
__device__ __forceinline__ void ph_attn_fast(CArgs& a, const Ctx& c) {
  const bf16_t* Q = (const bf16_t*)(a.ws + WS_Q); const bf16_t* Kb = (const bf16_t*)(a.ws + WS_K); const bf16_t* Vb = (const bf16_t*)(a.ws + WS_V); bf16_t* ATT = (bf16_t*)(a.ws + WS_ATT);
  const float lam = *(const float*)(a.ws + WS_LAM);
  constexpr int NU = NB * NH * (NSEQ / 128);
  for (int i = 0; ; ++i) {
    const int L = i * c.G + c.blk; if (L >= NU) break;
    const int v = pg8::xcd_remap(L, NU), qb = v & 31, bh = v >> 5, b = bh >> 2, h = bh & 3;
    const size_t row0 = (size_t)b * NSEQ + qb * 128;
    att::unit(Q + row0 * AW + h * 128, Kb + (size_t)b * SKV * AW + h * 128, Vb + (size_t)b * SKV * AW + h * 128, ATT + row0 * DM + h * 128, lam, a.in[I_GSUBLN], (char*)c.lds, c.tid);
  }
}

constexpr int NPHASE = 10;
__device__ __forceinline__ void run_phase(int ph, CArgs& a, const Ctx& c) {
    switch (ph) {
        case 0: { unsigned* f = (unsigned*)(a.ws + WS_CTL) + CW_ADALN;
                  ph_adaln(a, c); flag_arrive(f, c.tid); ph_transposes(a, c); flag_wait(f, (unsigned)c.G, c.tid); ph_hxrows(a, c); } break;
        case 1: break;
        case 2: ph_inproj_fast(a, c); break;
        case 3: ph_attn_fast(a, c); __syncthreads(); ph_pool_fast(a, c); break;
        case 4: ph_outproj_fast(a, c); break;
        case 5: ph_norm_router_fast(a, c); break;
        case 6: ph_tables(a, c); break;
        case 7: ph_gateup_fast(a, c); break;
        case 8: ph_down_fast(a, c); break;
        case 9: ph_combine(a, c); break;
        default: break;
    }
}
__global__ void __launch_bounds__(512, 2) mega(Args a_) {
    extern __shared__ __attribute__((aligned(16))) unsigned char lds[];
    const int lo = a_.ph_lo, hi = a_.ph_hi;
    { volatile LAS unsigned* z = (volatile LAS unsigned*)((LAS unsigned char*)lds + LDSCTL_OFF); for (int u = threadIdx.x; u < (LDS_BYTES - LDSCTL_OFF) / 4; u += 512) z[u] = 0u; }
    __syncthreads();
    volatile LAS unsigned* MISC = (volatile LAS unsigned*)((LAS unsigned char*)lds + MISC_OFF);
    XcdBarrier bar; bar.bar = (unsigned*)(a_.ws + WS_CTL); bar.x = 0; bar.st = nullptr;
    if (hi - lo > 1) bar = xcd_barrier_post((unsigned*)(a_.ws + WS_CTL), MISC + 8);
#define PHASE(k) if (lo <= (k) && (k) < hi) { \
        int t_ = threadIdx.x; asm volatile("" : "+v"(t_)); \
        CArgs* ap_ = (CArgs*)__builtin_amdgcn_kernarg_segment_ptr(); asm volatile("" : "+s"(ap_)); \
        Ctx c; c.tid = t_; c.lane = t_ & 63; c.wave = __builtin_amdgcn_readfirstlane(t_ >> 6); c.blk = blockIdx.x; c.G = gridDim.x; c.lds = lds; \
        run_phase((k), *ap_, c); \
        if ((k) == REPEAT_PH) { for (int rep_ = 0; rep_ < REPEAT_N; ++rep_) { xcd_barrier(bar); run_phase((k), *ap_, c); } } \
        if ((k) + 1 < hi) xcd_barrier(bar); }
    PHASE(0) PHASE(2) PHASE(3) PHASE(4) PHASE(5) PHASE(6) PHASE(7) PHASE(8) PHASE(9)
#undef PHASE
}

extern "C" void kernel_launch(void* const* d_in, const int* in_sizes, int n_in, void* d_out, int out_size, void* d_ws, size_t ws_size, hipStream_t stream) {
    static int grid = 0;
    if (grid == 0) {
        if (n_in != 28 || in_sizes[0] != T * DM || out_size != T * DM || ws_size < WS_END) {
            fprintf(stderr, "kernel_launch: unexpected shapes or workspace: n_in %d in0 %d out %d ws %zu (need %zu)\n", n_in, n_in > 0 ? in_sizes[0] : -1, out_size, ws_size, (size_t)WS_END);
            grid = -1; return; }
        int dev = 0, cus = 0;
        if (hipGetDevice(&dev) != hipSuccess || hipDeviceGetAttribute(&cus, hipDeviceAttributeMultiprocessorCount, dev) != hipSuccess) { grid = -1; return; }
        if (hipFuncSetAttribute((const void*)mega, hipFuncAttributeMaxDynamicSharedMemorySize, LDS_BYTES) != hipSuccess) { fprintf(stderr, "kernel_launch: hipFuncSetAttribute failed\n"); grid = -1; return; }
        grid = cus;
    }
    if (grid < 0) return;
    (void)hipMemsetAsync((char*)d_ws + WS_CTL, 0, CTL_ZERO_BYTES, stream);
    Args a{};
    for (int i = 0; i < 28; ++i) a.in[i] = (const float*)d_in[i];
    a.out = (float*)d_out; a.ws = (unsigned char*)d_ws;
#if MK_PER_PHASE_LAUNCH
    for (int p = 0; p < NPHASE; ++p) { a.ph_lo = p; a.ph_hi = p + 1; hipLaunchKernelGGL(mega, dim3(grid), dim3(512), LDS_BYTES, stream, a); }
#else
    a.ph_lo = 0; a.ph_hi = NPHASE; hipLaunchKernelGGL(mega, dim3(grid), dim3(512), LDS_BYTES, stream, a);
#endif
    const hipError_t le = hipPeekAtLastError();
    if (le != hipSuccess) fprintf(stderr, "kernel_launch: launch failed: %s\n", hipGetErrorName(le));
}
```

```cpp
#include <hip/hip_runtime.h>
#include <cstdio>
#include <cstdint>

#ifndef REPK_DOWN
#define REPK_DOWN 1
#endif
#ifndef REPK_GU
#define REPK_GU 1
#endif
#ifndef PROBE_PH
#define PROBE_PH (-1)
#endif
#ifndef PROBE_AMP
#define PROBE_AMP 10
#endif
#ifndef REPEAT_PH
#define REPEAT_PH (-1)
#endif
#ifndef REPEAT_N
#define REPEAT_N 1
#endif
#ifndef MK_PER_PHASE_LAUNCH
#define MK_PER_PHASE_LAUNCH 0
#endif

constexpr int NB = 4, NSEQ = 4096, DM = 1024, T = NB * NSEQ, CTXL = 256, TC = NB * CTXL, TT = T + TC;
constexpr int NH = 4, DQK = 64, DV = 128, AW = 512, INW = 2048, PW = 512;
constexpr int SKV = CTXL + NSEQ;
constexpr int NE = 64, FF = 256, TOPK = 8;
constexpr int NSLOT_R = T * TOPK;
constexpr int NSLOT = NSLOT_R + T;
constexpr float EPS = 1e-6f;
constexpr float LAM_INIT = 0.2f;
constexpr int NVB = 256;

typedef unsigned short bf16_t;
typedef unsigned int u32;

constexpr size_t KiB = 1024, MiB = 1024 * 1024;
constexpr size_t WS_CTL = 0;
constexpr size_t CTL_ZERO_BYTES = 64 * KiB;
constexpr size_t WS_MODS = 64 * KiB;
constexpr size_t WS_LAM = 192 * KiB;
constexpr size_t WS_ROPE = 196 * KiB;
constexpr size_t WS_SEG = 208 * KiB;
constexpr size_t WS_BLKCNT = 256 * KiB;
constexpr size_t WS_TOPE = 512 * KiB;
constexpr size_t WS_TOPW = 1 * MiB;
constexpr size_t WS_TOKSLOT = 1 * MiB + 512 * KiB;
constexpr size_t WS_SLOTTOK = 2 * MiB;
constexpr size_t WS_ULIST = 2 * MiB + 512 * KiB;
constexpr size_t WS_SLOTE = 3 * MiB;
constexpr size_t WS_WPOOL = 3 * MiB + 512 * KiB;
constexpr size_t WS_WRHI = 3 * MiB;
constexpr size_t WS_WRLO = 3 * MiB + 128 * KiB;
constexpr size_t WS_WD = 4 * MiB;
constexpr size_t WS_WGU = WS_WD + 33280 * KiB;
constexpr size_t WS_HX = WS_WGU + 65 * MiB;
constexpr size_t WS_WIN = WS_HX + 34 * MiB;
constexpr size_t WS_WOUT = WS_WIN + 4 * MiB;
constexpr size_t WS_Q = WS_WOUT + 2 * MiB;
constexpr size_t WS_K = WS_Q + 16 * MiB;
constexpr size_t WS_V = WS_K + 17 * MiB;
constexpr size_t WS_P = WS_V + 17 * MiB;
constexpr size_t WS_ATT = WS_P + 16 * MiB;
constexpr size_t WS_YX = WS_ATT + 32 * MiB;
constexpr size_t WS_ACT = 227 * MiB + 256 * KiB;
constexpr size_t WS_X1B = 184 * MiB;
constexpr size_t WS_Y = WS_WGU;
constexpr size_t WS_END = WS_ACT + (size_t)(NSLOT + 256) * FF * 2;
static_assert(WS_YX + 32 * MiB <= WS_END + 64 * MiB, "map");
static_assert(WS_Y + (size_t)(NSLOT + 256) * DM <= WS_X1B && WS_X1B + (size_t)T * DM * 2 <= WS_ACT, "Y | X1B | ACT must not overlap");

constexpr int LDS_BYTES = 163840;
constexpr int LDS_MAIN = 140 * 1024;
constexpr int LDS_TOKL = 140 * 1024;
constexpr int LDS_ROPE = 148 * 1024;
constexpr int LDSCTL_OFF = 156 * 1024;
constexpr int MISC_OFF = LDSCTL_OFF + 320;

#define GAS __attribute__((address_space(1)))
#define LAS __attribute__((address_space(3)))

__device__ __forceinline__ u32 f2bf(float f) { u32 u = __float_as_uint(f); return (u + 0x7fffu + ((u >> 16) & 1u)) >> 16; }
__device__ __forceinline__ u32 pk2(float lo, float hi) { return f2bf(lo) | (f2bf(hi) << 16); }
__device__ __forceinline__ float bflo(u32 w) { return __uint_as_float(w << 16); }
__device__ __forceinline__ float bfhi(u32 w) { return __uint_as_float(w & 0xffff0000u); }
__device__ __forceinline__ float bf2f(bf16_t b) { return __uint_as_float(((u32)b) << 16); }
__device__ __forceinline__ float shx(float v, int m, int lane) { return __int_as_float(__builtin_amdgcn_ds_bpermute((lane ^ m) << 2, __float_as_int(v))); }
__device__ __forceinline__ float shl(float v, int src) { return __int_as_float(__builtin_amdgcn_ds_bpermute(src << 2, __float_as_int(v))); }
__device__ __forceinline__ float wave_sum(float v, int lane) {
    (void)lane;
    v += __int_as_float(__builtin_amdgcn_update_dpp(0, __float_as_int(v), 0xB1, 0xf, 0xf, true));
    v += __int_as_float(__builtin_amdgcn_update_dpp(0, __float_as_int(v), 0x4E, 0xf, 0xf, true));
    v += __int_as_float(__builtin_amdgcn_update_dpp(0, __float_as_int(v), 0x141, 0xf, 0xf, true));
    v += __int_as_float(__builtin_amdgcn_update_dpp(0, __float_as_int(v), 0x140, 0xf, 0xf, true));
    const float s0 = __int_as_float(__builtin_amdgcn_readlane(__float_as_int(v), 0)), s1 = __int_as_float(__builtin_amdgcn_readlane(__float_as_int(v), 16));
    const float s2 = __int_as_float(__builtin_amdgcn_readlane(__float_as_int(v), 32)), s3 = __int_as_float(__builtin_amdgcn_readlane(__float_as_int(v), 48));
    return (s0 + s1) + (s2 + s3);
}
__device__ __forceinline__ float wave_max(float v, int lane) {
#pragma unroll
    for (int o = 1; o < 64; o <<= 1) v = fmaxf(v, shx(v, o, lane));
    return v;
}
__device__ __forceinline__ float silu_f(float v) { return v / (1.f + __expf(-v)); }
__device__ __forceinline__ float dot8(uint4 a, uint4 b, float acc) {
    acc = fmaf(bflo(a.x), bflo(b.x), acc); acc = fmaf(bfhi(a.x), bfhi(b.x), acc);
    acc = fmaf(bflo(a.y), bflo(b.y), acc); acc = fmaf(bfhi(a.y), bfhi(b.y), acc);
    acc = fmaf(bflo(a.z), bflo(b.z), acc); acc = fmaf(bfhi(a.z), bfhi(b.z), acc);
    acc = fmaf(bflo(a.w), bflo(b.w), acc); acc = fmaf(bfhi(a.w), bfhi(b.w), acc);
    return acc;
}
__device__ __forceinline__ float ndot(const bf16_t* a, const bf16_t* b, int K) {
    float a0 = 0.f, a1 = 0.f;
    for (int k = 0; k < K; k += 16) {
        const uint4 x0 = *(const uint4*)(a + k), y0 = *(const uint4*)(b + k), x1 = *(const uint4*)(a + k + 8), y1 = *(const uint4*)(b + k + 8);
        a0 = dot8(x0, y0, a0); a1 = dot8(x1, y1, a1);
    }
    return a0 + a1;
}

#define XB_TMO      128
#define XB_XCNT(j)  (256  + 64 * (j))
#define XB_XSUB(j)  (1280 + 64 * (j))
#define XB_XGEN(j)  (2304 + 64 * (j))
#define XB_TOP      3328
#define XB_TOPGEN   3392
#define XCD_BAR_WORDS 3456
#define XB_SPIN_CAP (1u << 22)
__device__ __forceinline__ unsigned xb_ld(unsigned* p)              { return __hip_atomic_load(p, __ATOMIC_RELAXED, __HIP_MEMORY_SCOPE_AGENT); }
__device__ __forceinline__ unsigned xb_add(unsigned* p, unsigned v) { return __hip_atomic_fetch_add(p, v, __ATOMIC_RELAXED, __HIP_MEMORY_SCOPE_AGENT); }
__device__ __forceinline__ unsigned xb_xcc_id() { return (unsigned)__builtin_amdgcn_s_getreg((3 << 11) | 20) & 0xFu; }
#define XB_SPIN(cond, bar) do { unsigned _sp = 0; while (cond) { __builtin_amdgcn_s_sleep(1); \
    if ((++_sp & 255u) == 0u) { if (xb_ld(&(bar)[XB_TMO])) break; if (_sp > XB_SPIN_CAP) { atomicAdd(&(bar)[XB_TMO], 1u); break; } } } } while (0)
struct XcdBarrier { unsigned* bar; unsigned x; volatile LAS unsigned* st; };
__device__ __forceinline__ XcdBarrier xcd_barrier_post(unsigned* bar, volatile LAS unsigned* st) {
    XcdBarrier b; b.bar = bar; b.x = xb_xcc_id(); b.st = st;
    if (threadIdx.x == 0) (void)xb_add(&bar[XB_XCNT(b.x)], 1u);
    return b;
}
__device__ __forceinline__ void xcd_barrier_complete(unsigned* bar, unsigned x, unsigned& nloc, unsigned& nx) {
    const unsigned G = gridDim.x * gridDim.y * gridDim.z;
    unsigned sum, cnt, mine, sp = 0u;
    for (;;) {
        sum = 0u; cnt = 0u; mine = 0u;
#pragma unroll
        for (unsigned j = 0; j < 16; ++j) { const unsigned c = xb_ld(&bar[XB_XCNT(j)]); sum += c; cnt += (c > 0u) ? 1u : 0u; mine = (j == x) ? c : mine; }
        if (sum == G) break;
        __builtin_amdgcn_s_sleep(1);
        if ((++sp & 255u) == 0u) { if (xb_ld(&bar[XB_TMO])) break; if (sp > XB_SPIN_CAP) { atomicAdd(&bar[XB_TMO], 1u); break; } }
    }
    nloc = mine > 0u ? mine : 1u; nx = cnt > 0u ? cnt : 1u;
}
__device__ __forceinline__ void xcd_barrier(const XcdBarrier& b, const int tid) {
    asm volatile("s_waitcnt vmcnt(0)" ::: "memory");
    __syncthreads();
    if (tid == 0) {
        unsigned* bar = b.bar;
        __builtin_amdgcn_s_waitcnt(0);
        unsigned nloc = b.st[0], nx = b.st[1];
        if (nloc == 0u) { xcd_barrier_complete(bar, b.x, nloc, nx); b.st[0] = nloc; b.st[1] = nx; }
        const unsigned old = xb_add(&bar[XB_XSUB(b.x)], 1u);
        const unsigned gen = old / nloc;
        if (old + 1u == (gen + 1u) * nloc) {
            __builtin_amdgcn_fence(__ATOMIC_RELEASE, "agent");
            asm volatile("s_waitcnt vmcnt(0)" ::: "memory");
            const unsigned og = xb_add(&bar[XB_TOP], 1u);
            const unsigned tg = og / nx;
            if (og + 1u == (tg + 1u) * nx) xb_add(&bar[XB_TOPGEN], 1u);
            else XB_SPIN(xb_ld(&bar[XB_TOPGEN]) == tg, bar);
            __builtin_amdgcn_fence(__ATOMIC_ACQUIRE, "agent");
            xb_add(&bar[XB_XGEN(b.x)], 1u);
            asm volatile("s_waitcnt vmcnt(0)" ::: "memory");
        } else {
            XB_SPIN(xb_ld(&bar[XB_XGEN(b.x)]) == gen, bar);
            __builtin_amdgcn_fence(__ATOMIC_ACQUIRE, "agent");
            asm volatile("s_waitcnt vmcnt(0)" ::: "memory");
        }
    }
    __syncthreads();
}


constexpr int CW_ADALN = 4096, CW_ROUTER = 4160;
__device__ __forceinline__ void flag_arrive(unsigned* cnt, int tid) {
    asm volatile("s_waitcnt vmcnt(0)" ::: "memory");
    __syncthreads();
    if (tid == 0) { __builtin_amdgcn_fence(__ATOMIC_RELEASE, "agent"); asm volatile("s_waitcnt vmcnt(0)" ::: "memory"); (void)xb_add(cnt, 1u); }
}
__device__ __forceinline__ void flag_wait(unsigned* cnt, unsigned target, int tid) {
    if (tid == 0) { unsigned sp = 0; while (xb_ld(cnt) < target) { __builtin_amdgcn_s_sleep(2); if (++sp > (1u << 24)) break; }
        __builtin_amdgcn_fence(__ATOMIC_ACQUIRE, "agent"); asm volatile("s_waitcnt vmcnt(0)" ::: "memory"); }
    __syncthreads();
}


#ifndef PROBE_SUB
#define PROBE_SUB (-1)
#endif
__device__ __forceinline__ void pt_mark(unsigned char* lds, int tid, int id, bool begin) {
    if (PROBE_SUB >= 0 && tid == 0) { volatile LAS unsigned* w = (volatile LAS unsigned*)((LAS unsigned char*)lds + MISC_OFF) + 16 + 2 * id;
        const unsigned now = (unsigned)__builtin_amdgcn_s_memrealtime(); if (begin) w[0] = now; else w[1] += now - w[0]; }
}

struct Args {
    const float* in[28];
    float* out;
    unsigned char* ws;
    int ph_lo, ph_hi;
};
enum { I_X = 0, I_C, I_CTX, I_CCTX, I_WADA, I_BADA, I_GPREMIX, I_GPOSTMIX, I_GPREFFN, I_GPOSTFFN, I_WIN, I_LQ1, I_LK1, I_LQ2, I_LK2,
       I_GSUBLN, I_WPOOL, I_BPOOL, I_PSCALE, I_WOUT, I_WROUTER, I_RBIAS, I_WEG, I_WEU, I_WED, I_WSG, I_WSU, I_WSD };

typedef __attribute__((address_space(4))) const Args CArgs;
struct Ctx {
    int tid, lane, wave, blk, G;
    unsigned char* lds;
};

__device__ __forceinline__ void ph_adaln(CArgs& a, const Ctx& c) {
    float* MODS = (float*)(a.ws + WS_MODS);
    float* red = (float*)c.lds;
    const float* w_ada = a.in[I_WADA];
    const int ksub = c.lane / 6, c4 = c.lane % 6;
    for (int it = c.blk; it < 256; it += c.G) {
        float acc[5][4];
#pragma unroll
        for (int r = 0; r < 5; ++r)
#pragma unroll
            for (int j = 0; j < 4; ++j) acc[r][j] = 0.f;
        if (ksub < 10) {
            for (int i = 0; i < 13; ++i) { const int kk = ksub + 10 * i;
                if (kk < 128) { const int k = c.wave * 128 + kk;
                    const float4 w = *(const float4*)(w_ada + (size_t)k * 6144 + it * 24 + 4 * c4);
#pragma unroll
                    for (int r = 0; r < 5; ++r) { const float sv = silu_f((r < 4) ? a.in[I_C][r * DM + k] : a.in[I_CCTX][k]);
                        acc[r][0] = fmaf(sv, w.x, acc[r][0]); acc[r][1] = fmaf(sv, w.y, acc[r][1]); acc[r][2] = fmaf(sv, w.z, acc[r][2]); acc[r][3] = fmaf(sv, w.w, acc[r][3]); } } }
#pragma unroll
            for (int r = 0; r < 5; ++r)
#pragma unroll
                for (int j = 0; j < 4; ++j) red[((c.wave * 10 + ksub) * 5 + r) * 24 + 4 * c4 + j] = acc[r][j];
        }
        __syncthreads();
        if (c.tid < 120) { const int r = c.tid / 24, col = c.tid % 24; float sum = 0.f;
            for (int q = 0; q < 80; ++q) sum += red[(q * 5 + r) * 24 + col];
            MODS[r * 6144 + it * 24 + col] = sum + a.in[I_BADA][it * 24 + col]; }
        __syncthreads();
    }
    if (c.blk == c.G - 1) {
        float* ROPE = (float*)(a.ws + WS_ROPE);
        for (int i = c.tid; i < 1024; i += 512) {
            const int pos = i >> 4, fi = i & 15;
            const float freq = powf(10000.f, -(float)fi / 16.f);
            const float ang = (float)pos * freq;
            ROPE[i * 2] = cosf(ang); ROPE[i * 2 + 1] = sinf(ang);
        }
        if (c.wave == 0) {
            const float s1 = wave_sum(a.in[I_LQ1][c.lane] * a.in[I_LK1][c.lane], c.lane);
            const float s2 = wave_sum(a.in[I_LQ2][c.lane] * a.in[I_LK2][c.lane], c.lane);
            if (c.lane == 0) *(float*)(a.ws + WS_LAM) = expf(s1) - expf(s2) + LAM_INIT;
        }
    }
    __syncthreads();
}

__device__ __forceinline__ void transpose_item(const float* W, int K, int N, bf16_t* WT, int k0, int n0, int drow0, float* scr, int lane) {
    float v[32];
#pragma unroll
    for (int i = 0; i < 32; ++i) v[i] = W[(size_t)(k0 + 2 * i + (lane >> 5)) * N + n0 + (lane & 31)];
#pragma unroll
    for (int i = 0; i < 32; ++i) scr[(2 * i + (lane >> 5)) * 33 + (lane & 31)] = v[i];
    asm volatile("s_waitcnt lgkmcnt(0)" ::: "memory");
    const int cc = lane & 7;
#pragma unroll
    for (int j = 0; j < 4; ++j) { const int n = (lane >> 3) + 8 * j; const float* s = scr + (8 * cc) * 33 + n;
        uint4 o; o.x = pk2(s[0 * 33], s[1 * 33]); o.y = pk2(s[2 * 33], s[3 * 33]); o.z = pk2(s[4 * 33], s[5 * 33]); o.w = pk2(s[6 * 33], s[7 * 33]);
        *(uint4*)(WT + (size_t)(drow0 + n) * K + k0 + 8 * cc) = o; }
    asm volatile("s_waitcnt lgkmcnt(0)" ::: "memory");
}
__device__ __forceinline__ void transpose_item_hilo(const float* W, bf16_t* WH, bf16_t* WL, int k0, int n0, float* scr, int lane) {
    float v[32];
#pragma unroll
    for (int i = 0; i < 32; ++i) v[i] = W[(size_t)(k0 + 2 * i + (lane >> 5)) * NE + n0 + (lane & 31)];
#pragma unroll
    for (int i = 0; i < 32; ++i) scr[(2 * i + (lane >> 5)) * 33 + (lane & 31)] = v[i];
    asm volatile("s_waitcnt lgkmcnt(0)" ::: "memory");
    const int cc = lane & 7;
#pragma unroll
    for (int j = 0; j < 4; ++j) { const int n = (lane >> 3) + 8 * j; const float* s = scr + (8 * cc) * 33 + n;
        u32 h[4], l[4];
#pragma unroll
        for (int q = 0; q < 4; ++q) { const float f0 = s[(2 * q) * 33], f1 = s[(2 * q + 1) * 33]; const u32 h0 = f2bf(f0), h1 = f2bf(f1);
            h[q] = h0 | (h1 << 16); l[q] = pk2(f0 - __uint_as_float(h0 << 16), f1 - __uint_as_float(h1 << 16)); }
        *(uint4*)(WH + (size_t)(n0 + n) * DM + k0 + 8 * cc) = make_uint4(h[0], h[1], h[2], h[3]);
        *(uint4*)(WL + (size_t)(n0 + n) * DM + k0 + 8 * cc) = make_uint4(l[0], l[1], l[2], l[3]); }
    asm volatile("s_waitcnt lgkmcnt(0)" ::: "memory");
}
constexpr int TR_I_IN = 16 * 64, TR_I_OUT = 16 * 32, TR_I_G = 16 * 8, TR_I_D = 4 * 32, TR_I_P = 4 * 2 * 4;
constexpr int TR_I_R = 16 * 2;
constexpr int TR_NIT = TR_I_IN + TR_I_OUT + TR_I_P + TR_I_R + 65 * (2 * TR_I_G + TR_I_D);
constexpr int TR_NFILL = 10240;
__device__ __forceinline__ void ph_transposes(CArgs& a, const Ctx& c, const int it_lo, const int it_hi, const int wrank, const int NW) {
    float* scr = (float*)(c.lds + c.wave * 16384);
    constexpr int I_IN = TR_I_IN, I_OUT = TR_I_OUT, I_G = TR_I_G, I_D = TR_I_D, I_P = TR_I_P;
    bf16_t* WIN = (bf16_t*)(a.ws + WS_WIN); bf16_t* WOUT = (bf16_t*)(a.ws + WS_WOUT); bf16_t* WGU = (bf16_t*)(a.ws + WS_WGU); bf16_t* WD = (bf16_t*)(a.ws + WS_WD);
    for (int it = it_lo + wrank; it < it_hi; it += NW) {
        int r = it;
        if (r < I_IN) { const int kb = r / 64, nb = r % 64; transpose_item(a.in[I_WIN], DM, INW, WIN, kb * 64, nb * 32, nb * 32, scr, c.lane); continue; } r -= I_IN;
        if (r < I_OUT) { const int kb = r / 32, nb = r % 32; transpose_item(a.in[I_WOUT], DM, DM, WOUT, kb * 64, nb * 32, nb * 32, scr, c.lane); continue; } r -= I_OUT;
        if (r < I_P) { const int g = r >> 3, kb = (r >> 2) & 1, nb = r & 3;
            transpose_item(a.in[I_WPOOL] + (size_t)g * 128 * 128, 128, 128, (bf16_t*)(a.ws + WS_WPOOL) + (size_t)g * 128 * 128, kb * 64, nb * 32, nb * 32, scr, c.lane); continue; } r -= I_P;
        if (r < TR_I_R) { transpose_item_hilo(a.in[I_WROUTER], (bf16_t*)(a.ws + WS_WRHI), (bf16_t*)(a.ws + WS_WRLO), (r >> 1) * 64, (r & 1) * 32, scr, c.lane); continue; } r -= TR_I_R;
        const int e = r / (2 * I_G + I_D); r -= e * (2 * I_G + I_D);
        if (r < 2 * I_G) {
            const int up = r / I_G; r -= up * I_G; const int kb = r / 8, nb = r % 8, n0 = nb * 32;
            const float* src = (e < 64) ? a.in[up ? I_WEU : I_WEG] + (size_t)e * DM * FF : a.in[up ? I_WSU : I_WSG];
            transpose_item(src, DM, FF, WGU + (size_t)e * 512 * DM, kb * 64, n0, 256 * (n0 >> 7) + (n0 & 127) + (up ? 128 : 0), scr, c.lane);
        } else {
            r -= 2 * I_G; const int kb = r / 32, nb = r % 32;
            const float* src = (e < 64) ? a.in[I_WED] + (size_t)e * FF * DM : a.in[I_WSD];
            transpose_item(src, FF, DM, WD + (size_t)e * DM * FF, kb * 64, nb * 32, nb * 32, scr, c.lane);
        }
    }
}
__device__ __forceinline__ void ph_hxrows(CArgs& a, const Ctx& c) {
    const int gw = c.blk * 8 + c.wave, NGW = c.G * 8;
    const float* MODS = (const float*)(a.ws + WS_MODS); bf16_t* HX = (bf16_t*)(a.ws + WS_HX);
    for (int m = gw; m < TT; m += NGW) {
        const float* xr = (m < T) ? a.in[I_X] + (size_t)m * DM : a.in[I_CTX] + (size_t)(m - T) * DM;
        const float* md = MODS + (size_t)((m < T) ? (m / NSEQ) : 4) * 6144;
        float4 v[4]; float ss = 0.f;
#pragma unroll
        for (int j = 0; j < 4; ++j) { v[j] = *(const float4*)(xr + 4 * c.lane + 256 * j); ss += v[j].x * v[j].x + v[j].y * v[j].y + v[j].z * v[j].z + v[j].w * v[j].w; }
        const float rs = rsqrtf(wave_sum(ss, c.lane) * (1.f / DM) + EPS);
#pragma unroll
        for (int j = 0; j < 4; ++j) {
            const int col = 4 * c.lane + 256 * j;
            const float4 g = *(const float4*)(a.in[I_GPREMIX] + col), sh = *(const float4*)(md + col), sc = *(const float4*)(md + 1024 + col);
            const float o0 = v[j].x * rs * g.x * (1.f + sc.x) + sh.x, o1 = v[j].y * rs * g.y * (1.f + sc.y) + sh.y;
            const float o2 = v[j].z * rs * g.z * (1.f + sc.z) + sh.z, o3 = v[j].w * rs * g.w * (1.f + sc.w) + sh.w;
            uint2 w; w.x = pk2(o0, o1); w.y = pk2(o2, o3);
            *(uint2*)(HX + (size_t)m * DM + col) = w;
        }
    }
}

__device__ __forceinline__ void route_token(CArgs& a, const Ctx& c, const int t, const float logit, const float rbias, int* hist) {
    int* TOPE = (int*)(a.ws + WS_TOPE); float* TOPW = (float*)(a.ws + WS_TOPW);
    const float score = 1.f / (1.f + expf(-logit));
    const float biased = score + rbias;
    int grank = 0;
#pragma unroll
    for (int j = 0; j < 8; ++j) { const float vj = shl(biased, (c.lane & ~7) + j); grank += (vj > biased || (vj == biased && j < (c.lane & 7))) ? 1 : 0; }
    float gs = (grank < 2) ? biased : 0.f;
    gs += shx(gs, 1, c.lane); gs += shx(gs, 2, c.lane); gs += shx(gs, 4, c.lane);
    int gr = 0; const int myg = c.lane >> 3;
#pragma unroll
    for (int g = 0; g < 8; ++g) { const float sg = __int_as_float(__builtin_amdgcn_readlane(__float_as_int(gs), g * 8)); gr += (sg > gs || (sg == gs && g < myg)) ? 1 : 0; }
    const unsigned fb = __float_as_uint(biased);
    const unsigned key = (gr < 4) ? (fb ^ ((fb >> 31) ? 0xffffffffu : 0x80000000u)) : 0u;
    unsigned T = 0u;
#pragma unroll
    for (int b = 31; b >= 0; --b) { const unsigned cand = T | (1u << b); if (__builtin_popcountll(__ballot(key >= cand)) >= TOPK) T = cand; }
    const unsigned long long mgt = __ballot(key > T), meq = __ballot(key == T);
    const unsigned long long below = (1ull << c.lane) - 1ull;
    const int need = TOPK - __builtin_popcountll(mgt);
    const bool sel = (key > T) || (key == T && __builtin_popcountll(meq & below) < need);
    const int cnt = __builtin_popcountll(__ballot(sel) & below);
    const float ssum = wave_sum(sel ? score : 0.f, c.lane);
    if (sel) {
        const int lr = atomicAdd(&hist[c.lane], 1);
        TOPE[t * 8 + cnt] = c.lane | (lr << 8);
        TOPW[t * 8 + cnt] = score / ssum * 2.5f;
    }
}
__device__ __forceinline__ void ph_norm_router_fast(CArgs& a, const Ctx& c) {
    typedef float f32x16 __attribute__((ext_vector_type(16)));
    typedef short bf16x8 __attribute__((ext_vector_type(8)));
    constexpr int HSB = 2064;
    char* HSH = (char*)c.lds;
    float* HS = (float*)c.lds;
    int* hist = (int*)(c.lds + 132352);
    float* PRM = (float*)(c.lds + LDS_TOKL);
    int* BLKCNT = (int*)(a.ws + WS_BLKCNT);
    const int kq = c.wave >> 1, jt = c.wave & 1;
    const float rbias = a.in[I_RBIAS][c.lane];
    const bf16_t* YX = (const bf16_t*)(a.ws + WS_YX); bf16_t* HX2 = (bf16_t*)(a.ws + WS_HX); bf16_t* X1B = (bf16_t*)(a.ws + WS_X1B);
    for (int vb = c.blk; vb < NVB; vb += c.G) {
        if (c.tid < 64) hist[c.tid] = 0;
        { const float* md = (const float*)(a.ws + WS_MODS) + (size_t)((vb * 64) / NSEQ) * 6144;
          for (int col = c.tid; col < DM; col += 512) { PRM[col] = md[2048 + col] * a.in[I_GPOSTMIX][col]; PRM[1024 + col] = a.in[I_GPREFFN][col] * (1.f + md[4096 + col]); PRM[2048 + col] = md[3072 + col]; } }
        __syncthreads();
        for (int pass = 0; pass < 2; ++pass) {
            const int t0 = vb * 64 + pass * 32;
            pt_mark(c.lds, c.tid, 3, true);
            {
                uint2 yA[4], yB[4]; float4 xA[4], xB[4];
#define RT_LOAD(Y, X, tok) do { const size_t t_ = (size_t)(tok); _Pragma("unroll") for (int j = 0; j < 4; ++j) { Y[j] = *(const uint2*)(YX + t_ * DM + 4 * c.lane + 256 * j); X[j] = *(const float4*)(a.in[I_X] + t_ * DM + 4 * c.lane + 256 * j); } } while (0)
#define RT_NORM(Y, X, ti_) do { const int ti = (ti_); const size_t t = (size_t)(t0 + ti); char* row = HSH + ti * HSB; \
                    float v[16]; float ss = 0.f; \
                    _Pragma("unroll") for (int j = 0; j < 4; ++j) { v[4 * j] = bflo(Y[j].x); v[4 * j + 1] = bfhi(Y[j].x); v[4 * j + 2] = bflo(Y[j].y); v[4 * j + 3] = bfhi(Y[j].y); } \
                    _Pragma("unroll") for (int j = 0; j < 16; ++j) ss += v[j] * v[j]; \
                    const float r1 = rsqrtf(wave_sum(ss, c.lane) * (1.f / DM) + EPS); \
                    float ss2 = 0.f; \
                    _Pragma("unroll") for (int j = 0; j < 4; ++j) { const float4 A1 = *(const float4*)(PRM + 4 * c.lane + 256 * j); float4 x1; \
                        x1.x = fmaf(A1.x, v[4 * j] * r1, X[j].x); x1.y = fmaf(A1.y, v[4 * j + 1] * r1, X[j].y); x1.z = fmaf(A1.z, v[4 * j + 2] * r1, X[j].z); x1.w = fmaf(A1.w, v[4 * j + 3] * r1, X[j].w); \
                        { uint2 xw_; xw_.x = pk2(x1.x, x1.y); xw_.y = pk2(x1.z, x1.w); *(uint2*)(X1B + t * DM + 4 * c.lane + 256 * j) = xw_; } \
                        v[4 * j] = x1.x; v[4 * j + 1] = x1.y; v[4 * j + 2] = x1.z; v[4 * j + 3] = x1.w; \
                        ss2 += x1.x * x1.x + x1.y * x1.y + x1.z * x1.z + x1.w * x1.w; } \
                    const float r2 = rsqrtf(wave_sum(ss2, c.lane) * (1.f / DM) + EPS); \
                    _Pragma("unroll") for (int j = 0; j < 4; ++j) { const int col = 4 * c.lane + 256 * j; const float4 G2 = *(const float4*)(PRM + 1024 + col), SH = *(const float4*)(PRM + 2048 + col); \
                        const float h0 = fmaf(v[4 * j] * r2, G2.x, SH.x), h1 = fmaf(v[4 * j + 1] * r2, G2.y, SH.y), h2 = fmaf(v[4 * j + 2] * r2, G2.z, SH.z), h3 = fmaf(v[4 * j + 3] * r2, G2.w, SH.w); \
                        const u32 b0_ = f2bf(h0), b1_ = f2bf(h1), b2_ = f2bf(h2), b3_ = f2bf(h3); \
                        uint2 w; w.x = b0_ | (b1_ << 16); w.y = b2_ | (b3_ << 16); \
                        *(uint2*)(HX2 + t * DM + col) = w; \
                        uint2 wl; wl.x = pk2(h0 - __uint_as_float(b0_ << 16), h1 - __uint_as_float(b1_ << 16)); wl.y = pk2(h2 - __uint_as_float(b2_ << 16), h3 - __uint_as_float(b3_ << 16)); \
                        *(uint2*)(row + col * 2) = w; *(uint2*)(row + 32 * HSB + col * 2) = wl; } } while (0)
                const int tw = t0 + c.wave * 4;
                RT_LOAD(yA, xA, tw);
#pragma unroll 1
                for (int it = 0; it < 2; ++it) {
                    RT_LOAD(yB, xB, tw + 2 * it + 1);
                    RT_NORM(yA, xA, c.wave * 4 + 2 * it);
                    if (it == 0) RT_LOAD(yA, xA, tw + 2);
                    RT_NORM(yB, xB, c.wave * 4 + 2 * it + 1);
                }
#undef RT_LOAD
#undef RT_NORM
            }
            __syncthreads(); pt_mark(c.lds, c.tid, 3, false); pt_mark(c.lds, c.tid, 4, true);
            f32x16 acc = {};
            {
                int ln_ = c.lane; asm volatile("" : "+v"(ln_)); const int r32 = ln_ & 31, hi = ln_ >> 5;
                const char* aH = HSH + r32 * HSB + (kq * 256 + hi * 8) * 2;
                const bf16_t* bH = (const bf16_t*)(a.ws + WS_WRHI) + (size_t)(jt * 32 + r32) * DM + kq * 256 + hi * 8; const bf16_t* bL = bH + (size_t)NE * DM;
#pragma unroll
                for (int bt = 0; bt < 2; ++bt) {
                    bf16x8 wh[8], wl[8];
#pragma unroll
                    for (int q = 0; q < 8; ++q) { wh[q] = *(const bf16x8*)(bH + (bt * 8 + q) * 16); wl[q] = *(const bf16x8*)(bL + (bt * 8 + q) * 16); }
#pragma unroll
                    for (int q = 0; q < 8; ++q) { const bf16x8 ah = *(const bf16x8*)(aH + (bt * 8 + q) * 32), al = *(const bf16x8*)(aH + 32 * HSB + (bt * 8 + q) * 32);
                        acc = __builtin_amdgcn_mfma_f32_32x32x16_bf16(ah, wh[q], acc, 0, 0, 0);
                        acc = __builtin_amdgcn_mfma_f32_32x32x16_bf16(ah, wl[q], acc, 0, 0, 0);
                        acc = __builtin_amdgcn_mfma_f32_32x32x16_bf16(al, wh[q], acc, 0, 0, 0); }
                }
            }
            __syncthreads(); pt_mark(c.lds, c.tid, 4, false); pt_mark(c.lds, c.tid, 5, true);
#pragma unroll
            for (int r = 0; r < 16; ++r) HS[(kq * 32 + ((r & 3) + 8 * (r >> 2) + 4 * (c.lane >> 5))) * 64 + jt * 32 + (c.lane & 31)] = acc[r];
            __syncthreads();
            for (int i = 0; i < 4; ++i) { const int ti = c.wave * 4 + i;
                const float lg = ((HS[(0 * 32 + ti) * 64 + c.lane] + HS[(1 * 32 + ti) * 64 + c.lane]) + HS[(2 * 32 + ti) * 64 + c.lane]) + HS[(3 * 32 + ti) * 64 + c.lane];
                route_token(a, c, t0 + ti, lg, rbias, hist); }
            __syncthreads(); pt_mark(c.lds, c.tid, 5, false);
        }
        if (c.tid < 64) BLKCNT[vb * 64 + c.tid] = hist[c.tid];
        __syncthreads();
    }
}

__device__ __forceinline__ int pl_row(int n) { return n < 0 ? 0 : (n >= NSEQ ? NSEQ - 1 : n); }
__device__ __forceinline__ void ph_pool_fast(CArgs& a, const Ctx& c) {
    typedef short bf16x8 __attribute__((ext_vector_type(8)));
    typedef float f32x16 __attribute__((ext_vector_type(16)));
    const bf16_t* P = (const bf16_t*)(a.ws + WS_P); bf16_t* ATT = (bf16_t*)(a.ws + WS_ATT); const bf16_t* WPT = (const bf16_t*)(a.ws + WS_WPOOL);
    constexpr int DSTR = 1040;
    constexpr int PL_ROWS = 80, OSTR = 272;
    char* Pl = (char*)c.lds;
    char* Dl = (char*)c.lds + PL_ROWS * 1024;
    for (int u = c.blk; u < T / 64; u += c.G) {
        const int row0 = u * 64, n0 = row0 % NSEQ;
        __syncthreads();
        {
            const bf16_t* pb = P + (size_t)(row0 - n0) * PW;
#define PL_LD(i) const uint4 v##i = *(const uint4*)(pb + (size_t)pl_row(n0 - 8 + ((c.tid + 512 * i) >> 6)) * PW + ((c.tid + 512 * i) & 63) * 8)
#define PL_ST(i) *(uint4*)(Pl + (c.tid + 512 * i) * 16) = v##i
            PL_LD(0); PL_LD(1); PL_LD(2); PL_LD(3); PL_LD(4); PL_LD(5); PL_LD(6); PL_LD(7); PL_LD(8); PL_LD(9);
            PL_ST(0); PL_ST(1); PL_ST(2); PL_ST(3); PL_ST(4); PL_ST(5); PL_ST(6); PL_ST(7); PL_ST(8); PL_ST(9);
#undef PL_LD
#undef PL_ST
        }
        __syncthreads();
        {
            const int cc = c.tid & 63, rr = c.tid >> 6, g = cc >> 4, w = 2 << g, hw = w >> 1;
            const char* pc = Pl + cc * 16 - (n0 - 8) * 1024;
            float s[8];
#pragma unroll
            for (int j = 0; j < 8; ++j) s[j] = 0.f;
            const int nfirst = n0 + rr * 8;
            int lo = nfirst - hw; if (lo < 0) lo = 0; int hiw = nfirst + hw; if (hiw > NSEQ) hiw = NSEQ;
            for (int n = lo; n < hiw; ++n) { const uint4 q = *(const uint4*)(pc + n * 1024);
                s[0] += bflo(q.x); s[1] += bfhi(q.x); s[2] += bflo(q.y); s[3] += bfhi(q.y); s[4] += bflo(q.z); s[5] += bfhi(q.z); s[6] += bflo(q.w); s[7] += bfhi(q.w); }
            for (int i = 0; i < 8; ++i) {
                const int n = nfirst + i;
                if (i > 0) {
                    const int nadd = n + hw - 1, nsub = n - hw - 1;
                    if (nadd < NSEQ) { const uint4 q = *(const uint4*)(pc + nadd * 1024);
                        s[0] += bflo(q.x); s[1] += bfhi(q.x); s[2] += bflo(q.y); s[3] += bfhi(q.y); s[4] += bflo(q.z); s[5] += bfhi(q.z); s[6] += bflo(q.w); s[7] += bfhi(q.w); }
                    if (nsub >= 0) { const uint4 q = *(const uint4*)(pc + nsub * 1024);
                        s[0] -= bflo(q.x); s[1] -= bfhi(q.x); s[2] -= bflo(q.y); s[3] -= bfhi(q.y); s[4] -= bflo(q.z); s[5] -= bfhi(q.z); s[6] -= bflo(q.w); s[7] -= bfhi(q.w); }
                }
                int l2 = n - hw; if (l2 < 0) l2 = 0; int h2 = n + hw; if (h2 > NSEQ) h2 = NSEQ;
                const float inv = 1.f / (float)(h2 - l2);
                const uint4 q = *(const uint4*)(pc + n * 1024);
                uint4 o; o.x = pk2(s[0] * inv - bflo(q.x), s[1] * inv - bfhi(q.x)); o.y = pk2(s[2] * inv - bflo(q.y), s[3] * inv - bfhi(q.y));
                o.z = pk2(s[4] * inv - bflo(q.z), s[5] * inv - bfhi(q.z)); o.w = pk2(s[6] * inv - bflo(q.w), s[7] * inv - bfhi(q.w));
                *(uint4*)(Dl + (rr * 8 + i) * DSTR + cc * 16) = o;
            }
        }
        __syncthreads();
        {
            const int g = c.wave >> 1, rh = c.wave & 1, r32 = c.lane & 31, hi = c.lane >> 5;
            f32x16 acc[4] = {};
            const char* ap = Dl + (rh * 32 + r32) * DSTR + g * 256 + hi * 16;
            const bf16_t* bp = WPT + ((size_t)g * 128 + r32) * 128 + hi * 8;
#pragma unroll
            for (int ks = 0; ks < 8; ++ks) {
                const bf16x8 af = *(const bf16x8*)(ap + ks * 32);
#pragma unroll
                for (int et = 0; et < 4; ++et) { const bf16x8 bf = *(const bf16x8*)(bp + (size_t)et * 32 * 128 + ks * 16);
                    acc[et] = __builtin_amdgcn_mfma_f32_32x32x16_bf16(af, bf, acc[et], 0, 0, 0); }
            }
            char* ost = Pl + c.wave * (32 * OSTR);
#pragma unroll
            for (int et = 0; et < 4; ++et) { const int ch = g * 128 + et * 32 + r32; const float bb = a.in[I_BPOOL][ch], sc = a.in[I_PSCALE][ch];
#pragma unroll
                for (int r = 0; r < 16; ++r) { const int lr = (r & 3) + 8 * (r >> 2) + 4 * hi;
                    *(bf16_t*)(ost + lr * OSTR + (et * 32 + r32) * 2) = (bf16_t)f2bf((acc[et][r] + bb) * sc); } }
            asm volatile("s_waitcnt lgkmcnt(0)" ::: "memory");
#pragma unroll
            for (int i = 0; i < 8; ++i) { const int q = c.lane + 64 * i, lr = q >> 4, chunk = q & 15;
                const uint4 v = *(const uint4*)(ost + lr * OSTR + chunk * 16);
                *(uint4*)(ATT + (size_t)(row0 + rh * 32 + lr) * DM + 512 + g * 128 + chunk * 8) = v; }
        }
    }
    __syncthreads();
}

__device__ __forceinline__ void ph_tables(CArgs& a, const Ctx& c) {
    const int* BLKCNT = (const int*)(a.ws + WS_BLKCNT); const int* TOPE = (const int*)(a.ws + WS_TOPE); const float* TOPW = (const float*)(a.ws + WS_TOPW);
    int* SEG = (int*)(a.ws + WS_SEG); int* TOKSLOT = (int*)(a.ws + WS_TOKSLOT); int* SLOTTOK = (int*)(a.ws + WS_SLOTTOK);
    int* psum = (int*)c.lds;
    int* segstart = psum + 512;
    int* segcnt = segstart + 64;
    int* base = segcnt + 64;
    { const int e = c.tid & 63, p = c.tid >> 6; int s = 0;
      for (int v = 0; v < 32; ++v) s += BLKCNT[(p * 32 + v) * 64 + e];
      psum[p * 64 + e] = s; }
    __syncthreads();
    if (c.tid < 64) { int s = 0;
#pragma unroll
        for (int p = 0; p < 8; ++p) s += psum[p * 64 + c.tid];
        segcnt[c.tid] = s; }
    __syncthreads();
    if (c.tid < 64) { int s = 0; for (int e2 = 0; e2 < c.tid; ++e2) s += segcnt[e2]; segstart[c.tid] = s; }
    __syncthreads();
    if (c.blk == 0) {
        if (c.tid < 64) { SEG[c.tid * 2] = segstart[c.tid]; SEG[c.tid * 2 + 1] = segcnt[c.tid]; }
        if (c.tid == 64) { SEG[128] = NSLOT_R; SEG[129] = T; }
    }
    for (int vb = c.blk; vb < NVB; vb += c.G) {
        if (c.tid < 64) { const int e = c.tid, p = vb >> 5; int s = segstart[e];
            for (int p2 = 0; p2 < p; ++p2) s += psum[p2 * 64 + e];
            for (int v = p * 32; v < vb; ++v) s += BLKCNT[v * 64 + e];
            base[e] = s; }
        __syncthreads();
        { const int t = vb * 64 + (c.tid >> 3), k = c.tid & 7; const int pe = TOPE[t * 8 + k], e = pe & 255, lr = pe >> 8;
          const int slot = base[e] + lr;
          SLOTTOK[slot] = t; TOKSLOT[t * 8 + k] = slot; }
        __syncthreads();
    }
    if (c.blk < 256) {
        int* tpre = base + 64;
        __syncthreads();
        if (c.tid <= 65) { int sacc = 0; for (int e2 = 0; e2 < c.tid; ++e2) sacc += ((e2 < 64 ? segcnt[e2] : T) + 255) >> 8; tpre[c.tid] = sacc; }
        __syncthreads();
        const int ntile = tpre[65];
        if (c.blk == 0 && c.tid == 0) SEG[130] = ntile;
        int* UL = (int*)(a.ws + WS_ULIST);
        for (int v = 0; v < 2; ++v) { const int npn = v ? 4 : 2, nwg = ntile * npn;
            for (int i = 0; i < 48; ++i) { const int L = i * c.G + c.blk; if (L >= nwg) break;
                const int q = nwg / 8, r = nwg % 8, xcd = L % 8, off = L / 8; const int wgid = (xcd < r ? xcd * (q + 1) : r * (q + 1) + (xcd - r) * q) + off, tl = wgid / npn;
                if (c.tid < 65 && tpre[c.tid] <= tl && tl < tpre[c.tid + 1]) { const int e = c.tid, o2 = 256 * (tl - tpre[e]); const int st = e < 64 ? segstart[e] : NSLOT_R, cn = e < 64 ? segcnt[e] : T, rem = cn - o2;
                    int* u = UL + ((size_t)(v * 256 + c.blk) * 48 + i) * 4; u[0] = st + o2; u[1] = rem < 256 ? rem : 256; u[2] = wgid % npn; u[3] = e; } } }
    }
}

__device__ __forceinline__ void ph_combine(CArgs& a, const Ctx& c) {
    typedef float f32x2 __attribute__((ext_vector_type(2)));
    const unsigned char* Y = (const unsigned char*)(a.ws + WS_Y); const int* TOKSLOT = (const int*)(a.ws + WS_TOKSLOT); const float* MODS = (const float*)(a.ws + WS_MODS); const float* TOPW = (const float*)(a.ws + WS_TOPW);
    const int gw = c.blk * 8 + c.wave, NGW = c.G * 8;
    for (int t = gw; t < T; t += NGW) {
        const int b = t / NSEQ;
        float v[16];
#pragma unroll
        for (int j = 0; j < 16; ++j) v[j] = 0.f;
#pragma unroll
        for (int k = 0; k < 9; ++k) {
            const int r = (k < 8) ? TOKSLOT[t * 8 + k] : (NSLOT_R + t);
            const float wk = (k < 8) ? TOPW[t * 8 + k] : 1.f;
#pragma unroll
            for (int j = 0; j < 4; ++j) { const int w = *(const int*)(Y + (size_t)r * DM + 4 * c.lane + 256 * j);
                const f32x2 lo = __builtin_amdgcn_cvt_pk_f32_fp8(w, false), hi = __builtin_amdgcn_cvt_pk_f32_fp8(w, true);
                v[4 * j] = fmaf(wk, lo[0], v[4 * j]); v[4 * j + 1] = fmaf(wk, lo[1], v[4 * j + 1]); v[4 * j + 2] = fmaf(wk, hi[0], v[4 * j + 2]); v[4 * j + 3] = fmaf(wk, hi[1], v[4 * j + 3]); }
        }
        float ss = 0.f;
#pragma unroll
        for (int j = 0; j < 16; ++j) ss += v[j] * v[j];
        const float rs = rsqrtf(wave_sum(ss, c.lane) * (1.f / DM) + EPS);
        const float* md = MODS + (size_t)b * 6144 + 5120;
        const int lcol = 128 * ((c.lane & 3) >> 1) + 32 * (c.lane >> 4) + 8 * ((c.lane & 15) >> 2) + 4 * (c.lane & 1);
#pragma unroll
        for (int j = 0; j < 4; ++j) {
            const int col = lcol + 256 * j;
            const uint2 xw = *(const uint2*)((const bf16_t*)(a.ws + WS_X1B) + (size_t)t * DM + col); float4 x1; x1.x = bflo(xw.x); x1.y = bfhi(xw.x); x1.z = bflo(xw.y); x1.w = bfhi(xw.y);
            const float4 g = *(const float4*)(a.in[I_GPOSTFFN] + col), gf = *(const float4*)(md + col);
            x1.x += gf.x * (v[4 * j] * rs * g.x); x1.y += gf.y * (v[4 * j + 1] * rs * g.y); x1.z += gf.z * (v[4 * j + 2] * rs * g.z); x1.w += gf.w * (v[4 * j + 3] * rs * g.w);
            *(float4*)(a.out + (size_t)t * DM + col) = x1;
        }
    }
}

constexpr int LDS_TAB = 128 * 1024;
constexpr int LDS_OAN = 132 * 1024;
namespace pg8 {
typedef short bf16x8 __attribute__((ext_vector_type(8)));
typedef float f32x4 __attribute__((ext_vector_type(4)));
typedef unsigned u32x4 __attribute__((ext_vector_type(4)));
typedef unsigned u32x2 __attribute__((ext_vector_type(2)));
constexpr int BM = 256, BK = 64, HALF = 128, HTB = HALF * BK * 2, STAGE_BYTES = 8 * HTB;
__device__ __forceinline__ int lds_byte(int r, int c) { const int st = (r >> 4) * 2 + (c >> 5), rr = r & 15, cc = c & 31, ob = rr * 64 + cc * 2; return st * 1024 + (ob ^ (((ob >> 9) & 1) << 5)); }
__device__ __forceinline__ void stage_rc(int b, int& R, int& C) { const int st = b / 1024, sb = b % 1024, swz = sb ^ (((sb >> 9) & 1) << 5); R = (st >> 1) * 16 + swz / 64; C = (st & 1) * 32 + (swz % 64) / 2; }
__device__ __forceinline__ int perm32(int rho) { const int n = rho >> 4, i = rho & 15; return 8 * (i >> 2) + 4 * n + (i & 3); }
__device__ __forceinline__ int xcd_remap(int L, int nwg) { const int q = nwg / 8, r = nwg % 8, xcd = L % 8, off = L / 8; return (xcd < r ? xcd * (q + 1) : r * (q + 1) + (xcd - r) * q) + off; }
__device__ __forceinline__ unsigned cvt_pk_bf16(float lo, float hi) { unsigned r; asm volatile("v_cvt_pk_bf16_f32 %0, %1, %2" : "=v"(r) : "v"(lo), "v"(hi)); return r; }

struct Unit { int row0, nvalid, pn, aux, idx; };

template <class Epi, class Sched, bool ALIGN_EPI, int K, int REPK = 1>
__device__ __forceinline__ void gemm_phase(LAS unsigned char* lds, const Sched& S, const Epi& E, const int tid) {
    const int wid = __builtin_amdgcn_readfirstlane(tid >> 6), lane = tid & 63, wr = wid >> 2, wc = wid & 3, fr = lane & 15, fq = lane >> 4;
    constexpr int nt = K / BK;
    unsigned voffB[2];
#pragma unroll
    for (int i = 0; i < 2; ++i) { int R, C; stage_rc(tid * 16 + i * 8192, R, C); const int Rb = Epi::PERM ? ((R & ~31) + perm32(R & 31)) : R;
        voffB[i] = (unsigned)(Rb * K + C) * 2u; }
    LAS u32x4* const oAnL = (LAS u32x4*)(lds + LDS_OAN) + tid;
    const size_t kstep = (size_t)(BK * 2);
    const size_t hstepB = (size_t)HALF * K * 2;
    const unsigned ldsw = (unsigned)wid * 1024u;
    const int aoff = lds_byte(wr * 64 + fr, fq * 8), boff = lds_byte(wc * 32 + fr, fq * 8);
#define PG8_SA(b, h) (((b) * 2 + (h)) * HTB)
#define PG8_SB(b, h) ((4 + (b) * 2 + (h)) * HTB)
#define PG8_STAGE(bufoff, gbase, voff) do { _Pragma("unroll") for (int _i = 0; _i < 2; ++_i) \
        __builtin_amdgcn_global_load_lds((const unsigned*)((const char*)(gbase) + (voff)[_i]), (LAS unsigned*)(lds + (bufoff) + ldsw + _i * 8192), 16, 0, 0); } while (0)
#define PG8_LDA(dst, b, h) do { _Pragma("unroll") for (int m = 0; m < 4; ++m) _Pragma("unroll") for (int k = 0; k < 2; ++k) dst[m][k] = *(const LAS bf16x8*)(lds + PG8_SA(b, h) + aoff + m * 2048 + k * 1024); } while (0)
#define PG8_LDB(dst, b, h) do { _Pragma("unroll") for (int n = 0; n < 2; ++n) _Pragma("unroll") for (int k = 0; k < 2; ++k) dst[n][k] = *(const LAS bf16x8*)(lds + PG8_SB(b, h) + boff + n * 2048 + k * 1024); } while (0)
#define PG8_MMA(ai, bj, At, Bt) do { __builtin_amdgcn_s_setprio(1); _Pragma("unroll") for (int m = 0; m < 4; ++m) _Pragma("unroll") for (int n = 0; n < 2; ++n) _Pragma("unroll") for (int k = 0; k < 2; ++k) \
        acc[ai][bj][m][n] = __builtin_amdgcn_mfma_f32_16x16x32_bf16(Bt[n][k], At[m][k], acc[ai][bj][m][n], 0, 0, 0); __builtin_amdgcn_s_setprio(0); } while (0)
#define PG8_WAIT_V(n) asm volatile("s_waitcnt vmcnt(" #n ")" ::: "memory")
#define PG8_WAIT_L(n) asm volatile("s_waitcnt lgkmcnt(" #n ")" ::: "memory")
#define PG8_BAR __builtin_amdgcn_s_barrier()
#define PG8_SCHED __builtin_amdgcn_sched_barrier(0)
    Unit cur, nxt; int ui = 0;
    if (!S.next(0, cur)) return;
    f32x4 acc[2][2][4][2];
#pragma unroll
    for (int a = 0; a < 2; ++a)
#pragma unroll
        for (int b = 0; b < 2; ++b)
#pragma unroll
            for (int m = 0; m < 4; ++m)
#pragma unroll
                for (int n = 0; n < 2; ++n) acc[a][b][m][n] = (f32x4){0.f, 0.f, 0.f, 0.f};
    bf16x8 At[4][2], B0[2][2], B1[2][2];
    unsigned oAc[2][2];
    S.a_off(cur, tid, oAc);
    const char* const Ab = S.a_base();
    const char* cB = S.b_base(cur);
    PG8_STAGE(PG8_SB(0, 0), cB, voffB); PG8_STAGE(PG8_SB(0, 1), cB + hstepB, voffB); PG8_STAGE(PG8_SA(0, 0), Ab, oAc[0]); PG8_STAGE(PG8_SA(0, 1), Ab, oAc[1]);
    if (wr == 1) PG8_BAR;
    PG8_WAIT_V(2); PG8_BAR;
    PG8_STAGE(PG8_SB(1, 0), cB + kstep, voffB); PG8_STAGE(PG8_SA(1, 0), Ab + kstep, oAc[0]); PG8_STAGE(PG8_SB(1, 1), cB + hstepB + kstep, voffB);
    PG8_WAIT_V(6); PG8_BAR;
    for (;;) {
        const bool has_next = S.next(ui + 1, nxt);
        if (has_next) { unsigned t_[2][2]; S.a_off(nxt, tid, t_); *oAnL = (u32x4){t_[0][0], t_[0][1], t_[1][0], t_[1][1]}; }
        const char* nB = has_next ? S.b_base(nxt) : cB;
#pragma unroll 1
        for (int tt = 0; tt < nt * REPK; tt += 2) {
            const int t = (REPK == 1) ? tt : tt % nt;
            const bool wrap = (t == nt - 2), last = (tt == nt * REPK - 2);
            const char* a1 = Ab + (size_t)(t + 1) * kstep;
            const char* a2 = wrap ? Ab : Ab + (size_t)(t + 2) * kstep; const char* b2 = last ? nB : (wrap ? cB : cB + (size_t)(t + 2) * kstep);
            const char* a3 = a2 + kstep; const char* b3 = b2 + kstep;
            PG8_LDB(B0, 0, 0); PG8_LDB(B1, 0, 1); PG8_SCHED; PG8_LDA(At, 0, 0); PG8_STAGE(PG8_SA(1, 1), a1, oAc[1]);
            if (last && has_next) { const u32x4 q = *oAnL; oAc[0][0] = q.x; oAc[0][1] = q.y; oAc[1][0] = q.z; oAc[1][1] = q.w; }
            PG8_WAIT_V(8); PG8_WAIT_L(0); PG8_BAR; PG8_MMA(0, 0, At, B0); PG8_MMA(0, 1, At, B1); PG8_BAR; PG8_SCHED;
            PG8_LDA(At, 0, 1); PG8_STAGE(PG8_SB(0, 0), b2, voffB); PG8_STAGE(PG8_SB(0, 1), b2 + hstepB, voffB); PG8_STAGE(PG8_SA(0, 0), a2, oAc[0]);
            PG8_WAIT_V(8); PG8_WAIT_L(0); PG8_BAR; PG8_MMA(1, 0, At, B0); PG8_MMA(1, 1, At, B1); PG8_BAR; PG8_SCHED;
            PG8_LDB(B0, 1, 0); PG8_LDB(B1, 1, 1); PG8_SCHED; PG8_LDA(At, 1, 0); PG8_STAGE(PG8_SA(0, 1), a2, oAc[1]);
            PG8_WAIT_V(8); PG8_WAIT_L(0); PG8_BAR; PG8_MMA(0, 0, At, B0); PG8_MMA(0, 1, At, B1); PG8_BAR; PG8_SCHED;
            PG8_LDA(At, 1, 1); PG8_STAGE(PG8_SB(1, 0), b3, voffB); PG8_STAGE(PG8_SB(1, 1), b3 + hstepB, voffB); PG8_STAGE(PG8_SA(1, 0), a3, oAc[0]);
            PG8_WAIT_V(8); PG8_WAIT_L(0); PG8_BAR; PG8_MMA(1, 0, At, B0); PG8_MMA(1, 1, At, B1); PG8_BAR; PG8_SCHED;
        }
        if constexpr (ALIGN_EPI) { if (wr == 0) PG8_BAR; }
        if constexpr (REPK > 1) {
#pragma unroll
            for (int a = 0; a < 2; ++a)
#pragma unroll
                for (int b = 0; b < 2; ++b)
#pragma unroll
                    for (int m = 0; m < 4; ++m)
#pragma unroll
                        for (int n = 0; n < 2; ++n) acc[a][b][m][n] *= (1.f / REPK); }
        E(acc, cur, wr, wc, fr, fq);
        if (!has_next) break;
#pragma unroll
        for (int a = 0; a < 2; ++a)
#pragma unroll
            for (int b = 0; b < 2; ++b)
#pragma unroll
                for (int m = 0; m < 4; ++m)
#pragma unroll
                    for (int n = 0; n < 2; ++n) acc[a][b][m][n] = (f32x4){0.f, 0.f, 0.f, 0.f};
        cur = nxt; cB = nB; ++ui;
        if constexpr (ALIGN_EPI) { if (wr == 1) PG8_BAR; }
    }
    PG8_WAIT_V(0);
    if constexpr (!ALIGN_EPI) { if (wr == 0) PG8_BAR; }
    PG8_BAR;
#undef PG8_SA
#undef PG8_SB
#undef PG8_STAGE
#undef PG8_LDA
#undef PG8_LDB
#undef PG8_MMA
#undef PG8_WAIT_V
#undef PG8_WAIT_L
#undef PG8_BAR
#undef PG8_SCHED
}

struct DenseSched {
    const char* A; const char* Bt; int nN, nwg, G, c, nmain;
    __device__ __forceinline__ bool next(int i, Unit& u) const {
        const int L = i * G + c; if (L >= nwg) return false;
        const int wgid = xcd_remap(L, nwg);
        if (wgid < nmain) { const int nig = 8 * nN, gid = wgid / nig, w = wgid % nig; u.row0 = 256 * (gid * 8 + (w % 8)); u.pn = w / 8; }
        else { const int j = wgid - nmain; u.row0 = T + 256 * (j >> 2); u.pn = 2 + (j & 3); }
        u.nvalid = 256; u.aux = 0; u.idx = i; return true;
    }
    __device__ __forceinline__ const char* a_base() const { return A; }
    __device__ __forceinline__ const char* b_base(const Unit& u) const { return Bt + (size_t)u.pn * 256 * DM * 2; }
    __device__ __forceinline__ void a_off(const Unit& u, int tid, unsigned (&o)[2][2]) const {
#pragma unroll
        for (int i = 0; i < 2; ++i) { int R, C; stage_rc(tid * 16 + i * 8192, R, C);
#pragma unroll
            for (int h = 0; h < 2; ++h) o[h][i] = (unsigned)((u.row0 + 128 * h + R) * DM + C) * 2u; }
    }
};
constexpr int GT_MAXSEG = 132, GT_ULIST = 768, GT_MAXU = 48;
struct GroupedSched {
    const char* A; const char* Bt; const int* slottok; const LAS int* tab; int nseg, npn, nwg, G, c, K, brows; const LAS int* tokl;
    __device__ __forceinline__ bool next(int i, Unit& u) const {
        const int L = i * G + c; if (L >= nwg) return false;
        u.idx = i;
        if (i < GT_MAXU) { const LAS int* q = tab + GT_ULIST + 4 * i; u.row0 = q[0]; u.nvalid = q[1]; u.pn = q[2]; u.aux = q[3]; return true; }
        const int wgid = xcd_remap(L, nwg), tl = wgid / npn; u.pn = wgid % npn;
        int s = 0; while (tab[s + 1] <= tl) ++s;
        const int off = 256 * (tl - tab[s]);
        u.row0 = tab[GT_MAXSEG + s] + off; const int rem = tab[2 * GT_MAXSEG + s] - off; u.nvalid = rem < 256 ? rem : 256; u.aux = tab[3 * GT_MAXSEG + s];
        return true;
    }
    __device__ __forceinline__ const char* a_base() const { return A; }
    __device__ __forceinline__ const char* b_base(const Unit& u) const { return Bt + ((size_t)u.aux * brows + (size_t)u.pn * 256) * K * 2; }
    __device__ __forceinline__ void a_off(const Unit& u, int tid, unsigned (&o)[2][2]) const {
#pragma unroll
        for (int i = 0; i < 2; ++i) { int R, C; stage_rc(tid * 16 + i * 8192, R, C);
#pragma unroll
            for (int h = 0; h < 2; ++h) {
                int r = 128 * h + R;
                if (slottok) { int tok; if (u.idx < 8) tok = tokl[u.idx * 256 + r];
                    else { if (r >= u.nvalid) r = u.nvalid - 1; const int slot = u.row0 + r; tok = (u.aux < 64) ? slottok[slot] : slot - NSLOT_R; }
                    o[h][i] = (unsigned)(tok * K + C) * 2u; }
                else o[h][i] = (unsigned)((u.row0 + r) * K + C) * 2u;
            } }
    }
};
__device__ __forceinline__ int grouped_table(LAS int* tab, const int* SEG, const int tid) {
    constexpr int nseg = 65;
    if (tid < nseg) { const int e = tid; const int st = SEG[e * 2], cn = SEG[e * 2 + 1];
        tab[GT_MAXSEG + tid] = st; tab[2 * GT_MAXSEG + tid] = cn; tab[3 * GT_MAXSEG + tid] = e; tab[4 * GT_MAXSEG + tid] = (cn + 255) >> 8; }
    __syncthreads();
    if (tid <= nseg) { int s = 0; for (int j = 0; j < tid; ++j) s += tab[4 * GT_MAXSEG + j]; tab[tid] = s; }
    __syncthreads();
    return tab[nseg];
}

__device__ __forceinline__ void grouped_units(LAS int* tab, int npn, int nwg, int G, int c, const int tid) {
    constexpr int nseg = 65;
    for (int i = 0; i < GT_MAXU; ++i) { const int L = i * G + c; if (L >= nwg) break;
        const int wgid = xcd_remap(L, nwg), tl = wgid / npn;
        if (tid < nseg && tab[tid] <= tl && tl < tab[tid + 1]) { const int off = 256 * (tl - tab[tid]); const int rem = tab[2 * GT_MAXSEG + tid] - off;
            LAS int* q = tab + GT_ULIST + 4 * i; q[0] = tab[GT_MAXSEG + tid] + off; q[1] = rem < 256 ? rem : 256; q[2] = wgid % npn; q[3] = tab[3 * GT_MAXSEG + tid]; } }
    __syncthreads();
}

struct EpiStore {
    static constexpr bool PERM = true;
    bf16_t* C; int ldc; int rowsub, rowsub_sh;
    __device__ __forceinline__ void operator()(const f32x4 (&acc)[2][2][4][2], const Unit& u, int wr, int wc, int fr, int fq) const {
        const int col0 = u.pn * 256 + wc * 32 + 8 * fq, crow0 = u.row0 - (u.aux < 64 ? rowsub : rowsub_sh);
        int rb = wr * 64 + fr; asm volatile("" : "+v"(rb));
#pragma unroll
        for (int ai = 0; ai < 2; ++ai)
#pragma unroll
            for (int m = 0; m < 4; ++m) { const int r = ai * 128 + m * 16 + rb;
                if (r < u.nvalid) { bf16_t* rowp = C + (size_t)(crow0 + r) * ldc + col0;
#pragma unroll
                    for (int bj = 0; bj < 2; ++bj) { const f32x4 v0 = acc[ai][bj][m][0], v1 = acc[ai][bj][m][1];
                        u32x4 w; w.x = cvt_pk_bf16(v0[0], v0[1]); w.y = cvt_pk_bf16(v0[2], v0[3]); w.z = cvt_pk_bf16(v1[0], v1[1]); w.w = cvt_pk_bf16(v1[2], v1[3]);
                        *(u32x4*)(rowp + bj * 128) = w; } } }
    }
};
struct EpiStoreFp8 {
    static constexpr bool PERM = true;
    unsigned char* C;
    __device__ __forceinline__ void operator()(const f32x4 (&acc)[2][2][4][2], const Unit& u, int wr, int wc, int fr, int fq) const {
        const int col0 = u.pn * 256 + wc * 64 + 16 * fq;
        int rb = wr * 64 + fr; asm volatile("" : "+v"(rb));
#pragma unroll
        for (int ai = 0; ai < 2; ++ai)
#pragma unroll
            for (int m = 0; m < 4; ++m) { const int r = ai * 128 + m * 16 + rb;
                if (r < u.nvalid) { u32x4 w;
#pragma unroll
                    for (int bj = 0; bj < 2; ++bj) { const f32x4 v0 = acc[ai][bj][m][0], v1 = acc[ai][bj][m][1];
                        int w0 = __builtin_amdgcn_cvt_pk_fp8_f32(v0[0], v0[1], 0, false); w0 = __builtin_amdgcn_cvt_pk_fp8_f32(v0[2], v0[3], w0, true);
                        int w1 = __builtin_amdgcn_cvt_pk_fp8_f32(v1[0], v1[1], 0, false); w1 = __builtin_amdgcn_cvt_pk_fp8_f32(v1[2], v1[3], w1, true);
                        if (bj == 0) { w.x = (unsigned)w0; w.y = (unsigned)w1; } else { w.z = (unsigned)w0; w.w = (unsigned)w1; } }
                    *(u32x4*)(C + (size_t)(u.row0 + r) * DM + col0) = w; } }
    }
};
struct EpiGateUp {
    static constexpr bool PERM = true;
    bf16_t* ACT;
    __device__ __forceinline__ void operator()(const f32x4 (&acc)[2][2][4][2], const Unit& u, int wr, int wc, int fr, int fq) const {
        const int col0 = u.pn * 128 + wc * 32 + 8 * fq;
        int rb = wr * 64 + fr; asm volatile("" : "+v"(rb));
#pragma unroll
        for (int ai = 0; ai < 2; ++ai)
#pragma unroll
            for (int m = 0; m < 4; ++m) { const int r = ai * 128 + m * 16 + rb;
                if (r < u.nvalid) { const int slot = u.row0 + r;
                    float o[8];
#pragma unroll
                    for (int n = 0; n < 2; ++n)
#pragma unroll
                        for (int i = 0; i < 4; ++i) { const float g = acc[ai][0][m][n][i], up = acc[ai][1][m][n][i]; o[4 * n + i] = g / (1.f + __expf(-g)) * up; }
                    u32x4 pk; pk.x = cvt_pk_bf16(o[0], o[1]); pk.y = cvt_pk_bf16(o[2], o[3]); pk.z = cvt_pk_bf16(o[4], o[5]); pk.w = cvt_pk_bf16(o[6], o[7]);
                    *(u32x4*)(ACT + (size_t)slot * FF + col0) = pk; } }
    }
};
constexpr float QSCALE = 0.125f * 1.4426950408889634f;
struct EpiInProj {
    static constexpr bool PERM = false;
    bf16_t *Q, *Kb, *Vb, *P; const LAS float* rope;
    __device__ __forceinline__ void operator()(const f32x4 (&acc)[2][2][4][2], const Unit& u, int wr, int wc, int fr, int fq) const {
        const bool latent = u.row0 < T; const int sec = u.pn >> 1;
        const bool dorope = latent && sec < 2;
        bf16_t* dstU; int n0 = 0;
        if (latent) { const int b = u.row0 / NSEQ; n0 = u.row0 % NSEQ; const size_t kvrow = (size_t)b * SKV + CTXL + n0;
            dstU = sec == 0 ? Q + (size_t)u.row0 * AW : sec == 1 ? Kb + kvrow * AW : sec == 2 ? Vb + kvrow * AW : P + (size_t)u.row0 * PW; }
        else { const int b = (u.row0 - T) / CTXL; dstU = (sec == 1 ? Kb : Vb) + (size_t)b * SKV * AW; }
        dstU += (u.pn & 1) * 256;
        int rb = wr * 64 + fr; asm volatile("" : "+v"(rb));
        const int lcol = wc * 32 + 4 * fq;
#pragma unroll
        for (int ai = 0; ai < 2; ++ai)
#pragma unroll
            for (int m = 0; m < 4; ++m) {
                const int r = ai * 128 + m * 16 + rb;
                f32x4 c4 = (f32x4){1.f, 1.f, 1.f, 1.f}, s4 = (f32x4){0.f, 0.f, 0.f, 0.f};
                if (dorope) { const int pos = (wc & 1) ? (r & 63) : ((n0 >> 6) + (r >> 6)); const LAS float* rp = rope + (pos * 16 + 4 * fq) * 2;
                    const f32x4 cs0 = *(const LAS f32x4*)rp, cs1 = *(const LAS f32x4*)(rp + 4); c4 = (f32x4){cs0[0], cs0[2], cs1[0], cs1[2]}; s4 = (f32x4){cs0[1], cs0[3], cs1[1], cs1[3]}; }
                bf16_t* dst = dstU + r * 512 + lcol;
#pragma unroll
                for (int bj = 0; bj < 2; ++bj) {
                    const f32x4 x1 = acc[ai][bj][m][0], x2 = acc[ai][bj][m][1];
                    f32x4 o1 = x1 * c4 - x2 * s4, o2 = x2 * c4 + x1 * s4;
                    if (sec == 0) { o1 *= QSCALE; o2 *= QSCALE; }
                    u32x2 w1, w2; w1.x = cvt_pk_bf16(o1[0], o1[1]); w1.y = cvt_pk_bf16(o1[2], o1[3]); w2.x = cvt_pk_bf16(o2[0], o2[1]); w2.y = cvt_pk_bf16(o2[2], o2[3]);
                    *(u32x2*)(dst + bj * 128) = w1; *(u32x2*)(dst + bj * 128 + 16) = w2;
                }
            }
    }
};
}

__device__ __forceinline__ void ph_inproj_fast(CArgs& a, const Ctx& c) {
    pg8::DenseSched S{(const char*)(a.ws + WS_HX), (const char*)(a.ws + WS_WIN), 8, 528, c.G, c.blk, 512};
    LAS float* ropeL = (LAS float*)((LAS unsigned char*)c.lds + LDS_ROPE);
    { const float4 v = *(const float4*)((const float*)(a.ws + WS_ROPE) + 4 * c.tid); ropeL[4 * c.tid] = v.x; ropeL[4 * c.tid + 1] = v.y; ropeL[4 * c.tid + 2] = v.z; ropeL[4 * c.tid + 3] = v.w; }
    __syncthreads();
    pg8::EpiInProj E{(bf16_t*)(a.ws + WS_Q), (bf16_t*)(a.ws + WS_K), (bf16_t*)(a.ws + WS_V), (bf16_t*)(a.ws + WS_P), ropeL};
    pg8::gemm_phase<pg8::EpiInProj, pg8::DenseSched, true, DM>((LAS unsigned char*)c.lds, S, E, c.tid);
    { constexpr int NWG = 528; const int maxu = (NWG + c.G - 1) / c.G, nlast = NWG - (maxu - 1) * c.G;
      if (nlast < c.G) { if (c.blk >= nlast) { __syncthreads(); ph_transposes(a, c, TR_NIT - TR_NFILL, TR_NIT, (c.blk - nlast) * 8 + c.wave, (c.G - nlast) * 8); } }
      else ph_transposes(a, c, TR_NIT - TR_NFILL, TR_NIT, c.blk * 8 + c.wave, c.G * 8); }
}
__device__ __forceinline__ void ph_outproj_fast(CArgs& a, const Ctx& c) {
    pg8::DenseSched S{(const char*)(a.ws + WS_ATT), (const char*)(a.ws + WS_WOUT), 4, 256, c.G, c.blk, 256};
    pg8::EpiStore E{(bf16_t*)(a.ws + WS_YX), DM, 0, 0};
    pg8::gemm_phase<pg8::EpiStore, pg8::DenseSched, true, DM>((LAS unsigned char*)c.lds, S, E, c.tid);
}
__device__ __forceinline__ void ph_gateup_fast(CArgs& a, const Ctx& c) {
    LAS int* tab = (LAS int*)((LAS unsigned char*)c.lds + LDS_TAB);
    const int ntile = ((const int*)(a.ws + WS_SEG))[130];
    if ((ntile * 2 + c.G - 1) / c.G > pg8::GT_MAXU || c.blk >= 256) { pg8::grouped_table(tab, (const int*)(a.ws + WS_SEG), c.tid); pg8::grouped_units(tab, 2, ntile * 2, c.G, c.blk, c.tid); }
    else { if (c.tid < 48) { const uint4 q_ = *((const uint4*)(a.ws + WS_ULIST) + (size_t)(0 * 256 + c.blk) * 48 + c.tid); LAS int* d_ = tab + pg8::GT_ULIST + 4 * c.tid; d_[0] = (int)q_.x; d_[1] = (int)q_.y; d_[2] = (int)q_.z; d_[3] = (int)q_.w; } __syncthreads(); }
    LAS int* tokl = (LAS int*)((LAS unsigned char*)c.lds + LDS_TOKL);
    { const int* SLOTTOK = (const int*)(a.ws + WS_SLOTTOK);
      for (int q = c.tid; q < 8 * 256; q += 512) { const int i = q >> 8, r = q & 255;
          if (i * c.G + c.blk < ntile * 2) { const LAS int* ul = tab + pg8::GT_ULIST + 4 * i; const int row0 = ul[0], nv = ul[1], e = ul[3];
              const int slot = row0 + (r < nv ? r : nv - 1); tokl[q] = (e < 64) ? SLOTTOK[slot] : slot - NSLOT_R; } }
      __syncthreads(); }
    pg8::GroupedSched S{(const char*)(a.ws + WS_HX), (const char*)(a.ws + WS_WGU), (const int*)(a.ws + WS_SLOTTOK), tab, 65, 2, ntile * 2, c.G, c.blk, DM, 512, tokl};
    pg8::EpiGateUp E{(bf16_t*)(a.ws + WS_ACT)};
    pg8::gemm_phase<pg8::EpiGateUp, pg8::GroupedSched, true, DM, REPK_GU>((LAS unsigned char*)c.lds, S, E, c.tid);
}
__device__ __forceinline__ void ph_down_fast(CArgs& a, const Ctx& c) {
    LAS int* tab = (LAS int*)((LAS unsigned char*)c.lds + LDS_TAB);
    const int ntile = ((const int*)(a.ws + WS_SEG))[130];
    if ((ntile * 4 + c.G - 1) / c.G > pg8::GT_MAXU || c.blk >= 256) { pg8::grouped_table(tab, (const int*)(a.ws + WS_SEG), c.tid); pg8::grouped_units(tab, 4, ntile * 4, c.G, c.blk, c.tid); }
    else { if (c.tid < 48) { const uint4 q_ = *((const uint4*)(a.ws + WS_ULIST) + (size_t)(1 * 256 + c.blk) * 48 + c.tid); LAS int* d_ = tab + pg8::GT_ULIST + 4 * c.tid; d_[0] = (int)q_.x; d_[1] = (int)q_.y; d_[2] = (int)q_.z; d_[3] = (int)q_.w; } __syncthreads(); }
    pg8::GroupedSched S{(const char*)(a.ws + WS_ACT), (const char*)(a.ws + WS_WD), nullptr, tab, 65, 4, ntile * 4, c.G, c.blk, FF, DM, nullptr};
    pg8::EpiStoreFp8 E{(unsigned char*)(a.ws + WS_Y)};
    pg8::gemm_phase<pg8::EpiStoreFp8, pg8::GroupedSched, true, FF, REPK_DOWN>((LAS unsigned char*)c.lds, S, E, c.tid);
}

namespace att {
using bf16x8 = __attribute__((ext_vector_type(8))) short;
using s16x4  = __attribute__((ext_vector_type(4))) short;
using f32x16 = __attribute__((ext_vector_type(16))) float;
using u32x4  = __attribute__((ext_vector_type(4))) unsigned;
constexpr int KVBLK = 64, LDK = 512;
constexpr float SCALE = 0.125f, THR = 8.f;
constexpr int SHM_V = KVBLK * 128 * 2, SHM_K = KVBLK * 128 * 2, NBUF = 3, OFF_WS = NBUF * (SHM_V + SHM_K);
#define KSWZ(row, colB) ((row) * 256 + ((colB) ^ (((row) & 7) << 4)))
#define SBAR() __builtin_amdgcn_sched_barrier(0)
__device__ __forceinline__ int crow(int r, int hi) { return (r & 3) + 8 * (r >> 2) + 4 * hi; }
__device__ __forceinline__ unsigned cvtpk(float lo, float hi) { unsigned r; asm volatile("v_cvt_pk_bf16_f32 %0, %1, %2" : "=v"(r) : "v"(lo), "v"(hi)); return r; }
__device__ __forceinline__ float max3f(float a, float b, float c) { return __builtin_fmaxf(__builtin_fmaxf(a, b), c); }
__device__ __forceinline__ void partialSM(f32x16& p0, f32x16& p1, f32x16& negm, const bool first, float& alpha) {
  constexpr float THR2 = THR * 1.4426950408889634f;
  float a = max3f(p0[0], p0[1], p1[0]), b = max3f(p0[2], p0[3], p1[1]); a = max3f(a, p1[2], p1[3]);
#pragma unroll
  for (int r = 4; r < 16; r += 4) { a = max3f(a, p0[r], p0[r + 1]); b = max3f(b, p0[r + 2], p0[r + 3]); a = max3f(a, p1[r], p1[r + 1]); b = max3f(b, p1[r + 2], p1[r + 3]); }
  float pmax = fmaxf(a, b);
  { auto rr = __builtin_amdgcn_permlane32_swap(__float_as_uint(pmax), __float_as_uint(pmax), false, false);
    pmax = fmaxf(__uint_as_float(rr[0]), __uint_as_float(rr[1])); }
  if (__builtin_expect(!first && __all(pmax <= THR2), 1)) { alpha = 1.f; }
  else { const float delta = first ? pmax : fmaxf(pmax, 0.f); alpha = __builtin_amdgcn_exp2f(-delta);
#pragma unroll
    for (int r = 0; r < 16; ++r) { p0[r] -= delta; p1[r] -= delta; negm[r] -= delta; } }
#pragma unroll
  for (int r = 0; r < 16; ++r) p0[r] = __builtin_amdgcn_exp2f(p0[r]);
}
__device__ __forceinline__ void finishSM(f32x16& p0, f32x16& p1, float alpha, float& l_reg, bf16x8& pa0, bf16x8& pa1, bf16x8& pa2, bf16x8& pa3) {
#pragma unroll
  for (int r = 0; r < 16; ++r) p1[r] = __builtin_amdgcn_exp2f(p1[r]);
  float ps = 0;
#pragma unroll
  for (int r = 0; r < 16; ++r) ps += p0[r];
#pragma unroll
  for (int r = 0; r < 16; ++r) ps += p1[r];
  { auto rr = __builtin_amdgcn_permlane32_swap(__float_as_uint(ps), __float_as_uint(ps), false, false);
    ps = __uint_as_float(rr[0]) + __uint_as_float(rr[1]); }
  l_reg = l_reg * alpha + ps;
#define PK4(P, BASE, OUT) do { unsigned a0 = cvtpk(P[BASE + 0], P[BASE + 1]), a1 = cvtpk(P[BASE + 2], P[BASE + 3]);   \
    unsigned b0 = cvtpk(P[BASE + 4], P[BASE + 5]), b1 = cvtpk(P[BASE + 6], P[BASE + 7]);                              \
    auto r0 = __builtin_amdgcn_permlane32_swap(a0, b0, false, false); auto r1 = __builtin_amdgcn_permlane32_swap(a1, b1, false, false); \
    u32x4 w = {r0[0], r1[0], r0[1], r1[1]}; OUT = *reinterpret_cast<bf16x8*>(&w); } while (0)
  PK4(p0, 0, pa0); PK4(p0, 8, pa1); PK4(p1, 0, pa2); PK4(p1, 8, pa3);
#undef PK4
}
__device__ __forceinline__ void qkt(f32x16& p0, f32x16& p1, const char* Ks, const bf16x8* qr, int r32, int hi, int mcol, const f32x16& negm) {
  p0 = negm; p1 = negm;
#pragma unroll
  for (int d0 = 0; d0 < 4; ++d0) { const int cb = (mcol + d0 * 16 + hi * 8) * 2;
    const bf16x8 b0 = *reinterpret_cast<const bf16x8*>(Ks + KSWZ(r32, cb));
    const bf16x8 b1 = *reinterpret_cast<const bf16x8*>(Ks + KSWZ(32 + r32, cb));
    p0 = __builtin_amdgcn_mfma_f32_32x32x16_bf16(b0, qr[d0], p0, 0, 0, 0);
    p1 = __builtin_amdgcn_mfma_f32_32x32x16_bf16(b1, qr[d0], p1, 0, 0, 0); }
}
__device__ __forceinline__ int v_st(int k, int c) { const int kk = (k & ~0xC) | ((k & 4) << 1) | ((k & 8) >> 1); return ((kk >> 3) * 4 + (c >> 5)) * 512 + ((kk & 7) * 32 + (c & 31)) * 2; }
__device__ __forceinline__ int v_rd_base(int lane) { return ((lane & 3) << 3) | (((lane >> 2) & 3) << 6) | (((lane >> 4) & 1) << 5) | (((lane >> 5) & 1) << 8); }
constexpr int v_rd_off(int d0, int ks, int half) { return d0 * 512 + ks * 4096 + half * 2048; }
template <int OFF> __device__ __forceinline__ s16x4 tr_read(int vb) {
  s16x4 r; asm volatile("ds_read_b64_tr_b16 %0, %1 offset:%2" : "=&v"(r) : "v"(vb), "i"(OFF) : "memory"); return r;
}
template <int D0> __device__ __forceinline__ void pv_one(f32x16& od, int vb, bf16x8 pa0, bf16x8 pa1, bf16x8 pa2, bf16x8 pa3) {
  const s16x4 l0 = tr_read<v_rd_off(D0, 0, 0)>(vb), h0 = tr_read<v_rd_off(D0, 0, 1)>(vb), l1 = tr_read<v_rd_off(D0, 1, 0)>(vb), h1 = tr_read<v_rd_off(D0, 1, 1)>(vb);
  const s16x4 l2 = tr_read<v_rd_off(D0, 2, 0)>(vb), h2 = tr_read<v_rd_off(D0, 2, 1)>(vb), l3 = tr_read<v_rd_off(D0, 3, 0)>(vb), h3 = tr_read<v_rd_off(D0, 3, 1)>(vb);
  asm volatile("s_waitcnt lgkmcnt(0)" ::: "memory"); SBAR();
#define PK(L, H) (bf16x8){L[0], L[1], L[2], L[3], H[0], H[1], H[2], H[3]}
  od = __builtin_amdgcn_mfma_f32_32x32x16_bf16(pa0, PK(l0, h0), od, 0, 0, 0);
  od = __builtin_amdgcn_mfma_f32_32x32x16_bf16(pa1, PK(l1, h1), od, 0, 0, 0);
  od = __builtin_amdgcn_mfma_f32_32x32x16_bf16(pa2, PK(l2, h2), od, 0, 0, 0);
  od = __builtin_amdgcn_mfma_f32_32x32x16_bf16(pa3, PK(l3, h3), od, 0, 0, 0);
#undef PK
}
__device__ __forceinline__ void pv_d0(f32x16* o, int vb, bf16x8 pa0, bf16x8 pa1, bf16x8 pa2, bf16x8 pa3) {
  pv_one<0>(o[0], vb, pa0, pa1, pa2, pa3); pv_one<1>(o[1], vb, pa0, pa1, pa2, pa3); pv_one<2>(o[2], vb, pa0, pa1, pa2, pa3); pv_one<3>(o[3], vb, pa0, pa1, pa2, pa3);
}
__device__ __forceinline__ void pv_sm(f32x16* o, int vb, bf16x8 pa0, bf16x8 pa1, bf16x8 pa2, bf16x8 pa3, f32x16& p0, f32x16& p1, f32x16& negm, float& alpha) {
  constexpr float THR2 = THR * 1.4426950408889634f;
  pv_one<0>(o[0], vb, pa0, pa1, pa2, pa3);
  float a = max3f(p0[0], p0[1], p1[0]), b = max3f(p0[2], p0[3], p1[1]); a = max3f(a, p1[2], p1[3]);
#pragma unroll
  for (int r = 4; r < 16; r += 4) { a = max3f(a, p0[r], p0[r + 1]); b = max3f(b, p0[r + 2], p0[r + 3]); a = max3f(a, p1[r], p1[r + 1]); b = max3f(b, p1[r + 2], p1[r + 3]); }
  float pmax = fmaxf(a, b);
  pv_one<1>(o[1], vb, pa0, pa1, pa2, pa3);
  { auto rr = __builtin_amdgcn_permlane32_swap(__float_as_uint(pmax), __float_as_uint(pmax), false, false);
    pmax = fmaxf(__uint_as_float(rr[0]), __uint_as_float(rr[1])); }
  if (__builtin_expect(__all(pmax <= THR2), 1)) { alpha = 1.f; }
  else { const float delta = fmaxf(pmax, 0.f); alpha = __builtin_amdgcn_exp2f(-delta);
#pragma unroll
    for (int r = 0; r < 16; ++r) { p0[r] -= delta; p1[r] -= delta; negm[r] -= delta; } }
  pv_one<2>(o[2], vb, pa0, pa1, pa2, pa3);
#pragma unroll
  for (int r = 0; r < 8; ++r) p0[r] = __builtin_amdgcn_exp2f(p0[r]);
  pv_one<3>(o[3], vb, pa0, pa1, pa2, pa3);
#pragma unroll
  for (int r = 8; r < 16; ++r) p0[r] = __builtin_amdgcn_exp2f(p0[r]);
}
__device__ __forceinline__ void unit(const bf16_t* __restrict__ Qb, const bf16_t* __restrict__ Kh, const bf16_t* __restrict__ Vh, bf16_t* __restrict__ Ob,
                                     const float lam, const float* __restrict__ gsub, char* lds, const int tid) {
  const int wid = __builtin_amdgcn_readfirstlane(tid >> 6), lane = tid & 63, r32 = lane & 31, hi = lane >> 5, qsub = wid & 3, map = wid >> 2, mcol = map * 64;
  char* V_lds = lds; char* K_lds = lds + NBUF * SHM_V;
  float* ws = (float*)(lds + OFF_WS) + wid * 64; float* li_l = ws; float* al_l = ws + 32;
  float l_reg = 0; f32x16 o[4] = {}; f32x16 negm = {}; bf16x8 qr[4];
  const bf16_t* Qw = Qb + (size_t)(qsub * 32 + r32) * AW + mcol + hi * 8;
#pragma unroll
  for (int d0 = 0; d0 < 4; ++d0) qr[d0] = *reinterpret_cast<const bf16x8*>(Qw + d0 * 16);
  const int sr = tid >> 4, sc = (tid & 15) * 8, vst0 = v_st(sr, sc), vst1 = v_st(32 + sr, sc);
  const int vb0 = (int)(uintptr_t)V_lds + v_rd_base(lane);
  struct { bf16x8 vs0, vs1, ks0, ks1; } sr_[1];
#define SLOAD(i, k0) do { sr_[i].vs0 = *reinterpret_cast<const bf16x8*>(&Vh[(size_t)((k0) + sr) * LDK + sc]); sr_[i].vs1 = *reinterpret_cast<const bf16x8*>(&Vh[(size_t)((k0) + 32 + sr) * LDK + sc]); \
    sr_[i].ks0 = *reinterpret_cast<const bf16x8*>(&Kh[(size_t)((k0) + sr) * LDK + sc]); sr_[i].ks1 = *reinterpret_cast<const bf16x8*>(&Kh[(size_t)((k0) + 32 + sr) * LDK + sc]); } while (0)
#define SWRITE(b, i) do { *(bf16x8*)(V_lds + (b) * SHM_V + vst0) = sr_[i].vs0; *(bf16x8*)(V_lds + (b) * SHM_V + vst1) = sr_[i].vs1; const int kc = sc * 2; \
    *(bf16x8*)(K_lds + (b) * SHM_K + KSWZ(sr, kc)) = sr_[i].ks0; *(bf16x8*)(K_lds + (b) * SHM_K + KSWZ(32 + sr, kc)) = sr_[i].ks1; } while (0)
#define SWAIT() asm volatile("s_waitcnt vmcnt(0)" ::: "memory")
#define RESC(a) do { if (__any((a) < 1.f)) { if (hi == 0) al_l[r32] = (a); asm volatile("s_waitcnt lgkmcnt(0)" ::: "memory"); \
    _Pragma("unroll") for (int d = 0; d < 4; ++d) _Pragma("unroll") for (int r = 0; r < 16; ++r) o[d][r] *= al_l[crow(r, hi)]; } } while (0)
  f32x16 pA0, pA1, pB0, pB1; float alA, alB; bf16x8 pa0, pa1, pa2, pa3; constexpr int NT = SKV / KVBLK;
  SLOAD(0, 0); asm volatile("s_waitcnt vmcnt(0)" ::: "memory"); SWRITE(0, 0); __syncthreads();
  qkt(pA0, pA1, K_lds, qr, r32, hi, mcol, negm); partialSM(pA0, pA1, negm, true, alA);
  SLOAD(0, KVBLK);
  SWAIT(); SWRITE(1, 0); __syncthreads();
  int sp = 0, scur = 1, sn = 2;
#define ASTEP(X0, X1, ALX, Y0, Y1, ALY, jj, LOADNEXT) do { \
    SBAR(); qkt(X0, X1, K_lds + scur * SHM_K, qr, r32, hi, mcol, negm); \
    finishSM(Y0, Y1, ALY, l_reg, pa0, pa1, pa2, pa3); SBAR(); \
    if (LOADNEXT) SLOAD(0, ((jj) + 1) * KVBLK); SBAR(); \
    pv_sm(o, vb0 + sp * SHM_V, pa0, pa1, pa2, pa3, X0, X1, negm, ALX); \
    if (LOADNEXT) { SWAIT(); SWRITE(sn, 0); } \
    RESC(ALX); __syncthreads(); \
    { const int t_ = sp; sp = scur; scur = sn; sn = t_; } } while (0)
  for (int j = 1; j + 1 < NT; j += 2) {
    ASTEP(pB0, pB1, alB, pA0, pA1, alA, j, true);
    ASTEP(pA0, pA1, alA, pB0, pB1, alB, j + 1, true);
  }
  ASTEP(pB0, pB1, alB, pA0, pA1, alA, NT - 1, false);
#undef ASTEP
  finishSM(pB0, pB1, alB, l_reg, pa0, pa1, pa2, pa3); SBAR();
  pv_d0(o, vb0 + sp * SHM_V, pa0, pa1, pa2, pa3);
  if (hi == 0) li_l[r32] = l_reg; asm volatile("s_waitcnt lgkmcnt(0)" ::: "memory");
  float rli[16];
#pragma unroll
  for (int r = 0; r < 16; ++r) rli[r] = __builtin_amdgcn_rcpf(li_l[crow(r, hi)]);
  __syncthreads();
  float* X2 = (float*)lds + qsub * 4096 + lane;
  if (map == 1) {
#pragma unroll
    for (int r = 0; r < 16; ++r)
#pragma unroll
      for (int d0 = 0; d0 < 4; ++d0) X2[(r * 4 + d0) * 64] = o[d0][r] * rli[r];
  }
  __syncthreads();
  if (map == 0) {
    float g[4];
#pragma unroll
    for (int d0 = 0; d0 < 4; ++d0) g[d0] = gsub[32 * d0 + r32] * (1.f - LAM_INIT);
    char* ost = (char*)lds + 65536 + qsub * 8192;
#pragma unroll
    for (int r = 0; r < 16; ++r) {
      float ss = 0.f;
#pragma unroll
      for (int d0 = 0; d0 < 4; ++d0) { const float v = o[d0][r] * rli[r] - lam * X2[(r * 4 + d0) * 64]; o[d0][r] = v; ss += v * v; }
#pragma unroll
      for (int m = 1; m < 32; m <<= 1) ss += shx(ss, m, lane);
      const float rs = rsqrtf(ss * (1.f / 128.f) + EPS);
      char* orow = ost + crow(r, hi) * 256 + r32 * 2;
#pragma unroll
      for (int d0 = 0; d0 < 4; ++d0) *(bf16_t*)(orow + 64 * d0) = (bf16_t)f2bf(o[d0][r] * rs * g[d0]);
    }
    asm volatile("s_waitcnt lgkmcnt(0)" ::: "memory");
#pragma unroll
    for (int i = 0; i < 8; ++i) { const int q = lane + 64 * i, lr = q >> 4, chunk = q & 15;
      const uint4 v = *(const uint4*)(ost + lr * 256 + chunk * 16);
      *(uint4*)(Ob + (size_t)(qsub * 32 + lr) * DM + chunk * 8) = v; }
  }
  __syncthreads();
#undef SLOAD
#undef SWRITE
#undef SWAIT
#undef RESC
}
#undef KSWZ
#undef SBAR
}
__device__ __forceinline__ void ph_attn_fast(CArgs& a, const Ctx& c) {
  const bf16_t* Q = (const bf16_t*)(a.ws + WS_Q); const bf16_t* Kb = (const bf16_t*)(a.ws + WS_K); const bf16_t* Vb = (const bf16_t*)(a.ws + WS_V); bf16_t* ATT = (bf16_t*)(a.ws + WS_ATT);
  const float lam = *(const float*)(a.ws + WS_LAM);
  constexpr int NU = NB * NH * (NSEQ / 128);
  for (int i = 0; ; ++i) {
    const int L = i * c.G + c.blk; if (L >= NU) break;
    const int v = pg8::xcd_remap(L, NU), qb = v & 31, bh = v >> 5, b = bh >> 2, h = bh & 3;
    const size_t row0 = (size_t)b * NSEQ + qb * 128;
    att::unit(Q + row0 * AW + h * 128, Kb + (size_t)b * SKV * AW + h * 128, Vb + (size_t)b * SKV * AW + h * 128, ATT + row0 * DM + h * 128, lam, a.in[I_GSUBLN], (char*)c.lds, c.tid);
  }
}

constexpr int NPHASE = 10;
__device__ __forceinline__ void run_phase(int ph, CArgs& a, const Ctx& c) {
    switch (ph) {
        case 0: { unsigned* f = (unsigned*)(a.ws + WS_CTL) + CW_ADALN;
                  pt_mark(c.lds, c.tid, 0, true); ph_adaln(a, c); flag_arrive(f, c.tid); pt_mark(c.lds, c.tid, 0, false);
                  pt_mark(c.lds, c.tid, 1, true); ph_transposes(a, c, 0, TR_NIT - TR_NFILL, c.blk * 8 + c.wave, c.G * 8); __syncthreads(); pt_mark(c.lds, c.tid, 1, false);
                  pt_mark(c.lds, c.tid, 2, true); flag_wait(f, (unsigned)c.G, c.tid); ph_hxrows(a, c); __syncthreads(); pt_mark(c.lds, c.tid, 2, false); } break;
        case 1: break;
        case 2: ph_inproj_fast(a, c); break;
        case 3: ph_attn_fast(a, c); __syncthreads(); ph_pool_fast(a, c); break;
        case 4: ph_outproj_fast(a, c); break;
        case 5: { unsigned* f = (unsigned*)(a.ws + WS_CTL) + CW_ROUTER;
                  ph_norm_router_fast(a, c); flag_arrive(f, c.tid); flag_wait(f, (unsigned)c.G, c.tid); ph_tables(a, c); } break;
        case 6: break;
        case 7: ph_gateup_fast(a, c); break;
        case 8: ph_down_fast(a, c); break;
        case 9: ph_combine(a, c); break;
        default: break;
    }
}
__global__ void __launch_bounds__(512, 2) mega(Args a_) {
    extern __shared__ __attribute__((aligned(16))) unsigned char lds[];
    const int lo = a_.ph_lo, hi = a_.ph_hi;
    { volatile LAS unsigned* z = (volatile LAS unsigned*)((LAS unsigned char*)lds + LDSCTL_OFF); for (int u = threadIdx.x; u < (LDS_BYTES - LDSCTL_OFF) / 4; u += 512) z[u] = 0u; }
    __syncthreads();
    volatile LAS unsigned* MISC = (volatile LAS unsigned*)((LAS unsigned char*)lds + MISC_OFF);
    XcdBarrier bar; bar.bar = (unsigned*)(a_.ws + WS_CTL); bar.x = 0; bar.st = nullptr;
    if (hi - lo > 1) bar = xcd_barrier_post((unsigned*)(a_.ws + WS_CTL), MISC + 8);
    unsigned long long probe_ticks = 0;
    const int wv0_ = __builtin_amdgcn_readfirstlane(threadIdx.x >> 6);
#define PHASE(k) if (lo <= (k) && (k) < hi) { \
        unsigned long long pt0_ = 0; if ((k) == PROBE_PH) pt0_ = __builtin_amdgcn_s_memrealtime(); \
        int t_ = wv0_ * 64 + (int)__builtin_amdgcn_mbcnt_hi(~0u, __builtin_amdgcn_mbcnt_lo(~0u, 0u)); asm volatile("" : "+v"(t_)); \
        CArgs* ap_ = (CArgs*)__builtin_amdgcn_kernarg_segment_ptr(); asm volatile("" : "+s"(ap_)); \
        Ctx c; c.tid = t_; c.lane = t_ & 63; c.wave = __builtin_amdgcn_readfirstlane(t_ >> 6); c.blk = blockIdx.x; c.G = gridDim.x; c.lds = lds; \
        run_phase((k), *ap_, c); \
        if ((k) == REPEAT_PH) { for (int rep_ = 0; rep_ < REPEAT_N; ++rep_) { xcd_barrier(bar, c.tid); run_phase((k), *ap_, c); } } \
        if ((k) + 1 < hi) xcd_barrier(bar, c.tid); \
        if ((k) == PROBE_PH) probe_ticks = __builtin_amdgcn_s_memrealtime() - pt0_; }
    PHASE(0) PHASE(2) PHASE(3) PHASE(4) PHASE(5) PHASE(7) PHASE(8) PHASE(9)
#undef PHASE
    if (PROBE_SUB >= 0) probe_ticks = ((volatile LAS unsigned*)((LAS unsigned char*)lds + MISC_OFF))[16 + 2 * PROBE_SUB + 1];
    if ((PROBE_PH >= 0 || PROBE_SUB >= 0) && blockIdx.x == 0) { const unsigned long long t0 = __builtin_amdgcn_s_memrealtime(); while (__builtin_amdgcn_s_memrealtime() - t0 < probe_ticks * PROBE_AMP) __builtin_amdgcn_s_sleep(8); }
}

extern "C" void kernel_launch(void* const* d_in, const int* in_sizes, int n_in, void* d_out, int out_size, void* d_ws, size_t ws_size, hipStream_t stream) {
    static int grid = 0;
    if (grid == 0) {
        if (n_in != 28 || in_sizes[0] != T * DM || out_size != T * DM || ws_size < WS_END) {
            fprintf(stderr, "kernel_launch: unexpected shapes or workspace: n_in %d in0 %d out %d ws %zu (need %zu)\n", n_in, n_in > 0 ? in_sizes[0] : -1, out_size, ws_size, (size_t)WS_END);
            grid = -1; return; }
        int dev = 0, cus = 0;
        if (hipGetDevice(&dev) != hipSuccess || hipDeviceGetAttribute(&cus, hipDeviceAttributeMultiprocessorCount, dev) != hipSuccess) { grid = -1; return; }
        if (hipFuncSetAttribute((const void*)mega, hipFuncAttributeMaxDynamicSharedMemorySize, LDS_BYTES) != hipSuccess) { fprintf(stderr, "kernel_launch: hipFuncSetAttribute failed\n"); grid = -1; return; }
        grid = cus;
    }
    if (grid < 0) return;
    (void)hipMemsetAsync((char*)d_ws + WS_CTL, 0, CTL_ZERO_BYTES, stream);
    Args a{};
    for (int i = 0; i < 28; ++i) a.in[i] = (const float*)d_in[i];
    a.out = (float*)d_out; a.ws = (unsigned char*)d_ws;
#if MK_PER_PHASE_LAUNCH
    for (int p = 0; p < NPHASE; ++p) { a.ph_lo = p; a.ph_hi = p + 1; hipLaunchKernelGGL(mega, dim3(grid), dim3(512), LDS_BYTES, stream, a); }
#else
    a.ph_lo = 0; a.ph_hi = NPHASE; hipLaunchKernelGGL(mega, dim3(grid), dim3(512), LDS_BYTES, stream, a);
#endif
    const hipError_t le = hipPeekAtLastError();
    if (le != hipSuccess) fprintf(stderr, "kernel_launch: launch failed: %s\n", hipGetErrorName(le));
}
```

```cpp
#include <hip/hip_runtime.h>
#include <cstdio>
#include <cstdint>

#ifndef REPK_DOWN
#define REPK_DOWN 1
#endif
#ifndef REPK_GU
#define REPK_GU 1
#endif
#ifndef PROBE_PH
#define PROBE_PH (-1)
#endif
#ifndef PROBE_AMP
#define PROBE_AMP 10
#endif
#ifndef REPEAT_PH
#define REPEAT_PH (-1)
#endif
#ifndef REPEAT_N
#define REPEAT_N 1
#endif
#ifndef MK_PER_PHASE_LAUNCH
#define MK_PER_PHASE_LAUNCH 0
#endif

constexpr int NB = 4, NSEQ = 4096, DM = 1024, T = NB * NSEQ, CTXL = 256, TC = NB * CTXL, TT = T + TC;
constexpr int NH = 4, DQK = 64, DV = 128, AW = 512, INW = 2048, PW = 512;
constexpr int SKV = CTXL + NSEQ;
constexpr int NE = 64, FF = 256, TOPK = 8;
constexpr int NSLOT_R = T * TOPK;
constexpr int NSLOT = NSLOT_R + T;
constexpr float EPS = 1e-6f;
constexpr float LAM_INIT = 0.2f;
constexpr int NVB = 256;

typedef unsigned short bf16_t;
typedef unsigned int u32;

constexpr size_t KiB = 1024, MiB = 1024 * 1024;
constexpr size_t WS_CTL = 0;
constexpr size_t CTL_ZERO_BYTES = 64 * KiB;
constexpr size_t WS_MODS = 64 * KiB;
constexpr size_t WS_LAM = 192 * KiB;
constexpr size_t WS_ROPE = 196 * KiB;
constexpr size_t WS_SEG = 208 * KiB;
constexpr size_t WS_BLKCNT = 256 * KiB;
constexpr size_t WS_TOPE = 512 * KiB;
constexpr size_t WS_TOPW = 1 * MiB;
constexpr size_t WS_TOKSLOT = 1 * MiB + 512 * KiB;
constexpr size_t WS_SLOTTOK = 2 * MiB;
constexpr size_t WS_ULIST = 2 * MiB + 512 * KiB;
constexpr size_t WS_SLOTE = 3 * MiB;
constexpr size_t WS_WPOOL = 3 * MiB + 512 * KiB;
constexpr size_t WS_WRHI = 3 * MiB;
constexpr size_t WS_WRLO = 3 * MiB + 128 * KiB;
constexpr size_t WS_WD = 4 * MiB;
constexpr size_t WS_WGU = WS_WD + 33280 * KiB;
constexpr size_t WS_HX = WS_WGU + 65 * MiB;
constexpr size_t WS_WIN = WS_HX + 34 * MiB;
constexpr size_t WS_WOUT = WS_WIN + 4 * MiB;
constexpr size_t WS_Q = WS_WOUT + 2 * MiB;
constexpr size_t WS_K = WS_Q + 16 * MiB;
constexpr size_t WS_V = WS_K + 17 * MiB;
constexpr size_t WS_P = WS_V + 17 * MiB;
constexpr size_t WS_ATT = WS_P + 16 * MiB;
constexpr size_t WS_YX = WS_ATT + 32 * MiB;
constexpr size_t WS_ACT = 227 * MiB + 256 * KiB;
constexpr size_t WS_X1B = 184 * MiB;
constexpr size_t WS_Y = WS_WGU;
constexpr size_t WS_END = WS_ACT + (size_t)(NSLOT + 256) * FF * 2;
static_assert(WS_YX + 32 * MiB <= WS_END + 64 * MiB, "map");
static_assert(WS_Y + (size_t)(NSLOT + 256) * DM <= WS_X1B && WS_X1B + (size_t)T * DM * 2 <= WS_ACT, "Y | X1B | ACT must not overlap");

constexpr int LDS_BYTES = 163840;
constexpr int LDS_MAIN = 140 * 1024;
constexpr int LDS_TOKL = 140 * 1024;
constexpr int LDS_ROPE = 148 * 1024;
constexpr int LDSCTL_OFF = 156 * 1024;
constexpr int MISC_OFF = LDSCTL_OFF + 320;

#define GAS __attribute__((address_space(1)))
#define LAS __attribute__((address_space(3)))

__device__ __forceinline__ u32 f2bf(float f) { u32 u = __float_as_uint(f); return (u + 0x7fffu + ((u >> 16) & 1u)) >> 16; }
__device__ __forceinline__ u32 pk2(float lo, float hi) { return f2bf(lo) | (f2bf(hi) << 16); }
__device__ __forceinline__ float bflo(u32 w) { return __uint_as_float(w << 16); }
__device__ __forceinline__ float bfhi(u32 w) { return __uint_as_float(w & 0xffff0000u); }
__device__ __forceinline__ float bf2f(bf16_t b) { return __uint_as_float(((u32)b) << 16); }
__device__ __forceinline__ float shx(float v, int m, int lane) { return __int_as_float(__builtin_amdgcn_ds_bpermute((lane ^ m) << 2, __float_as_int(v))); }
__device__ __forceinline__ float shl(float v, int src) { return __int_as_float(__builtin_amdgcn_ds_bpermute(src << 2, __float_as_int(v))); }
__device__ __forceinline__ float wave_sum(float v, int lane) {
    (void)lane;
    v += __int_as_float(__builtin_amdgcn_update_dpp(0, __float_as_int(v), 0xB1, 0xf, 0xf, true));
    v += __int_as_float(__builtin_amdgcn_update_dpp(0, __float_as_int(v), 0x4E, 0xf, 0xf, true));
    v += __int_as_float(__builtin_amdgcn_update_dpp(0, __float_as_int(v), 0x141, 0xf, 0xf, true));
    v += __int_as_float(__builtin_amdgcn_update_dpp(0, __float_as_int(v), 0x140, 0xf, 0xf, true));
    const float s0 = __int_as_float(__builtin_amdgcn_readlane(__float_as_int(v), 0)), s1 = __int_as_float(__builtin_amdgcn_readlane(__float_as_int(v), 16));
    const float s2 = __int_as_float(__builtin_amdgcn_readlane(__float_as_int(v), 32)), s3 = __int_as_float(__builtin_amdgcn_readlane(__float_as_int(v), 48));
    return (s0 + s1) + (s2 + s3);
}
__device__ __forceinline__ float wave_max(float v, int lane) {
#pragma unroll
    for (int o = 1; o < 64; o <<= 1) v = fmaxf(v, shx(v, o, lane));
    return v;
}
__device__ __forceinline__ float silu_f(float v) { return v / (1.f + __expf(-v)); }
__device__ __forceinline__ float dot8(uint4 a, uint4 b, float acc) {
    acc = fmaf(bflo(a.x), bflo(b.x), acc); acc = fmaf(bfhi(a.x), bfhi(b.x), acc);
    acc = fmaf(bflo(a.y), bflo(b.y), acc); acc = fmaf(bfhi(a.y), bfhi(b.y), acc);
    acc = fmaf(bflo(a.z), bflo(b.z), acc); acc = fmaf(bfhi(a.z), bfhi(b.z), acc);
    acc = fmaf(bflo(a.w), bflo(b.w), acc); acc = fmaf(bfhi(a.w), bfhi(b.w), acc);
    return acc;
}
__device__ __forceinline__ float ndot(const bf16_t* a, const bf16_t* b, int K) {
    float a0 = 0.f, a1 = 0.f;
    for (int k = 0; k < K; k += 16) {
        const uint4 x0 = *(const uint4*)(a + k), y0 = *(const uint4*)(b + k), x1 = *(const uint4*)(a + k + 8), y1 = *(const uint4*)(b + k + 8);
        a0 = dot8(x0, y0, a0); a1 = dot8(x1, y1, a1);
    }
    return a0 + a1;
}

#define XB_TMO      128
#define XB_XCNT(j)  (256  + 64 * (j))
#define XB_XSUB(j)  (1280 + 64 * (j))
#define XB_XGEN(j)  (2304 + 64 * (j))
#define XB_TOP      3328
#define XB_TOPGEN   3392
#define XCD_BAR_WORDS 3456
#define XB_SPIN_CAP (1u << 22)
__device__ __forceinline__ unsigned xb_ld(unsigned* p)              { return __hip_atomic_load(p, __ATOMIC_RELAXED, __HIP_MEMORY_SCOPE_AGENT); }
__device__ __forceinline__ unsigned xb_add(unsigned* p, unsigned v) { return __hip_atomic_fetch_add(p, v, __ATOMIC_RELAXED, __HIP_MEMORY_SCOPE_AGENT); }
__device__ __forceinline__ unsigned xb_xcc_id() { return (unsigned)__builtin_amdgcn_s_getreg((3 << 11) | 20) & 0xFu; }
#define XB_SPIN(cond, bar) do { unsigned _sp = 0; while (cond) { __builtin_amdgcn_s_sleep(1); \
    if ((++_sp & 255u) == 0u) { if (xb_ld(&(bar)[XB_TMO])) break; if (_sp > XB_SPIN_CAP) { atomicAdd(&(bar)[XB_TMO], 1u); break; } } } } while (0)
struct XcdBarrier { unsigned* bar; unsigned x; volatile LAS unsigned* st; };
__device__ __forceinline__ XcdBarrier xcd_barrier_post(unsigned* bar, volatile LAS unsigned* st) {
    XcdBarrier b; b.bar = bar; b.x = xb_xcc_id(); b.st = st;
    if (threadIdx.x == 0) (void)xb_add(&bar[XB_XCNT(b.x)], 1u);
    return b;
}
__device__ __forceinline__ void xcd_barrier_complete(unsigned* bar, unsigned x, unsigned& nloc, unsigned& nx) {
    const unsigned G = gridDim.x * gridDim.y * gridDim.z;
    unsigned sum, cnt, mine, sp = 0u;
    for (;;) {
        sum = 0u; cnt = 0u; mine = 0u;
#pragma unroll
        for (unsigned j = 0; j < 16; ++j) { const unsigned c = xb_ld(&bar[XB_XCNT(j)]); sum += c; cnt += (c > 0u) ? 1u : 0u; mine = (j == x) ? c : mine; }
        if (sum == G) break;
        __builtin_amdgcn_s_sleep(1);
        if ((++sp & 255u) == 0u) { if (xb_ld(&bar[XB_TMO])) break; if (sp > XB_SPIN_CAP) { atomicAdd(&bar[XB_TMO], 1u); break; } }
    }
    nloc = mine > 0u ? mine : 1u; nx = cnt > 0u ? cnt : 1u;
}
__device__ __forceinline__ void xcd_barrier(const XcdBarrier& b, const int tid) {
    asm volatile("s_waitcnt vmcnt(0)" ::: "memory");
    __syncthreads();
    if (tid == 0) {
        unsigned* bar = b.bar;
        __builtin_amdgcn_s_waitcnt(0);
        unsigned nloc = b.st[0], nx = b.st[1];
        if (nloc == 0u) { xcd_barrier_complete(bar, b.x, nloc, nx); b.st[0] = nloc; b.st[1] = nx; }
        const unsigned old = xb_add(&bar[XB_XSUB(b.x)], 1u);
        const unsigned gen = old / nloc;
        if (old + 1u == (gen + 1u) * nloc) {
            __builtin_amdgcn_fence(__ATOMIC_RELEASE, "agent");
            asm volatile("s_waitcnt vmcnt(0)" ::: "memory");
            const unsigned og = xb_add(&bar[XB_TOP], 1u);
            const unsigned tg = og / nx;
            if (og + 1u == (tg + 1u) * nx) xb_add(&bar[XB_TOPGEN], 1u);
            else XB_SPIN(xb_ld(&bar[XB_TOPGEN]) == tg, bar);
            __builtin_amdgcn_fence(__ATOMIC_ACQUIRE, "agent");
            xb_add(&bar[XB_XGEN(b.x)], 1u);
            asm volatile("s_waitcnt vmcnt(0)" ::: "memory");
        } else {
            XB_SPIN(xb_ld(&bar[XB_XGEN(b.x)]) == gen, bar);
            __builtin_amdgcn_fence(__ATOMIC_ACQUIRE, "agent");
            asm volatile("s_waitcnt vmcnt(0)" ::: "memory");
        }
    }
    __syncthreads();
}


constexpr int CW_ADALN = 4096, CW_ROUTER = 4160;
__device__ __forceinline__ void flag_arrive(unsigned* cnt, int tid) {
    asm volatile("s_waitcnt vmcnt(0)" ::: "memory");
    __syncthreads();
    if (tid == 0) { __builtin_amdgcn_fence(__ATOMIC_RELEASE, "agent"); asm volatile("s_waitcnt vmcnt(0)" ::: "memory"); (void)xb_add(cnt, 1u); }
}
__device__ __forceinline__ void flag_wait(unsigned* cnt, unsigned target, int tid) {
    if (tid == 0) { unsigned sp = 0; while (xb_ld(cnt) < target) { __builtin_amdgcn_s_sleep(2); if (++sp > (1u << 24)) break; }
        __builtin_amdgcn_fence(__ATOMIC_ACQUIRE, "agent"); asm volatile("s_waitcnt vmcnt(0)" ::: "memory"); }
    __syncthreads();
}


#ifndef PROBE_SUB
#define PROBE_SUB (-1)
#endif
__device__ __forceinline__ void pt_mark(unsigned char* lds, int tid, int id, bool begin) {
    if (PROBE_SUB >= 0 && tid == 0) { volatile LAS unsigned* w = (volatile LAS unsigned*)((LAS unsigned char*)lds + MISC_OFF) + 16 + 2 * id;
        const unsigned now = (unsigned)__builtin_amdgcn_s_memrealtime(); if (begin) w[0] = now; else w[1] += now - w[0]; }
}

struct Args {
    const float* in[28];
    float* out;
    unsigned char* ws;
    int ph_lo, ph_hi;
};
enum { I_X = 0, I_C, I_CTX, I_CCTX, I_WADA, I_BADA, I_GPREMIX, I_GPOSTMIX, I_GPREFFN, I_GPOSTFFN, I_WIN, I_LQ1, I_LK1, I_LQ2, I_LK2,
       I_GSUBLN, I_WPOOL, I_BPOOL, I_PSCALE, I_WOUT, I_WROUTER, I_RBIAS, I_WEG, I_WEU, I_WED, I_WSG, I_WSU, I_WSD };

typedef __attribute__((address_space(4))) const Args CArgs;
struct Ctx {
    int tid, lane, wave, blk, G;
    unsigned char* lds;
};

__device__ __forceinline__ void ph_adaln(CArgs& a, const Ctx& c) {
    float* MODS = (float*)(a.ws + WS_MODS);
    float* red = (float*)c.lds;
    const float* w_ada = a.in[I_WADA];
    const int ksub = c.lane / 6, c4 = c.lane % 6;
    for (int it = c.blk; it < 256; it += c.G) {
        float acc[5][4];
#pragma unroll
        for (int r = 0; r < 5; ++r)
#pragma unroll
            for (int j = 0; j < 4; ++j) acc[r][j] = 0.f;
        if (ksub < 10) {
            for (int i = 0; i < 13; ++i) { const int kk = ksub + 10 * i;
                if (kk < 128) { const int k = c.wave * 128 + kk;
                    const float4 w = *(const float4*)(w_ada + (size_t)k * 6144 + it * 24 + 4 * c4);
#pragma unroll
                    for (int r = 0; r < 5; ++r) { const float sv = silu_f((r < 4) ? a.in[I_C][r * DM + k] : a.in[I_CCTX][k]);
                        acc[r][0] = fmaf(sv, w.x, acc[r][0]); acc[r][1] = fmaf(sv, w.y, acc[r][1]); acc[r][2] = fmaf(sv, w.z, acc[r][2]); acc[r][3] = fmaf(sv, w.w, acc[r][3]); } } }
#pragma unroll
            for (int r = 0; r < 5; ++r)
#pragma unroll
                for (int j = 0; j < 4; ++j) red[((c.wave * 10 + ksub) * 5 + r) * 24 + 4 * c4 + j] = acc[r][j];
        }
        __syncthreads();
        if (c.tid < 120) { const int r = c.tid / 24, col = c.tid % 24; float sum = 0.f;
            for (int q = 0; q < 80; ++q) sum += red[(q * 5 + r) * 24 + col];
            MODS[r * 6144 + it * 24 + col] = sum + a.in[I_BADA][it * 24 + col]; }
        __syncthreads();
    }
    if (c.blk == c.G - 1) {
        float* ROPE = (float*)(a.ws + WS_ROPE);
        for (int i = c.tid; i < 1024; i += 512) {
            const int pos = i >> 4, fi = i & 15;
            const float freq = powf(10000.f, -(float)fi / 16.f);
            const float ang = (float)pos * freq;
            ROPE[i * 2] = cosf(ang); ROPE[i * 2 + 1] = sinf(ang);
        }
        if (c.wave == 0) {
            const float s1 = wave_sum(a.in[I_LQ1][c.lane] * a.in[I_LK1][c.lane], c.lane);
            const float s2 = wave_sum(a.in[I_LQ2][c.lane] * a.in[I_LK2][c.lane], c.lane);
            if (c.lane == 0) *(float*)(a.ws + WS_LAM) = expf(s1) - expf(s2) + LAM_INIT;
        }
    }
    __syncthreads();
}

__device__ __forceinline__ void transpose_item(const float* W, int K, int N, bf16_t* WT, int k0, int n0, int drow0, float* scr, int lane) {
    float v[32];
#pragma unroll
    for (int i = 0; i < 32; ++i) v[i] = W[(size_t)(k0 + 2 * i + (lane >> 5)) * N + n0 + (lane & 31)];
#pragma unroll
    for (int i = 0; i < 32; ++i) scr[(2 * i + (lane >> 5)) * 33 + (lane & 31)] = v[i];
    asm volatile("s_waitcnt lgkmcnt(0)" ::: "memory");
    const int cc = lane & 7;
#pragma unroll
    for (int j = 0; j < 4; ++j) { const int n = (lane >> 3) + 8 * j; const float* s = scr + (8 * cc) * 33 + n;
        uint4 o; o.x = pk2(s[0 * 33], s[1 * 33]); o.y = pk2(s[2 * 33], s[3 * 33]); o.z = pk2(s[4 * 33], s[5 * 33]); o.w = pk2(s[6 * 33], s[7 * 33]);
        *(uint4*)(WT + (size_t)(drow0 + n) * K + k0 + 8 * cc) = o; }
    asm volatile("s_waitcnt lgkmcnt(0)" ::: "memory");
}
__device__ __forceinline__ void transpose_item_hilo(const float* W, bf16_t* WH, bf16_t* WL, int k0, int n0, float* scr, int lane) {
    float v[32];
#pragma unroll
    for (int i = 0; i < 32; ++i) v[i] = W[(size_t)(k0 + 2 * i + (lane >> 5)) * NE + n0 + (lane & 31)];
#pragma unroll
    for (int i = 0; i < 32; ++i) scr[(2 * i + (lane >> 5)) * 33 + (lane & 31)] = v[i];
    asm volatile("s_waitcnt lgkmcnt(0)" ::: "memory");
    const int cc = lane & 7;
#pragma unroll
    for (int j = 0; j < 4; ++j) { const int n = (lane >> 3) + 8 * j; const float* s = scr + (8 * cc) * 33 + n;
        u32 h[4], l[4];
#pragma unroll
        for (int q = 0; q < 4; ++q) { const float f0 = s[(2 * q) * 33], f1 = s[(2 * q + 1) * 33]; const u32 h0 = f2bf(f0), h1 = f2bf(f1);
            h[q] = h0 | (h1 << 16); l[q] = pk2(f0 - __uint_as_float(h0 << 16), f1 - __uint_as_float(h1 << 16)); }
        *(uint4*)(WH + (size_t)(n0 + n) * DM + k0 + 8 * cc) = make_uint4(h[0], h[1], h[2], h[3]);
        *(uint4*)(WL + (size_t)(n0 + n) * DM + k0 + 8 * cc) = make_uint4(l[0], l[1], l[2], l[3]); }
    asm volatile("s_waitcnt lgkmcnt(0)" ::: "memory");
}
constexpr int TR_I_IN = 16 * 64, TR_I_OUT = 16 * 32, TR_I_G = 16 * 8, TR_I_D = 4 * 32, TR_I_P = 4 * 2 * 4;
constexpr int TR_I_R = 16 * 2;
constexpr int TR_NIT = TR_I_IN + TR_I_OUT + TR_I_P + TR_I_R + 65 * (2 * TR_I_G + TR_I_D);
constexpr int TR_NFILL = 10240;
__device__ __forceinline__ void ph_transposes(CArgs& a, const Ctx& c, const int it_lo, const int it_hi, const int wrank, const int NW) {
    float* scr = (float*)(c.lds + c.wave * 16384);
    constexpr int I_IN = TR_I_IN, I_OUT = TR_I_OUT, I_G = TR_I_G, I_D = TR_I_D, I_P = TR_I_P;
    bf16_t* WIN = (bf16_t*)(a.ws + WS_WIN); bf16_t* WOUT = (bf16_t*)(a.ws + WS_WOUT); bf16_t* WGU = (bf16_t*)(a.ws + WS_WGU); bf16_t* WD = (bf16_t*)(a.ws + WS_WD);
    for (int it = it_lo + wrank; it < it_hi; it += NW) {
        int r = it;
        if (r < I_IN) { const int kb = r / 64, nb = r % 64; transpose_item(a.in[I_WIN], DM, INW, WIN, kb * 64, nb * 32, nb * 32, scr, c.lane); continue; } r -= I_IN;
        if (r < I_OUT) { const int kb = r / 32, nb = r % 32; transpose_item(a.in[I_WOUT], DM, DM, WOUT, kb * 64, nb * 32, nb * 32, scr, c.lane); continue; } r -= I_OUT;
        if (r < I_P) { const int g = r >> 3, kb = (r >> 2) & 1, nb = r & 3;
            transpose_item(a.in[I_WPOOL] + (size_t)g * 128 * 128, 128, 128, (bf16_t*)(a.ws + WS_WPOOL) + (size_t)g * 128 * 128, kb * 64, nb * 32, nb * 32, scr, c.lane); continue; } r -= I_P;
        if (r < TR_I_R) { transpose_item_hilo(a.in[I_WROUTER], (bf16_t*)(a.ws + WS_WRHI), (bf16_t*)(a.ws + WS_WRLO), (r >> 1) * 64, (r & 1) * 32, scr, c.lane); continue; } r -= TR_I_R;
        const int e = r / (2 * I_G + I_D); r -= e * (2 * I_G + I_D);
        if (r < 2 * I_G) {
            const int up = r / I_G; r -= up * I_G; const int kb = r / 8, nb = r % 8, n0 = nb * 32;
            const float* src = (e < 64) ? a.in[up ? I_WEU : I_WEG] + (size_t)e * DM * FF : a.in[up ? I_WSU : I_WSG];
            transpose_item(src, DM, FF, WGU + (size_t)e * 512 * DM, kb * 64, n0, 256 * (n0 >> 7) + (n0 & 127) + (up ? 128 : 0), scr, c.lane);
        } else {
            r -= 2 * I_G; const int kb = r / 32, nb = r % 32;
            const float* src = (e < 64) ? a.in[I_WED] + (size_t)e * FF * DM : a.in[I_WSD];
            transpose_item(src, FF, DM, WD + (size_t)e * DM * FF, kb * 64, nb * 32, nb * 32, scr, c.lane);
        }
    }
}
__device__ __forceinline__ void ph_hxrows(CArgs& a, const Ctx& c) {
    const int gw = c.blk * 8 + c.wave, NGW = c.G * 8;
    const float* MODS = (const float*)(a.ws + WS_MODS); bf16_t* HX = (bf16_t*)(a.ws + WS_HX);
    for (int m0 = 2 * gw; m0 < TT; m0 += 2 * NGW) {
        const int m1 = m0 + 1;
        const float* xr0 = (m0 < T) ? a.in[I_X] + (size_t)m0 * DM : a.in[I_CTX] + (size_t)(m0 - T) * DM;
        const float* xr1 = xr0 + DM;
        float4 v0[4], v1[4]; float ss0 = 0.f, ss1 = 0.f;
#pragma unroll
        for (int j = 0; j < 4; ++j) { v0[j] = *(const float4*)(xr0 + 4 * c.lane + 256 * j); v1[j] = *(const float4*)(xr1 + 4 * c.lane + 256 * j); }
#pragma unroll
        for (int j = 0; j < 4; ++j) { ss0 += v0[j].x * v0[j].x + v0[j].y * v0[j].y + v0[j].z * v0[j].z + v0[j].w * v0[j].w;
                                      ss1 += v1[j].x * v1[j].x + v1[j].y * v1[j].y + v1[j].z * v1[j].z + v1[j].w * v1[j].w; }
        const float rs0 = rsqrtf(wave_sum(ss0, c.lane) * (1.f / DM) + EPS), rs1 = rsqrtf(wave_sum(ss1, c.lane) * (1.f / DM) + EPS);
        const float* md = MODS + (size_t)((m0 < T) ? (m0 / NSEQ) : 4) * 6144;
#pragma unroll
        for (int j = 0; j < 4; ++j) {
            const int col = 4 * c.lane + 256 * j;
            const float4 g = *(const float4*)(a.in[I_GPREMIX] + col), sh = *(const float4*)(md + col), sc = *(const float4*)(md + 1024 + col);
            const float gx = g.x * (1.f + sc.x), gy = g.y * (1.f + sc.y), gz = g.z * (1.f + sc.z), gw_ = g.w * (1.f + sc.w);
            uint2 w0, w1;
            w0.x = pk2(v0[j].x * rs0 * gx + sh.x, v0[j].y * rs0 * gy + sh.y); w0.y = pk2(v0[j].z * rs0 * gz + sh.z, v0[j].w * rs0 * gw_ + sh.w);
            w1.x = pk2(v1[j].x * rs1 * gx + sh.x, v1[j].y * rs1 * gy + sh.y); w1.y = pk2(v1[j].z * rs1 * gz + sh.z, v1[j].w * rs1 * gw_ + sh.w);
            *(uint2*)(HX + (size_t)m0 * DM + col) = w0; *(uint2*)(HX + (size_t)m1 * DM + col) = w1;
        }
    }
}

__device__ __forceinline__ void route_token(CArgs& a, const Ctx& c, const int t, const float logit, const float rbias, int* hist) {
    int* TOPE = (int*)(a.ws + WS_TOPE); float* TOPW = (float*)(a.ws + WS_TOPW);
    const float score = 1.f / (1.f + expf(-logit));
    const float biased = score + rbias;
    int grank = 0;
#pragma unroll
    for (int j = 0; j < 8; ++j) { const float vj = shl(biased, (c.lane & ~7) + j); grank += (vj > biased || (vj == biased && j < (c.lane & 7))) ? 1 : 0; }
    float gs = (grank < 2) ? biased : 0.f;
    gs += shx(gs, 1, c.lane); gs += shx(gs, 2, c.lane); gs += shx(gs, 4, c.lane);
    int gr = 0; const int myg = c.lane >> 3;
#pragma unroll
    for (int g = 0; g < 8; ++g) { const float sg = __int_as_float(__builtin_amdgcn_readlane(__float_as_int(gs), g * 8)); gr += (sg > gs || (sg == gs && g < myg)) ? 1 : 0; }
    const unsigned fb = __float_as_uint(biased);
    const unsigned key = (gr < 4) ? (fb ^ ((fb >> 31) ? 0xffffffffu : 0x80000000u)) : 0u;
    unsigned T = 0u;
#pragma unroll
    for (int b = 31; b >= 0; --b) { const unsigned cand = T | (1u << b); if (__builtin_popcountll(__ballot(key >= cand)) >= TOPK) T = cand; }
    const unsigned long long mgt = __ballot(key > T), meq = __ballot(key == T);
    const unsigned long long below = (1ull << c.lane) - 1ull;
    const int need = TOPK - __builtin_popcountll(mgt);
    const bool sel = (key > T) || (key == T && __builtin_popcountll(meq & below) < need);
    const int cnt = __builtin_popcountll(__ballot(sel) & below);
    const float ssum = wave_sum(sel ? score : 0.f, c.lane);
    if (sel) {
        const int lr = atomicAdd(&hist[c.lane], 1);
        TOPE[t * 8 + cnt] = c.lane | (lr << 8);
        TOPW[t * 8 + cnt] = score / ssum * 2.5f;
    }
}
__device__ __forceinline__ void ph_norm_router_fast(CArgs& a, const Ctx& c) {
    typedef float f32x16 __attribute__((ext_vector_type(16)));
    typedef short bf16x8 __attribute__((ext_vector_type(8)));
    constexpr int HSB = 2064;
    char* HSH = (char*)c.lds;
    float* HS = (float*)c.lds;
    int* hist = (int*)(c.lds + 132352);
    float* PRM = (float*)(c.lds + LDS_TOKL);
    int* BLKCNT = (int*)(a.ws + WS_BLKCNT);
    const int kq = c.wave >> 1, jt = c.wave & 1;
    const float rbias = a.in[I_RBIAS][c.lane];
    const bf16_t* YX = (const bf16_t*)(a.ws + WS_YX); bf16_t* HX2 = (bf16_t*)(a.ws + WS_HX); bf16_t* X1B = (bf16_t*)(a.ws + WS_X1B);
    for (int vb = c.blk; vb < NVB; vb += c.G) {
        if (c.tid < 64) hist[c.tid] = 0;
        { const float* md = (const float*)(a.ws + WS_MODS) + (size_t)((vb * 64) / NSEQ) * 6144;
          for (int col = c.tid; col < DM; col += 512) { PRM[col] = md[2048 + col] * a.in[I_GPOSTMIX][col]; PRM[1024 + col] = a.in[I_GPREFFN][col] * (1.f + md[4096 + col]); PRM[2048 + col] = md[3072 + col]; } }
        __syncthreads();
        for (int pass = 0; pass < 2; ++pass) {
            const int t0 = vb * 64 + pass * 32;
            pt_mark(c.lds, c.tid, 3, true);
            {
                uint2 yA[4], yB[4]; float4 xA[4], xB[4];
#define RT_LOAD(Y, X, tok) do { const size_t t_ = (size_t)(tok); _Pragma("unroll") for (int j = 0; j < 4; ++j) { Y[j] = *(const uint2*)(YX + t_ * DM + 4 * c.lane + 256 * j); X[j] = *(const float4*)(a.in[I_X] + t_ * DM + 4 * c.lane + 256 * j); } } while (0)
#define RT_NORM(Y, X, ti_) do { const int ti = (ti_); const size_t t = (size_t)(t0 + ti); char* row = HSH + ti * HSB; \
                    float v[16]; float ss = 0.f; \
                    _Pragma("unroll") for (int j = 0; j < 4; ++j) { v[4 * j] = bflo(Y[j].x); v[4 * j + 1] = bfhi(Y[j].x); v[4 * j + 2] = bflo(Y[j].y); v[4 * j + 3] = bfhi(Y[j].y); } \
                    _Pragma("unroll") for (int j = 0; j < 16; ++j) ss += v[j] * v[j]; \
                    const float r1 = rsqrtf(wave_sum(ss, c.lane) * (1.f / DM) + EPS); \
                    float ss2 = 0.f; \
                    _Pragma("unroll") for (int j = 0; j < 4; ++j) { const float4 A1 = *(const float4*)(PRM + 4 * c.lane + 256 * j); float4 x1; \
                        x1.x = fmaf(A1.x, v[4 * j] * r1, X[j].x); x1.y = fmaf(A1.y, v[4 * j + 1] * r1, X[j].y); x1.z = fmaf(A1.z, v[4 * j + 2] * r1, X[j].z); x1.w = fmaf(A1.w, v[4 * j + 3] * r1, X[j].w); \
                        { uint2 xw_; xw_.x = pk2(x1.x, x1.y); xw_.y = pk2(x1.z, x1.w); *(uint2*)(X1B + t * DM + 4 * c.lane + 256 * j) = xw_; } \
                        v[4 * j] = x1.x; v[4 * j + 1] = x1.y; v[4 * j + 2] = x1.z; v[4 * j + 3] = x1.w; \
                        ss2 += x1.x * x1.x + x1.y * x1.y + x1.z * x1.z + x1.w * x1.w; } \
                    const float r2 = rsqrtf(wave_sum(ss2, c.lane) * (1.f / DM) + EPS); \
                    _Pragma("unroll") for (int j = 0; j < 4; ++j) { const int col = 4 * c.lane + 256 * j; const float4 G2 = *(const float4*)(PRM + 1024 + col), SH = *(const float4*)(PRM + 2048 + col); \
                        const float h0 = fmaf(v[4 * j] * r2, G2.x, SH.x), h1 = fmaf(v[4 * j + 1] * r2, G2.y, SH.y), h2 = fmaf(v[4 * j + 2] * r2, G2.z, SH.z), h3 = fmaf(v[4 * j + 3] * r2, G2.w, SH.w); \
                        const u32 b0_ = f2bf(h0), b1_ = f2bf(h1), b2_ = f2bf(h2), b3_ = f2bf(h3); \
                        uint2 w; w.x = b0_ | (b1_ << 16); w.y = b2_ | (b3_ << 16); \
                        *(uint2*)(HX2 + t * DM + col) = w; \
                        uint2 wl; wl.x = pk2(h0 - __uint_as_float(b0_ << 16), h1 - __uint_as_float(b1_ << 16)); wl.y = pk2(h2 - __uint_as_float(b2_ << 16), h3 - __uint_as_float(b3_ << 16)); \
                        *(uint2*)(row + col * 2) = w; *(uint2*)(row + 32 * HSB + col * 2) = wl; } } while (0)
                const int tw = t0 + c.wave * 4;
                RT_LOAD(yA, xA, tw);
#pragma unroll 1
                for (int it = 0; it < 2; ++it) {
                    RT_LOAD(yB, xB, tw + 2 * it + 1);
                    RT_NORM(yA, xA, c.wave * 4 + 2 * it);
                    if (it == 0) RT_LOAD(yA, xA, tw + 2);
                    RT_NORM(yB, xB, c.wave * 4 + 2 * it + 1);
                }
#undef RT_LOAD
#undef RT_NORM
            }
            __syncthreads(); pt_mark(c.lds, c.tid, 3, false); pt_mark(c.lds, c.tid, 4, true);
            f32x16 acc = {};
            {
                int ln_ = c.lane; asm volatile("" : "+v"(ln_)); const int r32 = ln_ & 31, hi = ln_ >> 5;
                const char* aH = HSH + r32 * HSB + (kq * 256 + hi * 8) * 2;
                const bf16_t* bH = (const bf16_t*)(a.ws + WS_WRHI) + (size_t)(jt * 32 + r32) * DM + kq * 256 + hi * 8; const bf16_t* bL = bH + (size_t)NE * DM;
#pragma unroll
                for (int bt = 0; bt < 2; ++bt) {
                    bf16x8 wh[8], wl[8];
#pragma unroll
                    for (int q = 0; q < 8; ++q) { wh[q] = *(const bf16x8*)(bH + (bt * 8 + q) * 16); wl[q] = *(const bf16x8*)(bL + (bt * 8 + q) * 16); }
#pragma unroll
                    for (int q = 0; q < 8; ++q) { const bf16x8 ah = *(const bf16x8*)(aH + (bt * 8 + q) * 32), al = *(const bf16x8*)(aH + 32 * HSB + (bt * 8 + q) * 32);
                        acc = __builtin_amdgcn_mfma_f32_32x32x16_bf16(ah, wh[q], acc, 0, 0, 0);
                        acc = __builtin_amdgcn_mfma_f32_32x32x16_bf16(ah, wl[q], acc, 0, 0, 0);
                        acc = __builtin_amdgcn_mfma_f32_32x32x16_bf16(al, wh[q], acc, 0, 0, 0); }
                }
            }
            __syncthreads(); pt_mark(c.lds, c.tid, 4, false); pt_mark(c.lds, c.tid, 5, true);
#pragma unroll
            for (int r = 0; r < 16; ++r) HS[(kq * 32 + ((r & 3) + 8 * (r >> 2) + 4 * (c.lane >> 5))) * 64 + jt * 32 + (c.lane & 31)] = acc[r];
            __syncthreads();
            for (int i = 0; i < 4; ++i) { const int ti = c.wave * 4 + i;
                const float lg = ((HS[(0 * 32 + ti) * 64 + c.lane] + HS[(1 * 32 + ti) * 64 + c.lane]) + HS[(2 * 32 + ti) * 64 + c.lane]) + HS[(3 * 32 + ti) * 64 + c.lane];
                route_token(a, c, t0 + ti, lg, rbias, hist); }
            __syncthreads(); pt_mark(c.lds, c.tid, 5, false);
        }
        if (c.tid < 64) BLKCNT[vb * 64 + c.tid] = hist[c.tid];
        __syncthreads();
    }
}

__device__ __forceinline__ int pl_row(int n) { return n < 0 ? 0 : (n >= NSEQ ? NSEQ - 1 : n); }
__device__ __forceinline__ void ph_pool_fast(CArgs& a, const Ctx& c) {
    typedef short bf16x8 __attribute__((ext_vector_type(8)));
    typedef float f32x16 __attribute__((ext_vector_type(16)));
    const bf16_t* P = (const bf16_t*)(a.ws + WS_P); bf16_t* ATT = (bf16_t*)(a.ws + WS_ATT); const bf16_t* WPT = (const bf16_t*)(a.ws + WS_WPOOL);
    constexpr int DSTR = 1040;
    constexpr int PL_ROWS = 80, OSTR = 272;
    char* Pl = (char*)c.lds;
    char* Dl = (char*)c.lds + PL_ROWS * 1024;
    for (int u = c.blk; u < T / 64; u += c.G) {
        const int row0 = u * 64, n0 = row0 % NSEQ;
        __syncthreads();
        {
            const bf16_t* pb = P + (size_t)(row0 - n0) * PW;
#define PL_LD(i) const uint4 v##i = *(const uint4*)(pb + (size_t)pl_row(n0 - 8 + ((c.tid + 512 * i) >> 6)) * PW + ((c.tid + 512 * i) & 63) * 8)
#define PL_ST(i) *(uint4*)(Pl + (c.tid + 512 * i) * 16) = v##i
            PL_LD(0); PL_LD(1); PL_LD(2); PL_LD(3); PL_LD(4); PL_LD(5); PL_LD(6); PL_LD(7); PL_LD(8); PL_LD(9);
            PL_ST(0); PL_ST(1); PL_ST(2); PL_ST(3); PL_ST(4); PL_ST(5); PL_ST(6); PL_ST(7); PL_ST(8); PL_ST(9);
#undef PL_LD
#undef PL_ST
        }
        __syncthreads();
        {
            const int cc = c.tid & 63, rr = c.tid >> 6, g = cc >> 4, w = 2 << g, hw = w >> 1;
            const char* pc = Pl + cc * 16 - (n0 - 8) * 1024;
            float s[8];
#pragma unroll
            for (int j = 0; j < 8; ++j) s[j] = 0.f;
            const int nfirst = n0 + rr * 8;
            int lo = nfirst - hw; if (lo < 0) lo = 0; int hiw = nfirst + hw; if (hiw > NSEQ) hiw = NSEQ;
            for (int n = lo; n < hiw; ++n) { const uint4 q = *(const uint4*)(pc + n * 1024);
                s[0] += bflo(q.x); s[1] += bfhi(q.x); s[2] += bflo(q.y); s[3] += bfhi(q.y); s[4] += bflo(q.z); s[5] += bfhi(q.z); s[6] += bflo(q.w); s[7] += bfhi(q.w); }
            for (int i = 0; i < 8; ++i) {
                const int n = nfirst + i;
                if (i > 0) {
                    const int nadd = n + hw - 1, nsub = n - hw - 1;
                    if (nadd < NSEQ) { const uint4 q = *(const uint4*)(pc + nadd * 1024);
                        s[0] += bflo(q.x); s[1] += bfhi(q.x); s[2] += bflo(q.y); s[3] += bfhi(q.y); s[4] += bflo(q.z); s[5] += bfhi(q.z); s[6] += bflo(q.w); s[7] += bfhi(q.w); }
                    if (nsub >= 0) { const uint4 q = *(const uint4*)(pc + nsub * 1024);
                        s[0] -= bflo(q.x); s[1] -= bfhi(q.x); s[2] -= bflo(q.y); s[3] -= bfhi(q.y); s[4] -= bflo(q.z); s[5] -= bfhi(q.z); s[6] -= bflo(q.w); s[7] -= bfhi(q.w); }
                }
                int l2 = n - hw; if (l2 < 0) l2 = 0; int h2 = n + hw; if (h2 > NSEQ) h2 = NSEQ;
                const float inv = 1.f / (float)(h2 - l2);
                const uint4 q = *(const uint4*)(pc + n * 1024);
                uint4 o; o.x = pk2(s[0] * inv - bflo(q.x), s[1] * inv - bfhi(q.x)); o.y = pk2(s[2] * inv - bflo(q.y), s[3] * inv - bfhi(q.y));
                o.z = pk2(s[4] * inv - bflo(q.z), s[5] * inv - bfhi(q.z)); o.w = pk2(s[6] * inv - bflo(q.w), s[7] * inv - bfhi(q.w));
                *(uint4*)(Dl + (rr * 8 + i) * DSTR + cc * 16) = o;
            }
        }
        __syncthreads();
        {
            const int g = c.wave >> 1, rh = c.wave & 1, r32 = c.lane & 31, hi = c.lane >> 5;
            f32x16 acc[4] = {};
            const char* ap = Dl + (rh * 32 + r32) * DSTR + g * 256 + hi * 16;
            const bf16_t* bp = WPT + ((size_t)g * 128 + r32) * 128 + hi * 8;
#pragma unroll
            for (int ks = 0; ks < 8; ++ks) {
                const bf16x8 af = *(const bf16x8*)(ap + ks * 32);
#pragma unroll
                for (int et = 0; et < 4; ++et) { const bf16x8 bf = *(const bf16x8*)(bp + (size_t)et * 32 * 128 + ks * 16);
                    acc[et] = __builtin_amdgcn_mfma_f32_32x32x16_bf16(af, bf, acc[et], 0, 0, 0); }
            }
            char* ost = Pl + c.wave * (32 * OSTR);
#pragma unroll
            for (int et = 0; et < 4; ++et) { const int ch = g * 128 + et * 32 + r32; const float bb = a.in[I_BPOOL][ch], sc = a.in[I_PSCALE][ch];
#pragma unroll
                for (int r = 0; r < 16; ++r) { const int lr = (r & 3) + 8 * (r >> 2) + 4 * hi;
                    *(bf16_t*)(ost + lr * OSTR + (et * 32 + r32) * 2) = (bf16_t)f2bf((acc[et][r] + bb) * sc); } }
            asm volatile("s_waitcnt lgkmcnt(0)" ::: "memory");
#pragma unroll
            for (int i = 0; i < 8; ++i) { const int q = c.lane + 64 * i, lr = q >> 4, chunk = q & 15;
                const uint4 v = *(const uint4*)(ost + lr * OSTR + chunk * 16);
                *(uint4*)(ATT + (size_t)(row0 + rh * 32 + lr) * DM + 512 + g * 128 + chunk * 8) = v; }
        }
    }
    __syncthreads();
}

__device__ __forceinline__ void ph_tables(CArgs& a, const Ctx& c) {
    const int* BLKCNT = (const int*)(a.ws + WS_BLKCNT); const int* TOPE = (const int*)(a.ws + WS_TOPE); const float* TOPW = (const float*)(a.ws + WS_TOPW);
    int* SEG = (int*)(a.ws + WS_SEG); int* TOKSLOT = (int*)(a.ws + WS_TOKSLOT); int* SLOTTOK = (int*)(a.ws + WS_SLOTTOK);
    int* psum = (int*)c.lds;
    int* segstart = psum + 512;
    int* segcnt = segstart + 64;
    int* base = segcnt + 64;
    { const int e = c.tid & 63, p = c.tid >> 6; int s = 0;
      for (int v = 0; v < 32; ++v) s += BLKCNT[(p * 32 + v) * 64 + e];
      psum[p * 64 + e] = s; }
    __syncthreads();
    if (c.tid < 64) { int s = 0;
#pragma unroll
        for (int p = 0; p < 8; ++p) s += psum[p * 64 + c.tid];
        segcnt[c.tid] = s; }
    __syncthreads();
    if (c.tid < 64) { int s = 0; for (int e2 = 0; e2 < c.tid; ++e2) s += segcnt[e2]; segstart[c.tid] = s; }
    __syncthreads();
    if (c.blk == 0) {
        if (c.tid < 64) { SEG[c.tid * 2] = segstart[c.tid]; SEG[c.tid * 2 + 1] = segcnt[c.tid]; }
        if (c.tid == 64) { SEG[128] = NSLOT_R; SEG[129] = T; }
    }
    for (int vb = c.blk; vb < NVB; vb += c.G) {
        if (c.tid < 64) { const int e = c.tid, p = vb >> 5; int s = segstart[e];
            for (int p2 = 0; p2 < p; ++p2) s += psum[p2 * 64 + e];
            for (int v = p * 32; v < vb; ++v) s += BLKCNT[v * 64 + e];
            base[e] = s; }
        __syncthreads();
        { const int t = vb * 64 + (c.tid >> 3), k = c.tid & 7; const int pe = TOPE[t * 8 + k], e = pe & 255, lr = pe >> 8;
          const int slot = base[e] + lr;
          SLOTTOK[slot] = t; TOKSLOT[t * 8 + k] = slot; }
        __syncthreads();
    }
    if (c.blk < 256) {
        int* tpre = base + 64;
        __syncthreads();
        if (c.tid <= 65) { int sacc = 0; for (int e2 = 0; e2 < c.tid; ++e2) sacc += ((e2 < 64 ? segcnt[e2] : T) + 255) >> 8; tpre[c.tid] = sacc; }
        __syncthreads();
        const int ntile = tpre[65];
        if (c.blk == 0 && c.tid == 0) SEG[130] = ntile;
        int* UL = (int*)(a.ws + WS_ULIST);
        for (int v = 0; v < 2; ++v) { const int npn = v ? 4 : 2, nwg = ntile * npn;
            for (int i = 0; i < 48; ++i) { const int L = i * c.G + c.blk; if (L >= nwg) break;
                const int q = nwg / 8, r = nwg % 8, xcd = L % 8, off = L / 8; const int wgid = (xcd < r ? xcd * (q + 1) : r * (q + 1) + (xcd - r) * q) + off, tl = wgid / npn;
                if (c.tid < 65 && tpre[c.tid] <= tl && tl < tpre[c.tid + 1]) { const int e = c.tid, o2 = 256 * (tl - tpre[e]); const int st = e < 64 ? segstart[e] : NSLOT_R, cn = e < 64 ? segcnt[e] : T, rem = cn - o2;
                    int* u = UL + ((size_t)(v * 256 + c.blk) * 48 + i) * 4; u[0] = st + o2; u[1] = rem < 256 ? rem : 256; u[2] = wgid % npn; u[3] = e; } } }
    }
}

__device__ __forceinline__ void ph_combine(CArgs& a, const Ctx& c) {
    typedef float f32x2 __attribute__((ext_vector_type(2)));
    const unsigned char* Y = (const unsigned char*)(a.ws + WS_Y); const int* TOKSLOT = (const int*)(a.ws + WS_TOKSLOT); const float* MODS = (const float*)(a.ws + WS_MODS); const float* TOPW = (const float*)(a.ws + WS_TOPW);
    const int gw = c.blk * 8 + c.wave, NGW = c.G * 8;
    for (int t = gw; t < T; t += NGW) {
        const int b = t / NSEQ;
        float v[16];
#pragma unroll
        for (int j = 0; j < 16; ++j) v[j] = 0.f;
#pragma unroll
        for (int k = 0; k < 9; ++k) {
            const int r = (k < 8) ? TOKSLOT[t * 8 + k] : (NSLOT_R + t);
            const float wk = (k < 8) ? TOPW[t * 8 + k] : 1.f;
#pragma unroll
            for (int j = 0; j < 4; ++j) { const int w = *(const int*)(Y + (size_t)r * DM + 4 * c.lane + 256 * j);
                const f32x2 lo = __builtin_amdgcn_cvt_pk_f32_fp8(w, false), hi = __builtin_amdgcn_cvt_pk_f32_fp8(w, true);
                v[4 * j] = fmaf(wk, lo[0], v[4 * j]); v[4 * j + 1] = fmaf(wk, lo[1], v[4 * j + 1]); v[4 * j + 2] = fmaf(wk, hi[0], v[4 * j + 2]); v[4 * j + 3] = fmaf(wk, hi[1], v[4 * j + 3]); }
        }
        float ss = 0.f;
#pragma unroll
        for (int j = 0; j < 16; ++j) ss += v[j] * v[j];
        const float rs = rsqrtf(wave_sum(ss, c.lane) * (1.f / DM) + EPS);
        const float* md = MODS + (size_t)b * 6144 + 5120;
        const int lcol = 128 * ((c.lane & 3) >> 1) + 32 * (c.lane >> 4) + 8 * ((c.lane & 15) >> 2) + 4 * (c.lane & 1);
#pragma unroll
        for (int j = 0; j < 4; ++j) {
            const int col = lcol + 256 * j;
            const uint2 xw = *(const uint2*)((const bf16_t*)(a.ws + WS_X1B) + (size_t)t * DM + col); float4 x1; x1.x = bflo(xw.x); x1.y = bfhi(xw.x); x1.z = bflo(xw.y); x1.w = bfhi(xw.y);
            const float4 g = *(const float4*)(a.in[I_GPOSTFFN] + col), gf = *(const float4*)(md + col);
            x1.x += gf.x * (v[4 * j] * rs * g.x); x1.y += gf.y * (v[4 * j + 1] * rs * g.y); x1.z += gf.z * (v[4 * j + 2] * rs * g.z); x1.w += gf.w * (v[4 * j + 3] * rs * g.w);
            *(float4*)(a.out + (size_t)t * DM + col) = x1;
        }
    }
}

constexpr int LDS_TAB = 128 * 1024;
constexpr int LDS_OAN = 132 * 1024;
namespace pg8 {
typedef short bf16x8 __attribute__((ext_vector_type(8)));
typedef float f32x4 __attribute__((ext_vector_type(4)));
typedef unsigned u32x4 __attribute__((ext_vector_type(4)));
typedef unsigned u32x2 __attribute__((ext_vector_type(2)));
constexpr int BM = 256, BK = 64, HALF = 128, HTB = HALF * BK * 2, STAGE_BYTES = 8 * HTB;
__device__ __forceinline__ int lds_byte(int r, int c) { const int st = (r >> 4) * 2 + (c >> 5), rr = r & 15, cc = c & 31, ob = rr * 64 + cc * 2; return st * 1024 + (ob ^ (((ob >> 9) & 1) << 5)); }
__device__ __forceinline__ void stage_rc(int b, int& R, int& C) { const int st = b / 1024, sb = b % 1024, swz = sb ^ (((sb >> 9) & 1) << 5); R = (st >> 1) * 16 + swz / 64; C = (st & 1) * 32 + (swz % 64) / 2; }
__device__ __forceinline__ int perm32(int rho) { const int n = rho >> 4, i = rho & 15; return 8 * (i >> 2) + 4 * n + (i & 3); }
__device__ __forceinline__ int xcd_remap(int L, int nwg) { const int q = nwg / 8, r = nwg % 8, xcd = L % 8, off = L / 8; return (xcd < r ? xcd * (q + 1) : r * (q + 1) + (xcd - r) * q) + off; }
__device__ __forceinline__ unsigned cvt_pk_bf16(float lo, float hi) { unsigned r; asm volatile("v_cvt_pk_bf16_f32 %0, %1, %2" : "=v"(r) : "v"(lo), "v"(hi)); return r; }

struct Unit { int row0, nvalid, pn, aux, idx; };

template <class Epi, class Sched, bool ALIGN_EPI, int K, int REPK = 1>
__device__ __forceinline__ void gemm_phase(LAS unsigned char* lds, const Sched& S, const Epi& E, const int tid) {
    const int wid = __builtin_amdgcn_readfirstlane(tid >> 6), lane = tid & 63, wr = wid >> 2, wc = wid & 3, fr = lane & 15, fq = lane >> 4;
    constexpr int nt = K / BK;
    unsigned voffB[2];
#pragma unroll
    for (int i = 0; i < 2; ++i) { int R, C; stage_rc(tid * 16 + i * 8192, R, C); const int Rb = Epi::PERM ? ((R & ~31) + perm32(R & 31)) : R;
        voffB[i] = (unsigned)(Rb * K + C) * 2u; }
    LAS u32x4* const oAnL = (LAS u32x4*)(lds + LDS_OAN) + tid;
    const size_t kstep = (size_t)(BK * 2);
    const size_t hstepB = (size_t)HALF * K * 2;
    const unsigned ldsw = (unsigned)wid * 1024u;
    const int aoff = lds_byte(wr * 64 + fr, fq * 8), boff = lds_byte(wc * 32 + fr, fq * 8);
#define PG8_SA(b, h) (((b) * 2 + (h)) * HTB)
#define PG8_SB(b, h) ((4 + (b) * 2 + (h)) * HTB)
#define PG8_STAGE(bufoff, gbase, voff) do { _Pragma("unroll") for (int _i = 0; _i < 2; ++_i) \
        __builtin_amdgcn_global_load_lds((const unsigned*)((const char*)(gbase) + (voff)[_i]), (LAS unsigned*)(lds + (bufoff) + ldsw + _i * 8192), 16, 0, 0); } while (0)
#define PG8_LDA(dst, b, h) do { _Pragma("unroll") for (int m = 0; m < 4; ++m) _Pragma("unroll") for (int k = 0; k < 2; ++k) dst[m][k] = *(const LAS bf16x8*)(lds + PG8_SA(b, h) + aoff + m * 2048 + k * 1024); } while (0)
#define PG8_LDB(dst, b, h) do { _Pragma("unroll") for (int n = 0; n < 2; ++n) _Pragma("unroll") for (int k = 0; k < 2; ++k) dst[n][k] = *(const LAS bf16x8*)(lds + PG8_SB(b, h) + boff + n * 2048 + k * 1024); } while (0)
#define PG8_MMA(ai, bj, At, Bt) do { __builtin_amdgcn_s_setprio(1); _Pragma("unroll") for (int m = 0; m < 4; ++m) _Pragma("unroll") for (int n = 0; n < 2; ++n) _Pragma("unroll") for (int k = 0; k < 2; ++k) \
        acc[ai][bj][m][n] = __builtin_amdgcn_mfma_f32_16x16x32_bf16(Bt[n][k], At[m][k], acc[ai][bj][m][n], 0, 0, 0); __builtin_amdgcn_s_setprio(0); } while (0)
#define PG8_WAIT_V(n) asm volatile("s_waitcnt vmcnt(" #n ")" ::: "memory")
#define PG8_WAIT_L(n) asm volatile("s_waitcnt lgkmcnt(" #n ")" ::: "memory")
#define PG8_BAR __builtin_amdgcn_s_barrier()
#define PG8_SCHED __builtin_amdgcn_sched_barrier(0)
    Unit cur, nxt; int ui = 0;
    if (!S.next(0, cur)) return;
    f32x4 acc[2][2][4][2];
#pragma unroll
    for (int a = 0; a < 2; ++a)
#pragma unroll
        for (int b = 0; b < 2; ++b)
#pragma unroll
            for (int m = 0; m < 4; ++m)
#pragma unroll
                for (int n = 0; n < 2; ++n) acc[a][b][m][n] = (f32x4){0.f, 0.f, 0.f, 0.f};
    bf16x8 At[4][2], B0[2][2], B1[2][2];
    unsigned oAc[2][2];
    S.a_off(cur, tid, oAc);
    const char* const Ab = S.a_base();
    const char* cB = S.b_base(cur);
    PG8_STAGE(PG8_SB(0, 0), cB, voffB); PG8_STAGE(PG8_SB(0, 1), cB + hstepB, voffB); PG8_STAGE(PG8_SA(0, 0), Ab, oAc[0]); PG8_STAGE(PG8_SA(0, 1), Ab, oAc[1]);
    if (wr == 1) PG8_BAR;
    PG8_WAIT_V(2); PG8_BAR;
    PG8_STAGE(PG8_SB(1, 0), cB + kstep, voffB); PG8_STAGE(PG8_SA(1, 0), Ab + kstep, oAc[0]); PG8_STAGE(PG8_SB(1, 1), cB + hstepB + kstep, voffB);
    PG8_WAIT_V(6); PG8_BAR;
    for (;;) {
        const bool has_next = S.next(ui + 1, nxt);
        if (has_next) { unsigned t_[2][2]; S.a_off(nxt, tid, t_); *oAnL = (u32x4){t_[0][0], t_[0][1], t_[1][0], t_[1][1]}; }
        const char* nB = has_next ? S.b_base(nxt) : cB;
#pragma unroll 1
        for (int tt = 0; tt < nt * REPK; tt += 2) {
            const int t = (REPK == 1) ? tt : tt % nt;
            const bool wrap = (t == nt - 2), last = (tt == nt * REPK - 2);
            const char* a1 = Ab + (size_t)(t + 1) * kstep;
            const char* a2 = wrap ? Ab : Ab + (size_t)(t + 2) * kstep; const char* b2 = last ? nB : (wrap ? cB : cB + (size_t)(t + 2) * kstep);
            const char* a3 = a2 + kstep; const char* b3 = b2 + kstep;
            PG8_LDB(B0, 0, 0); PG8_LDB(B1, 0, 1); PG8_SCHED; PG8_LDA(At, 0, 0); PG8_STAGE(PG8_SA(1, 1), a1, oAc[1]);
            if (last && has_next) { const u32x4 q = *oAnL; oAc[0][0] = q.x; oAc[0][1] = q.y; oAc[1][0] = q.z; oAc[1][1] = q.w; }
            PG8_WAIT_V(8); PG8_WAIT_L(0); PG8_BAR; PG8_MMA(0, 0, At, B0); PG8_MMA(0, 1, At, B1); PG8_BAR; PG8_SCHED;
            PG8_LDA(At, 0, 1); PG8_STAGE(PG8_SB(0, 0), b2, voffB); PG8_STAGE(PG8_SB(0, 1), b2 + hstepB, voffB); PG8_STAGE(PG8_SA(0, 0), a2, oAc[0]);
            PG8_WAIT_V(8); PG8_WAIT_L(0); PG8_BAR; PG8_MMA(1, 0, At, B0); PG8_MMA(1, 1, At, B1); PG8_BAR; PG8_SCHED;
            PG8_LDB(B0, 1, 0); PG8_LDB(B1, 1, 1); PG8_SCHED; PG8_LDA(At, 1, 0); PG8_STAGE(PG8_SA(0, 1), a2, oAc[1]);
            PG8_WAIT_V(8); PG8_WAIT_L(0); PG8_BAR; PG8_MMA(0, 0, At, B0); PG8_MMA(0, 1, At, B1); PG8_BAR; PG8_SCHED;
            PG8_LDA(At, 1, 1); PG8_STAGE(PG8_SB(1, 0), b3, voffB); PG8_STAGE(PG8_SB(1, 1), b3 + hstepB, voffB); PG8_STAGE(PG8_SA(1, 0), a3, oAc[0]);
            PG8_WAIT_V(8); PG8_WAIT_L(0); PG8_BAR; PG8_MMA(1, 0, At, B0); PG8_MMA(1, 1, At, B1); PG8_BAR; PG8_SCHED;
        }
        if constexpr (ALIGN_EPI) { if (wr == 0) PG8_BAR; }
        if constexpr (REPK > 1) {
#pragma unroll
            for (int a = 0; a < 2; ++a)
#pragma unroll
                for (int b = 0; b < 2; ++b)
#pragma unroll
                    for (int m = 0; m < 4; ++m)
#pragma unroll
                        for (int n = 0; n < 2; ++n) acc[a][b][m][n] *= (1.f / REPK); }
        E(acc, cur, wr, wc, fr, fq);
        if (!has_next) break;
#pragma unroll
        for (int a = 0; a < 2; ++a)
#pragma unroll
            for (int b = 0; b < 2; ++b)
#pragma unroll
                for (int m = 0; m < 4; ++m)
#pragma unroll
                    for (int n = 0; n < 2; ++n) acc[a][b][m][n] = (f32x4){0.f, 0.f, 0.f, 0.f};
        cur = nxt; cB = nB; ++ui;
        if constexpr (ALIGN_EPI) { if (wr == 1) PG8_BAR; }
    }
    PG8_WAIT_V(0);
    if constexpr (!ALIGN_EPI) { if (wr == 0) PG8_BAR; }
    PG8_BAR;
#undef PG8_SA
#undef PG8_SB
#undef PG8_STAGE
#undef PG8_LDA
#undef PG8_LDB
#undef PG8_MMA
#undef PG8_WAIT_V
#undef PG8_WAIT_L
#undef PG8_BAR
#undef PG8_SCHED
}

struct DenseSched {
    const char* A; const char* Bt; int nN, nwg, G, c, nmain;
    __device__ __forceinline__ bool next(int i, Unit& u) const {
        const int L = i * G + c; if (L >= nwg) return false;
        const int wgid = xcd_remap(L, nwg);
        if (wgid < nmain) { const int nig = 8 * nN, gid = wgid / nig, w = wgid % nig; u.row0 = 256 * (gid * 8 + (w % 8)); u.pn = w / 8; }
        else { const int j = wgid - nmain; u.row0 = T + 256 * (j >> 2); u.pn = 2 + (j & 3); }
        u.nvalid = 256; u.aux = 0; u.idx = i; return true;
    }
    __device__ __forceinline__ const char* a_base() const { return A; }
    __device__ __forceinline__ const char* b_base(const Unit& u) const { return Bt + (size_t)u.pn * 256 * DM * 2; }
    __device__ __forceinline__ void a_off(const Unit& u, int tid, unsigned (&o)[2][2]) const {
#pragma unroll
        for (int i = 0; i < 2; ++i) { int R, C; stage_rc(tid * 16 + i * 8192, R, C);
#pragma unroll
            for (int h = 0; h < 2; ++h) o[h][i] = (unsigned)((u.row0 + 128 * h + R) * DM + C) * 2u; }
    }
};
constexpr int GT_MAXSEG = 132, GT_ULIST = 768, GT_MAXU = 48;
struct GroupedSched {
    const char* A; const char* Bt; const int* slottok; const LAS int* tab; int nseg, npn, nwg, G, c, K, brows; const LAS int* tokl;
    __device__ __forceinline__ bool next(int i, Unit& u) const {
        const int L = i * G + c; if (L >= nwg) return false;
        u.idx = i;
        if (i < GT_MAXU) { const LAS int* q = tab + GT_ULIST + 4 * i; u.row0 = q[0]; u.nvalid = q[1]; u.pn = q[2]; u.aux = q[3]; return true; }
        const int wgid = xcd_remap(L, nwg), tl = wgid / npn; u.pn = wgid % npn;
        int s = 0; while (tab[s + 1] <= tl) ++s;
        const int off = 256 * (tl - tab[s]);
        u.row0 = tab[GT_MAXSEG + s] + off; const int rem = tab[2 * GT_MAXSEG + s] - off; u.nvalid = rem < 256 ? rem : 256; u.aux = tab[3 * GT_MAXSEG + s];
        return true;
    }
    __device__ __forceinline__ const char* a_base() const { return A; }
    __device__ __forceinline__ const char* b_base(const Unit& u) const { return Bt + ((size_t)u.aux * brows + (size_t)u.pn * 256) * K * 2; }
    __device__ __forceinline__ void a_off(const Unit& u, int tid, unsigned (&o)[2][2]) const {
#pragma unroll
        for (int i = 0; i < 2; ++i) { int R, C; stage_rc(tid * 16 + i * 8192, R, C);
#pragma unroll
            for (int h = 0; h < 2; ++h) {
                int r = 128 * h + R;
                if (slottok) { int tok; if (u.idx < 8) tok = tokl[u.idx * 256 + r];
                    else { if (r >= u.nvalid) r = u.nvalid - 1; const int slot = u.row0 + r; tok = (u.aux < 64) ? slottok[slot] : slot - NSLOT_R; }
                    o[h][i] = (unsigned)(tok * K + C) * 2u; }
                else o[h][i] = (unsigned)((u.row0 + r) * K + C) * 2u;
            } }
    }
};
__device__ __forceinline__ int grouped_table(LAS int* tab, const int* SEG, const int tid) {
    constexpr int nseg = 65;
    if (tid < nseg) { const int e = tid; const int st = SEG[e * 2], cn = SEG[e * 2 + 1];
        tab[GT_MAXSEG + tid] = st; tab[2 * GT_MAXSEG + tid] = cn; tab[3 * GT_MAXSEG + tid] = e; tab[4 * GT_MAXSEG + tid] = (cn + 255) >> 8; }
    __syncthreads();
    if (tid <= nseg) { int s = 0; for (int j = 0; j < tid; ++j) s += tab[4 * GT_MAXSEG + j]; tab[tid] = s; }
    __syncthreads();
    return tab[nseg];
}

__device__ __forceinline__ void grouped_units(LAS int* tab, int npn, int nwg, int G, int c, const int tid) {
    constexpr int nseg = 65;
    for (int i = 0; i < GT_MAXU; ++i) { const int L = i * G + c; if (L >= nwg) break;
        const int wgid = xcd_remap(L, nwg), tl = wgid / npn;
        if (tid < nseg && tab[tid] <= tl && tl < tab[tid + 1]) { const int off = 256 * (tl - tab[tid]); const int rem = tab[2 * GT_MAXSEG + tid] - off;
            LAS int* q = tab + GT_ULIST + 4 * i; q[0] = tab[GT_MAXSEG + tid] + off; q[1] = rem < 256 ? rem : 256; q[2] = wgid % npn; q[3] = tab[3 * GT_MAXSEG + tid]; } }
    __syncthreads();
}

struct EpiStore {
    static constexpr bool PERM = true;
    bf16_t* C; int ldc; int rowsub, rowsub_sh;
    __device__ __forceinline__ void operator()(const f32x4 (&acc)[2][2][4][2], const Unit& u, int wr, int wc, int fr, int fq) const {
        const int col0 = u.pn * 256 + wc * 32 + 8 * fq, crow0 = u.row0 - (u.aux < 64 ? rowsub : rowsub_sh);
        int rb = wr * 64 + fr; asm volatile("" : "+v"(rb));
#pragma unroll
        for (int ai = 0; ai < 2; ++ai)
#pragma unroll
            for (int m = 0; m < 4; ++m) { const int r = ai * 128 + m * 16 + rb;
                if (r < u.nvalid) { bf16_t* rowp = C + (size_t)(crow0 + r) * ldc + col0;
#pragma unroll
                    for (int bj = 0; bj < 2; ++bj) { const f32x4 v0 = acc[ai][bj][m][0], v1 = acc[ai][bj][m][1];
                        u32x4 w; w.x = cvt_pk_bf16(v0[0], v0[1]); w.y = cvt_pk_bf16(v0[2], v0[3]); w.z = cvt_pk_bf16(v1[0], v1[1]); w.w = cvt_pk_bf16(v1[2], v1[3]);
                        *(u32x4*)(rowp + bj * 128) = w; } } }
    }
};
struct EpiStoreFp8 {
    static constexpr bool PERM = true;
    unsigned char* C;
    __device__ __forceinline__ void operator()(const f32x4 (&acc)[2][2][4][2], const Unit& u, int wr, int wc, int fr, int fq) const {
        const int col0 = u.pn * 256 + wc * 64 + 16 * fq;
        int rb = wr * 64 + fr; asm volatile("" : "+v"(rb));
#pragma unroll
        for (int ai = 0; ai < 2; ++ai)
#pragma unroll
            for (int m = 0; m < 4; ++m) { const int r = ai * 128 + m * 16 + rb;
                if (r < u.nvalid) { u32x4 w;
#pragma unroll
                    for (int bj = 0; bj < 2; ++bj) { const f32x4 v0 = acc[ai][bj][m][0], v1 = acc[ai][bj][m][1];
                        int w0 = __builtin_amdgcn_cvt_pk_fp8_f32(v0[0], v0[1], 0, false); w0 = __builtin_amdgcn_cvt_pk_fp8_f32(v0[2], v0[3], w0, true);
                        int w1 = __builtin_amdgcn_cvt_pk_fp8_f32(v1[0], v1[1], 0, false); w1 = __builtin_amdgcn_cvt_pk_fp8_f32(v1[2], v1[3], w1, true);
                        if (bj == 0) { w.x = (unsigned)w0; w.y = (unsigned)w1; } else { w.z = (unsigned)w0; w.w = (unsigned)w1; } }
                    *(u32x4*)(C + (size_t)(u.row0 + r) * DM + col0) = w; } }
    }
};
struct EpiGateUp {
    static constexpr bool PERM = true;
    bf16_t* ACT;
    __device__ __forceinline__ void operator()(const f32x4 (&acc)[2][2][4][2], const Unit& u, int wr, int wc, int fr, int fq) const {
        const int col0 = u.pn * 128 + wc * 32 + 8 * fq;
        int rb = wr * 64 + fr; asm volatile("" : "+v"(rb));
#pragma unroll
        for (int ai = 0; ai < 2; ++ai)
#pragma unroll
            for (int m = 0; m < 4; ++m) { const int r = ai * 128 + m * 16 + rb;
                if (r < u.nvalid) { const int slot = u.row0 + r;
                    float o[8];
#pragma unroll
                    for (int n = 0; n < 2; ++n)
#pragma unroll
                        for (int i = 0; i < 4; ++i) { const float g = acc[ai][0][m][n][i], up = acc[ai][1][m][n][i]; o[4 * n + i] = g / (1.f + __expf(-g)) * up; }
                    u32x4 pk; pk.x = cvt_pk_bf16(o[0], o[1]); pk.y = cvt_pk_bf16(o[2], o[3]); pk.z = cvt_pk_bf16(o[4], o[5]); pk.w = cvt_pk_bf16(o[6], o[7]);
                    *(u32x4*)(ACT + (size_t)slot * FF + col0) = pk; } }
    }
};
constexpr float QSCALE = 0.125f * 1.4426950408889634f;
struct EpiInProj {
    static constexpr bool PERM = false;
    bf16_t *Q, *Kb, *Vb, *P; const LAS float* rope;
    __device__ __forceinline__ void operator()(const f32x4 (&acc)[2][2][4][2], const Unit& u, int wr, int wc, int fr, int fq) const {
        const bool latent = u.row0 < T; const int sec = u.pn >> 1;
        const bool dorope = latent && sec < 2;
        bf16_t* dstU; int n0 = 0;
        if (latent) { const int b = u.row0 / NSEQ; n0 = u.row0 % NSEQ; const size_t kvrow = (size_t)b * SKV + CTXL + n0;
            dstU = sec == 0 ? Q + (size_t)u.row0 * AW : sec == 1 ? Kb + kvrow * AW : sec == 2 ? Vb + kvrow * AW : P + (size_t)u.row0 * PW; }
        else { const int b = (u.row0 - T) / CTXL; dstU = (sec == 1 ? Kb : Vb) + (size_t)b * SKV * AW; }
        dstU += (u.pn & 1) * 256;
        int rb = wr * 64 + fr; asm volatile("" : "+v"(rb));
        const int lcol = wc * 32 + 4 * fq;
#pragma unroll
        for (int ai = 0; ai < 2; ++ai)
#pragma unroll
            for (int m = 0; m < 4; ++m) {
                const int r = ai * 128 + m * 16 + rb;
                f32x4 c4 = (f32x4){1.f, 1.f, 1.f, 1.f}, s4 = (f32x4){0.f, 0.f, 0.f, 0.f};
                if (dorope) { const int pos = (wc & 1) ? (r & 63) : ((n0 >> 6) + (r >> 6)); const LAS float* rp = rope + (pos * 16 + 4 * fq) * 2;
                    const f32x4 cs0 = *(const LAS f32x4*)rp, cs1 = *(const LAS f32x4*)(rp + 4); c4 = (f32x4){cs0[0], cs0[2], cs1[0], cs1[2]}; s4 = (f32x4){cs0[1], cs0[3], cs1[1], cs1[3]}; }
                bf16_t* dst = dstU + r * 512 + lcol;
#pragma unroll
                for (int bj = 0; bj < 2; ++bj) {
                    const f32x4 x1 = acc[ai][bj][m][0], x2 = acc[ai][bj][m][1];
                    f32x4 o1 = x1 * c4 - x2 * s4, o2 = x2 * c4 + x1 * s4;
                    if (sec == 0) { o1 *= QSCALE; o2 *= QSCALE; }
                    u32x2 w1, w2; w1.x = cvt_pk_bf16(o1[0], o1[1]); w1.y = cvt_pk_bf16(o1[2], o1[3]); w2.x = cvt_pk_bf16(o2[0], o2[1]); w2.y = cvt_pk_bf16(o2[2], o2[3]);
                    *(u32x2*)(dst + bj * 128) = w1; *(u32x2*)(dst + bj * 128 + 16) = w2;
                }
            }
    }
};
}

__device__ __forceinline__ void ph_inproj_fast(CArgs& a, const Ctx& c) {
    pg8::DenseSched S{(const char*)(a.ws + WS_HX), (const char*)(a.ws + WS_WIN), 8, 528, c.G, c.blk, 512};
    LAS float* ropeL = (LAS float*)((LAS unsigned char*)c.lds + LDS_ROPE);
    { const float4 v = *(const float4*)((const float*)(a.ws + WS_ROPE) + 4 * c.tid); ropeL[4 * c.tid] = v.x; ropeL[4 * c.tid + 1] = v.y; ropeL[4 * c.tid + 2] = v.z; ropeL[4 * c.tid + 3] = v.w; }
    __syncthreads();
    pg8::EpiInProj E{(bf16_t*)(a.ws + WS_Q), (bf16_t*)(a.ws + WS_K), (bf16_t*)(a.ws + WS_V), (bf16_t*)(a.ws + WS_P), ropeL};
    pg8::gemm_phase<pg8::EpiInProj, pg8::DenseSched, true, DM>((LAS unsigned char*)c.lds, S, E, c.tid);
    { constexpr int NWG = 528; const int maxu = (NWG + c.G - 1) / c.G, nlast = NWG - (maxu - 1) * c.G;
      if (nlast < c.G) { if (c.blk >= nlast) { __syncthreads(); ph_transposes(a, c, TR_NIT - TR_NFILL, TR_NIT, (c.blk - nlast) * 8 + c.wave, (c.G - nlast) * 8); } }
      else ph_transposes(a, c, TR_NIT - TR_NFILL, TR_NIT, c.blk * 8 + c.wave, c.G * 8); }
}
__device__ __forceinline__ void ph_outproj_fast(CArgs& a, const Ctx& c) {
    pg8::DenseSched S{(const char*)(a.ws + WS_ATT), (const char*)(a.ws + WS_WOUT), 4, 256, c.G, c.blk, 256};
    pg8::EpiStore E{(bf16_t*)(a.ws + WS_YX), DM, 0, 0};
    pg8::gemm_phase<pg8::EpiStore, pg8::DenseSched, true, DM>((LAS unsigned char*)c.lds, S, E, c.tid);
}
__device__ __forceinline__ void ph_gateup_fast(CArgs& a, const Ctx& c) {
    LAS int* tab = (LAS int*)((LAS unsigned char*)c.lds + LDS_TAB);
    const int ntile = ((const int*)(a.ws + WS_SEG))[130];
    if ((ntile * 2 + c.G - 1) / c.G > pg8::GT_MAXU || c.blk >= 256) { pg8::grouped_table(tab, (const int*)(a.ws + WS_SEG), c.tid); pg8::grouped_units(tab, 2, ntile * 2, c.G, c.blk, c.tid); }
    else { if (c.tid < 48) { const uint4 q_ = *((const uint4*)(a.ws + WS_ULIST) + (size_t)(0 * 256 + c.blk) * 48 + c.tid); LAS int* d_ = tab + pg8::GT_ULIST + 4 * c.tid; d_[0] = (int)q_.x; d_[1] = (int)q_.y; d_[2] = (int)q_.z; d_[3] = (int)q_.w; } __syncthreads(); }
    LAS int* tokl = (LAS int*)((LAS unsigned char*)c.lds + LDS_TOKL);
    { const int* SLOTTOK = (const int*)(a.ws + WS_SLOTTOK);
      for (int q = c.tid; q < 8 * 256; q += 512) { const int i = q >> 8, r = q & 255;
          if (i * c.G + c.blk < ntile * 2) { const LAS int* ul = tab + pg8::GT_ULIST + 4 * i; const int row0 = ul[0], nv = ul[1], e = ul[3];
              const int slot = row0 + (r < nv ? r : nv - 1); tokl[q] = (e < 64) ? SLOTTOK[slot] : slot - NSLOT_R; } }
      __syncthreads(); }
    pg8::GroupedSched S{(const char*)(a.ws + WS_HX), (const char*)(a.ws + WS_WGU), (const int*)(a.ws + WS_SLOTTOK), tab, 65, 2, ntile * 2, c.G, c.blk, DM, 512, tokl};
    pg8::EpiGateUp E{(bf16_t*)(a.ws + WS_ACT)};
    pg8::gemm_phase<pg8::EpiGateUp, pg8::GroupedSched, true, DM, REPK_GU>((LAS unsigned char*)c.lds, S, E, c.tid);
}
__device__ __forceinline__ void ph_down_fast(CArgs& a, const Ctx& c) {
    LAS int* tab = (LAS int*)((LAS unsigned char*)c.lds + LDS_TAB);
    const int ntile = ((const int*)(a.ws + WS_SEG))[130];
    if ((ntile * 4 + c.G - 1) / c.G > pg8::GT_MAXU || c.blk >= 256) { pg8::grouped_table(tab, (const int*)(a.ws + WS_SEG), c.tid); pg8::grouped_units(tab, 4, ntile * 4, c.G, c.blk, c.tid); }
    else { if (c.tid < 48) { const uint4 q_ = *((const uint4*)(a.ws + WS_ULIST) + (size_t)(1 * 256 + c.blk) * 48 + c.tid); LAS int* d_ = tab + pg8::GT_ULIST + 4 * c.tid; d_[0] = (int)q_.x; d_[1] = (int)q_.y; d_[2] = (int)q_.z; d_[3] = (int)q_.w; } __syncthreads(); }
    pg8::GroupedSched S{(const char*)(a.ws + WS_ACT), (const char*)(a.ws + WS_WD), nullptr, tab, 65, 4, ntile * 4, c.G, c.blk, FF, DM, nullptr};
    pg8::EpiStoreFp8 E{(unsigned char*)(a.ws + WS_Y)};
    pg8::gemm_phase<pg8::EpiStoreFp8, pg8::GroupedSched, true, FF, REPK_DOWN>((LAS unsigned char*)c.lds, S, E, c.tid);
}

namespace att {
using bf16x8 = __attribute__((ext_vector_type(8))) short;
using s16x4  = __attribute__((ext_vector_type(4))) short;
using f32x16 = __attribute__((ext_vector_type(16))) float;
using u32x4  = __attribute__((ext_vector_type(4))) unsigned;
constexpr int KVBLK = 64, LDK = 512;
constexpr float SCALE = 0.125f, THR = 8.f;
constexpr int SHM_V = KVBLK * 128 * 2, SHM_K = KVBLK * 128 * 2, NBUF = 3, OFF_WS = NBUF * (SHM_V + SHM_K);
#define KSWZ(row, colB) ((row) * 256 + ((colB) ^ (((row) & 7) << 4)))
#define SBAR() __builtin_amdgcn_sched_barrier(0)
__device__ __forceinline__ int crow(int r, int hi) { return (r & 3) + 8 * (r >> 2) + 4 * hi; }
__device__ __forceinline__ unsigned cvtpk(float lo, float hi) { unsigned r; asm volatile("v_cvt_pk_bf16_f32 %0, %1, %2" : "=v"(r) : "v"(lo), "v"(hi)); return r; }
__device__ __forceinline__ float max3f(float a, float b, float c) { return __builtin_fmaxf(__builtin_fmaxf(a, b), c); }
__device__ __forceinline__ void partialSM(f32x16& p0, f32x16& p1, f32x16& negm, const bool first, float& alpha) {
  constexpr float THR2 = THR * 1.4426950408889634f;
  float a = max3f(p0[0], p0[1], p1[0]), b = max3f(p0[2], p0[3], p1[1]); a = max3f(a, p1[2], p1[3]);
#pragma unroll
  for (int r = 4; r < 16; r += 4) { a = max3f(a, p0[r], p0[r + 1]); b = max3f(b, p0[r + 2], p0[r + 3]); a = max3f(a, p1[r], p1[r + 1]); b = max3f(b, p1[r + 2], p1[r + 3]); }
  float pmax = fmaxf(a, b);
  { auto rr = __builtin_amdgcn_permlane32_swap(__float_as_uint(pmax), __float_as_uint(pmax), false, false);
    pmax = fmaxf(__uint_as_float(rr[0]), __uint_as_float(rr[1])); }
  if (__builtin_expect(!first && __all(pmax <= THR2), 1)) { alpha = 1.f; }
  else { const float delta = first ? pmax : fmaxf(pmax, 0.f); alpha = __builtin_amdgcn_exp2f(-delta);
#pragma unroll
    for (int r = 0; r < 16; ++r) { p0[r] -= delta; p1[r] -= delta; negm[r] -= delta; } }
#pragma unroll
  for (int r = 0; r < 16; ++r) p0[r] = __builtin_amdgcn_exp2f(p0[r]);
}
__device__ __forceinline__ void finishSM(f32x16& p0, f32x16& p1, float alpha, float& l_reg, bf16x8& pa0, bf16x8& pa1, bf16x8& pa2, bf16x8& pa3) {
#pragma unroll
  for (int r = 0; r < 16; ++r) p1[r] = __builtin_amdgcn_exp2f(p1[r]);
  float ps = 0;
#pragma unroll
  for (int r = 0; r < 16; ++r) ps += p0[r];
#pragma unroll
  for (int r = 0; r < 16; ++r) ps += p1[r];
  { auto rr = __builtin_amdgcn_permlane32_swap(__float_as_uint(ps), __float_as_uint(ps), false, false);
    ps = __uint_as_float(rr[0]) + __uint_as_float(rr[1]); }
  l_reg = l_reg * alpha + ps;
#define PK4(P, BASE, OUT) do { unsigned a0 = cvtpk(P[BASE + 0], P[BASE + 1]), a1 = cvtpk(P[BASE + 2], P[BASE + 3]);   \
    unsigned b0 = cvtpk(P[BASE + 4], P[BASE + 5]), b1 = cvtpk(P[BASE + 6], P[BASE + 7]);                              \
    auto r0 = __builtin_amdgcn_permlane32_swap(a0, b0, false, false); auto r1 = __builtin_amdgcn_permlane32_swap(a1, b1, false, false); \
    u32x4 w = {r0[0], r1[0], r0[1], r1[1]}; OUT = *reinterpret_cast<bf16x8*>(&w); } while (0)
  PK4(p0, 0, pa0); PK4(p0, 8, pa1); PK4(p1, 0, pa2); PK4(p1, 8, pa3);
#undef PK4
}
__device__ __forceinline__ void qkt(f32x16& p0, f32x16& p1, const char* Ks, const bf16x8* qr, int r32, int hi, int mcol, const f32x16& negm) {
  p0 = negm; p1 = negm;
#pragma unroll
  for (int d0 = 0; d0 < 4; ++d0) { const int cb = (mcol + d0 * 16 + hi * 8) * 2;
    const bf16x8 b0 = *reinterpret_cast<const bf16x8*>(Ks + KSWZ(r32, cb));
    const bf16x8 b1 = *reinterpret_cast<const bf16x8*>(Ks + KSWZ(32 + r32, cb));
    p0 = __builtin_amdgcn_mfma_f32_32x32x16_bf16(b0, qr[d0], p0, 0, 0, 0);
    p1 = __builtin_amdgcn_mfma_f32_32x32x16_bf16(b1, qr[d0], p1, 0, 0, 0); }
}
__device__ __forceinline__ int v_st(int k, int c) { const int kk = (k & ~0xC) | ((k & 4) << 1) | ((k & 8) >> 1); return ((kk >> 3) * 4 + (c >> 5)) * 512 + ((kk & 7) * 32 + (c & 31)) * 2; }
__device__ __forceinline__ int v_rd_base(int lane) { return ((lane & 3) << 3) | (((lane >> 2) & 3) << 6) | (((lane >> 4) & 1) << 5) | (((lane >> 5) & 1) << 8); }
constexpr int v_rd_off(int d0, int ks, int half) { return d0 * 512 + ks * 4096 + half * 2048; }
template <int OFF> __device__ __forceinline__ s16x4 tr_read(int vb) {
  s16x4 r; asm volatile("ds_read_b64_tr_b16 %0, %1 offset:%2" : "=&v"(r) : "v"(vb), "i"(OFF) : "memory"); return r;
}
template <int D0> __device__ __forceinline__ void pv_one(f32x16& od, int vb, bf16x8 pa0, bf16x8 pa1, bf16x8 pa2, bf16x8 pa3) {
  const s16x4 l0 = tr_read<v_rd_off(D0, 0, 0)>(vb), h0 = tr_read<v_rd_off(D0, 0, 1)>(vb), l1 = tr_read<v_rd_off(D0, 1, 0)>(vb), h1 = tr_read<v_rd_off(D0, 1, 1)>(vb);
  const s16x4 l2 = tr_read<v_rd_off(D0, 2, 0)>(vb), h2 = tr_read<v_rd_off(D0, 2, 1)>(vb), l3 = tr_read<v_rd_off(D0, 3, 0)>(vb), h3 = tr_read<v_rd_off(D0, 3, 1)>(vb);
  asm volatile("s_waitcnt lgkmcnt(0)" ::: "memory"); SBAR();
#define PK(L, H) (bf16x8){L[0], L[1], L[2], L[3], H[0], H[1], H[2], H[3]}
  od = __builtin_amdgcn_mfma_f32_32x32x16_bf16(pa0, PK(l0, h0), od, 0, 0, 0);
  od = __builtin_amdgcn_mfma_f32_32x32x16_bf16(pa1, PK(l1, h1), od, 0, 0, 0);
  od = __builtin_amdgcn_mfma_f32_32x32x16_bf16(pa2, PK(l2, h2), od, 0, 0, 0);
  od = __builtin_amdgcn_mfma_f32_32x32x16_bf16(pa3, PK(l3, h3), od, 0, 0, 0);
#undef PK
}
__device__ __forceinline__ void pv_d0(f32x16* o, int vb, bf16x8 pa0, bf16x8 pa1, bf16x8 pa2, bf16x8 pa3) {
  pv_one<0>(o[0], vb, pa0, pa1, pa2, pa3); pv_one<1>(o[1], vb, pa0, pa1, pa2, pa3); pv_one<2>(o[2], vb, pa0, pa1, pa2, pa3); pv_one<3>(o[3], vb, pa0, pa1, pa2, pa3);
}
__device__ __forceinline__ void pv_sm(f32x16* o, int vb, bf16x8 pa0, bf16x8 pa1, bf16x8 pa2, bf16x8 pa3, f32x16& p0, f32x16& p1, f32x16& negm, float& alpha) {
  constexpr float THR2 = THR * 1.4426950408889634f;
  pv_one<0>(o[0], vb, pa0, pa1, pa2, pa3);
  float a = max3f(p0[0], p0[1], p1[0]), b = max3f(p0[2], p0[3], p1[1]); a = max3f(a, p1[2], p1[3]);
#pragma unroll
  for (int r = 4; r < 16; r += 4) { a = max3f(a, p0[r], p0[r + 1]); b = max3f(b, p0[r + 2], p0[r + 3]); a = max3f(a, p1[r], p1[r + 1]); b = max3f(b, p1[r + 2], p1[r + 3]); }
  float pmax = fmaxf(a, b);
  pv_one<1>(o[1], vb, pa0, pa1, pa2, pa3);
  { auto rr = __builtin_amdgcn_permlane32_swap(__float_as_uint(pmax), __float_as_uint(pmax), false, false);
    pmax = fmaxf(__uint_as_float(rr[0]), __uint_as_float(rr[1])); }
  if (__builtin_expect(__all(pmax <= THR2), 1)) { alpha = 1.f; }
  else { const float delta = fmaxf(pmax, 0.f); alpha = __builtin_amdgcn_exp2f(-delta);
#pragma unroll
    for (int r = 0; r < 16; ++r) { p0[r] -= delta; p1[r] -= delta; negm[r] -= delta; } }
  pv_one<2>(o[2], vb, pa0, pa1, pa2, pa3);
#pragma unroll
  for (int r = 0; r < 8; ++r) p0[r] = __builtin_amdgcn_exp2f(p0[r]);
  pv_one<3>(o[3], vb, pa0, pa1, pa2, pa3);
#pragma unroll
  for (int r = 8; r < 16; ++r) p0[r] = __builtin_amdgcn_exp2f(p0[r]);
}
__device__ __forceinline__ void unit(const bf16_t* __restrict__ Qb, const bf16_t* __restrict__ Kh, const bf16_t* __restrict__ Vh, bf16_t* __restrict__ Ob,
                                     const float lam, const float* __restrict__ gsub, char* lds, const int tid) {
  const int wid = __builtin_amdgcn_readfirstlane(tid >> 6), lane = tid & 63, r32 = lane & 31, hi = lane >> 5, qsub = wid & 3, map = wid >> 2, mcol = map * 64;
  char* V_lds = lds; char* K_lds = lds + NBUF * SHM_V;
  float* ws = (float*)(lds + OFF_WS) + wid * 64; float* li_l = ws; float* al_l = ws + 32;
  float l_reg = 0; f32x16 o[4] = {}; f32x16 negm = {}; bf16x8 qr[4];
  const bf16_t* Qw = Qb + (size_t)(qsub * 32 + r32) * AW + mcol + hi * 8;
#pragma unroll
  for (int d0 = 0; d0 < 4; ++d0) qr[d0] = *reinterpret_cast<const bf16x8*>(Qw + d0 * 16);
  const int vb0 = (int)(uintptr_t)V_lds + v_rd_base(lane);
  unsigned ksrc[2], vsrc[2];
#pragma unroll
  for (int i = 0; i < 2; ++i) { const int pq = 2 * wid + i;
    const int krow = 4 * pq + (lane >> 4); ksrc[i] = (unsigned)(krow * LDK * 2 + (((lane & 15) ^ (krow & 7)) * 16));
    const int kk = 8 * (pq >> 1) + ((lane & 31) >> 2), key = (kk & ~0xC) | ((kk & 4) << 1) | ((kk & 8) >> 1), col = 32 * (2 * (pq & 1) + (lane >> 5)) + 8 * (lane & 3);
    vsrc[i] = (unsigned)(key * LDK * 2 + col * 2); }
  const unsigned pieceoff = (unsigned)wid * 2048u;
#define SDMA(slot, k0) do { const char* kg_ = (const char*)Kh + (size_t)(k0) * LDK * 2; const char* vg_ = (const char*)Vh + (size_t)(k0) * LDK * 2; \
    _Pragma("unroll") for (int i_ = 0; i_ < 2; ++i_) { \
      __builtin_amdgcn_global_load_lds((const unsigned*)(kg_ + ksrc[i_]), (LAS unsigned*)((LAS char*)K_lds + (slot) * SHM_K + pieceoff + i_ * 1024), 16, 0, 0); \
      __builtin_amdgcn_global_load_lds((const unsigned*)(vg_ + vsrc[i_]), (LAS unsigned*)((LAS char*)V_lds + (slot) * SHM_V + pieceoff + i_ * 1024), 16, 0, 0); } } while (0)
#define SWAIT() asm volatile("s_waitcnt vmcnt(0)" ::: "memory")
#define RESC(a) do { if (__any((a) < 1.f)) { if (hi == 0) al_l[r32] = (a); asm volatile("s_waitcnt lgkmcnt(0)" ::: "memory"); \
    _Pragma("unroll") for (int d = 0; d < 4; ++d) _Pragma("unroll") for (int r = 0; r < 16; ++r) o[d][r] *= al_l[crow(r, hi)]; } } while (0)
  f32x16 pA0, pA1, pB0, pB1; float alA, alB; bf16x8 pa0, pa1, pa2, pa3; constexpr int NT = SKV / KVBLK;
  SDMA(0, 0); SDMA(1, KVBLK); SWAIT(); __syncthreads();
  qkt(pA0, pA1, K_lds, qr, r32, hi, mcol, negm); partialSM(pA0, pA1, negm, true, alA);
  int sp = 0, scur = 1, sn = 2;
#define ASTEP(X0, X1, ALX, Y0, Y1, ALY, jj, LOADNEXT) do { \
    if (LOADNEXT) SDMA(sn, ((jj) + 1) * KVBLK);                    \
    SBAR(); qkt(X0, X1, K_lds + scur * SHM_K, qr, r32, hi, mcol, negm); \
    finishSM(Y0, Y1, ALY, l_reg, pa0, pa1, pa2, pa3); SBAR(); \
    pv_sm(o, vb0 + sp * SHM_V, pa0, pa1, pa2, pa3, X0, X1, negm, ALX); \
    RESC(ALX); SWAIT(); __syncthreads(); \
    { const int t_ = sp; sp = scur; scur = sn; sn = t_; } } while (0)
  for (int j = 1; j + 1 < NT; j += 2) {
    ASTEP(pB0, pB1, alB, pA0, pA1, alA, j, true);
    ASTEP(pA0, pA1, alA, pB0, pB1, alB, j + 1, true);
  }
  ASTEP(pB0, pB1, alB, pA0, pA1, alA, NT - 1, false);
#undef ASTEP
  finishSM(pB0, pB1, alB, l_reg, pa0, pa1, pa2, pa3); SBAR();
  pv_d0(o, vb0 + sp * SHM_V, pa0, pa1, pa2, pa3);
  if (hi == 0) li_l[r32] = l_reg; asm volatile("s_waitcnt lgkmcnt(0)" ::: "memory");
  float rli[16];
#pragma unroll
  for (int r = 0; r < 16; ++r) rli[r] = __builtin_amdgcn_rcpf(li_l[crow(r, hi)]);
  __syncthreads();
  float* X2 = (float*)lds + qsub * 4096 + lane;
  if (map == 1) {
#pragma unroll
    for (int r = 0; r < 16; ++r)
#pragma unroll
      for (int d0 = 0; d0 < 4; ++d0) X2[(r * 4 + d0) * 64] = o[d0][r] * rli[r];
  }
  __syncthreads();
  if (map == 0) {
    float g[4];
#pragma unroll
    for (int d0 = 0; d0 < 4; ++d0) g[d0] = gsub[32 * d0 + r32] * (1.f - LAM_INIT);
    char* ost = (char*)lds + 65536 + qsub * 8192;
#pragma unroll
    for (int r = 0; r < 16; ++r) {
      float ss = 0.f;
#pragma unroll
      for (int d0 = 0; d0 < 4; ++d0) { const float v = o[d0][r] * rli[r] - lam * X2[(r * 4 + d0) * 64]; o[d0][r] = v; ss += v * v; }
#pragma unroll
      for (int m = 1; m < 32; m <<= 1) ss += shx(ss, m, lane);
      const float rs = rsqrtf(ss * (1.f / 128.f) + EPS);
      char* orow = ost + crow(r, hi) * 256 + r32 * 2;
#pragma unroll
      for (int d0 = 0; d0 < 4; ++d0) *(bf16_t*)(orow + 64 * d0) = (bf16_t)f2bf(o[d0][r] * rs * g[d0]);
    }
    asm volatile("s_waitcnt lgkmcnt(0)" ::: "memory");
#pragma unroll
    for (int i = 0; i < 8; ++i) { const int q = lane + 64 * i, lr = q >> 4, chunk = q & 15;
      const uint4 v = *(const uint4*)(ost + lr * 256 + chunk * 16);
      *(uint4*)(Ob + (size_t)(qsub * 32 + lr) * DM + chunk * 8) = v; }
  }
  __syncthreads();
#undef SLOAD
#undef SWRITE
#undef SWAIT
#undef RESC
}
#undef KSWZ
#undef SBAR
}
__device__ __forceinline__ void ph_attn_fast(CArgs& a, const Ctx& c) {
  const bf16_t* Q = (const bf16_t*)(a.ws + WS_Q); const bf16_t* Kb = (const bf16_t*)(a.ws + WS_K); const bf16_t* Vb = (const bf16_t*)(a.ws + WS_V); bf16_t* ATT = (bf16_t*)(a.ws + WS_ATT);
  const float lam = *(const float*)(a.ws + WS_LAM);
  constexpr int NU = NB * NH * (NSEQ / 128);
  for (int i = 0; ; ++i) {
    const int L = i * c.G + c.blk; if (L >= NU) break;
    const int v = pg8::xcd_remap(L, NU), qb = v & 31, bh = v >> 5, b = bh >> 2, h = bh & 3;
    const size_t row0 = (size_t)b * NSEQ + qb * 128;
    att::unit(Q + row0 * AW + h * 128, Kb + (size_t)b * SKV * AW + h * 128, Vb + (size_t)b * SKV * AW + h * 128, ATT + row0 * DM + h * 128, lam, a.in[I_GSUBLN], (char*)c.lds, c.tid);
  }
}

constexpr int NPHASE = 10;
__device__ __forceinline__ void run_phase(int ph, CArgs& a, const Ctx& c) {
    switch (ph) {
        case 0: { unsigned* f = (unsigned*)(a.ws + WS_CTL) + CW_ADALN;
                  pt_mark(c.lds, c.tid, 0, true); ph_adaln(a, c); flag_arrive(f, c.tid); pt_mark(c.lds, c.tid, 0, false);
                  pt_mark(c.lds, c.tid, 1, true); ph_transposes(a, c, 0, TR_NIT - TR_NFILL, c.blk * 8 + c.wave, c.G * 8); __syncthreads(); pt_mark(c.lds, c.tid, 1, false);
                  pt_mark(c.lds, c.tid, 2, true); flag_wait(f, (unsigned)c.G, c.tid); ph_hxrows(a, c); __syncthreads(); pt_mark(c.lds, c.tid, 2, false); } break;
        case 1: break;
        case 2: ph_inproj_fast(a, c); break;
        case 3: ph_attn_fast(a, c); __syncthreads(); ph_pool_fast(a, c); break;
        case 4: ph_outproj_fast(a, c); break;
        case 5: { unsigned* f = (unsigned*)(a.ws + WS_CTL) + CW_ROUTER;
                  ph_norm_router_fast(a, c); flag_arrive(f, c.tid); flag_wait(f, (unsigned)c.G, c.tid); ph_tables(a, c); } break;
        case 6: break;
        case 7: ph_gateup_fast(a, c); break;
        case 8: ph_down_fast(a, c); break;
        case 9: ph_combine(a, c); break;
        default: break;
    }
}
__global__ void __launch_bounds__(512, 2) mega(Args a_) {
    extern __shared__ __attribute__((aligned(16))) unsigned char lds[];
    const int lo = a_.ph_lo, hi = a_.ph_hi;
    { volatile LAS unsigned* z = (volatile LAS unsigned*)((LAS unsigned char*)lds + LDSCTL_OFF); for (int u = threadIdx.x; u < (LDS_BYTES - LDSCTL_OFF) / 4; u += 512) z[u] = 0u; }
    __syncthreads();
    volatile LAS unsigned* MISC = (volatile LAS unsigned*)((LAS unsigned char*)lds + MISC_OFF);
    XcdBarrier bar; bar.bar = (unsigned*)(a_.ws + WS_CTL); bar.x = 0; bar.st = nullptr;
    if (hi - lo > 1) bar = xcd_barrier_post((unsigned*)(a_.ws + WS_CTL), MISC + 8);
    unsigned long long probe_ticks = 0;
    const int wv0_ = __builtin_amdgcn_readfirstlane(threadIdx.x >> 6);
#define PHASE(k) if (lo <= (k) && (k) < hi) { \
        unsigned long long pt0_ = 0; if ((k) == PROBE_PH) pt0_ = __builtin_amdgcn_s_memrealtime(); \
        int t_ = wv0_ * 64 + (int)__builtin_amdgcn_mbcnt_hi(~0u, __builtin_amdgcn_mbcnt_lo(~0u, 0u)); asm volatile("" : "+v"(t_)); \
        CArgs* ap_ = (CArgs*)__builtin_amdgcn_kernarg_segment_ptr(); asm volatile("" : "+s"(ap_)); \
        Ctx c; c.tid = t_; c.lane = t_ & 63; c.wave = __builtin_amdgcn_readfirstlane(t_ >> 6); c.blk = blockIdx.x; c.G = gridDim.x; c.lds = lds; \
        run_phase((k), *ap_, c); \
        if ((k) == REPEAT_PH) { for (int rep_ = 0; rep_ < REPEAT_N; ++rep_) { xcd_barrier(bar, c.tid); run_phase((k), *ap_, c); } } \
        if ((k) + 1 < hi) xcd_barrier(bar, c.tid); \
        if ((k) == PROBE_PH) probe_ticks = __builtin_amdgcn_s_memrealtime() - pt0_; }
    PHASE(0) PHASE(2) PHASE(3) PHASE(4) PHASE(5) PHASE(7) PHASE(8) PHASE(9)
#undef PHASE
    if (PROBE_SUB >= 0) probe_ticks = ((volatile LAS unsigned*)((LAS unsigned char*)lds + MISC_OFF))[16 + 2 * PROBE_SUB + 1];
    if ((PROBE_PH >= 0 || PROBE_SUB >= 0) && blockIdx.x == 0) { const unsigned long long t0 = __builtin_amdgcn_s_memrealtime(); while (__builtin_amdgcn_s_memrealtime() - t0 < probe_ticks * PROBE_AMP) __builtin_amdgcn_s_sleep(8); }
}

extern "C" void kernel_launch(void* const* d_in, const int* in_sizes, int n_in, void* d_out, int out_size, void* d_ws, size_t ws_size, hipStream_t stream) {
    static int grid = 0;
    if (grid == 0) {
        if (n_in != 28 || in_sizes[0] != T * DM || out_size != T * DM || ws_size < WS_END) {
            fprintf(stderr, "kernel_launch: unexpected shapes or workspace: n_in %d in0 %d out %d ws %zu (need %zu)\n", n_in, n_in > 0 ? in_sizes[0] : -1, out_size, ws_size, (size_t)WS_END);
            grid = -1; return; }
        int dev = 0, cus = 0;
        if (hipGetDevice(&dev) != hipSuccess || hipDeviceGetAttribute(&cus, hipDeviceAttributeMultiprocessorCount, dev) != hipSuccess) { grid = -1; return; }
        if (hipFuncSetAttribute((const void*)mega, hipFuncAttributeMaxDynamicSharedMemorySize, LDS_BYTES) != hipSuccess) { fprintf(stderr, "kernel_launch: hipFuncSetAttribute failed\n"); grid = -1; return; }
        grid = cus;
    }
    if (grid < 0) return;
    (void)hipMemsetAsync((char*)d_ws + WS_CTL, 0, CTL_ZERO_BYTES, stream);
    Args a{};
    for (int i = 0; i < 28; ++i) a.in[i] = (const float*)d_in[i];
    a.out = (float*)d_out; a.ws = (unsigned char*)d_ws;
#if MK_PER_PHASE_LAUNCH
    for (int p = 0; p < NPHASE; ++p) { a.ph_lo = p; a.ph_hi = p + 1; hipLaunchKernelGGL(mega, dim3(grid), dim3(512), LDS_BYTES, stream, a); }
#else
    a.ph_lo = 0; a.ph_hi = NPHASE; hipLaunchKernelGGL(mega, dim3(grid), dim3(512), LDS_BYTES, stream, a);
#endif
    const hipError_t le = hipPeekAtLastError();
    if (le != hipSuccess) fprintf(stderr, "kernel_launch: launch failed: %s\n", hipGetErrorName(le));
}
```
